# Optimizing an MI355X kernel written in HIP

```python
import math
import jax, jax.numpy as jnp
from jax import lax
import numpy as np

D_MODEL = 1024
BATCH = 4
SEQ = 8192
DEPTH = 2

CHUNK = 64
SB_HEADS = 4
SB_HEAD_DIM = 64
SB_BLOCK = 128
GDN_HEADS = 4
GDN_HEAD_DIM = 128
GDN_CONV = 4
SC_WIDTH = 256
SC_CONV = 3
D_FF = 2816
PLE_DIM = 256
LN_EPS = 1e-5
NORM_EPS = 1e-6
ALPHA = (2 * DEPTH) ** 0.25
BETA = (8 * DEPTH) ** -0.25

SB_WIDTH = SB_HEADS * SB_HEAD_DIM
GDN_WIDTH = GDN_HEADS * GDN_HEAD_DIM
MIX_WIDTH = SB_WIDTH + GDN_WIDTH + SC_WIDTH
OFF_SB = 3 * SB_WIDTH
OFF_GDN_QKV = OFF_SB + 3 * GDN_WIDTH
OFF_GDN_Z = OFF_GDN_QKV + GDN_WIDTH
OFF_GDN_A = OFF_GDN_Z + GDN_HEADS
OFF_GDN_B = OFF_GDN_A + GDN_HEADS
IN_COLS = OFF_GDN_B + 3 * SC_WIDTH

kernel_name = 'hybrid_streaming_encoder_block'


def layer_norm(x, g, b):
    xf = x.astype(jnp.float32)
    mu = jnp.mean(xf, axis=-1, keepdims=True)
    var = jnp.mean(jnp.square(xf - mu), axis=-1, keepdims=True)
    return ((xf - mu) * lax.rsqrt(var + LN_EPS) * g + b).astype(x.dtype)


def swiglu(x, w_in, w_out):
    gate, up = jnp.split(x @ w_in, 2, axis=-1)
    return (jax.nn.silu(gate) * up) @ w_out


def causal_dwconv(x, w):
    K = w.shape[0]
    S = x.shape[1]
    xp = jnp.pad(x, ((0, 0), (K - 1, 0), (0, 0)))
    return sum(xp[:, i:i + S] * w[i] for i in range(K))


def l2_normalize(t):
    tf = t.astype(jnp.float32)
    return tf * lax.rsqrt(jnp.sum(tf * tf, axis=-1, keepdims=True) + NORM_EPS)


def gated_rms_norm(o, z, w):
    of = o.astype(jnp.float32)
    y = of * lax.rsqrt(jnp.mean(of * of, axis=-1, keepdims=True) + NORM_EPS) * w
    return (y * jax.nn.silu(z.astype(jnp.float32))).astype(z.dtype)


def stick_breaking_attention(q, k, v):
    S = q.shape[2]
    scale = q.shape[-1] ** -0.5
    outs = []
    for t0 in range(0, S, SB_BLOCK):
        t1 = t0 + SB_BLOCK
        qb = q[:, :, t0:t1].astype(jnp.float32)
        kp = k[:, :, :t1].astype(jnp.float32)
        vp = v[:, :, :t1].astype(jnp.float32)
        z = jnp.einsum('bhqd,bhkd->bhqk', qb, kp) * scale
        mask = jnp.arange(t1)[None, :] < jnp.arange(t0, t1)[:, None]
        log_skip = jnp.where(mask, jax.nn.log_sigmoid(-z), 0.0)
        later = lax.cumsum(log_skip, axis=3, reverse=True) - log_skip
        att = jnp.where(mask, jnp.exp(jax.nn.log_sigmoid(z) + later), 0.0)
        outs.append(jnp.einsum('bhqk,bhkd->bhqd', att, vp))
    return jnp.concatenate(outs, axis=2).astype(v.dtype)


def gated_delta_rule_chunked(q, k, v, g, beta):
    Bsz, S, H, dk = q.shape
    dv = v.shape[-1]
    n = S // CHUNK

    def blocks(t):
        t = t.reshape(Bsz, n, CHUNK, H, *t.shape[3:])
        return jnp.swapaxes(jnp.moveaxis(t, 1, 0), 2, 3)

    q, k, v, g, beta = blocks(q), blocks(k), blocks(v), blocks(g), blocks(beta)
    gcum = jnp.cumsum(g, axis=-1)
    incl = jnp.tril(jnp.ones((CHUNK, CHUNK), dtype=bool))
    strict = jnp.tril(jnp.ones((CHUNK, CHUNK), dtype=bool), k=-1)
    decay = jnp.exp(jnp.where(incl, gcum[..., :, None] - gcum[..., None, :], -jnp.inf))
    k_beta = k * beta[..., None]
    m = jnp.where(strict, jnp.einsum('nbhik,nbhjk->nbhij', k_beta, k) * decay, 0.0)
    eye = jnp.eye(CHUNK, dtype=m.dtype)
    t_inv = lax.linalg.triangular_solve(eye + m, jnp.broadcast_to(eye, m.shape),
                                        left_side=True, lower=True)
    u = jnp.einsum('nbhij,nbhjv->nbhiv', t_inv, v * beta[..., None])
    w = jnp.einsum('nbhij,nbhjk->nbhik', t_inv, k_beta * jnp.exp(gcum)[..., None])
    qk = jnp.einsum('nbhik,nbhjk->nbhij', q, k) * decay
    q_dec = q * jnp.exp(gcum)[..., None]
    k_dec = k * jnp.exp(gcum[..., -1:] - gcum)[..., None]
    g_last = jnp.exp(gcum[..., -1])

    def step(state, xs):
        u_c, w_c, qk_c, q_c, k_c, gl = xs
        v_new = u_c - jnp.einsum('bhik,bhkv->bhiv', w_c, state)
        o = jnp.einsum('bhik,bhkv->bhiv', q_c, state) + jnp.einsum('bhij,bhjv->bhiv', qk_c, v_new)
        state = state * gl[..., None, None] + jnp.einsum('bhik,bhiv->bhkv', k_c, v_new)
        return state, o

    s0 = jnp.zeros((Bsz, H, dk, dv), jnp.float32)
    _, o = lax.scan(step, s0, (u, w, qk, q_dec, k_dec, g_last))
    return jnp.moveaxis(jnp.swapaxes(o, 2, 3), 0, 1).reshape(Bsz, S, H, dv)


def token_mix(h, w_in, gdn_conv_w, gdn_a_log, gdn_dt_bias, gdn_norm_w, sc_conv_w, w_out):
    Bsz, S, _ = h.shape
    proj = h @ w_in
    sb_qkv, gdn_qkv, gdn_z, gdn_a, gdn_b, sc_bch = jnp.split(
        proj, [OFF_SB, OFF_GDN_QKV, OFF_GDN_Z, OFF_GDN_A, OFF_GDN_B], axis=-1)

    sb_q, sb_k, sb_v = [t.reshape(Bsz, S, SB_HEADS, SB_HEAD_DIM).transpose(0, 2, 1, 3)
                        for t in jnp.split(sb_qkv, 3, axis=-1)]
    o_sb = stick_breaking_attention(sb_q, sb_k, sb_v).transpose(0, 2, 1, 3).reshape(Bsz, S, SB_WIDTH)

    gdn_qkv = jax.nn.silu(causal_dwconv(gdn_qkv, gdn_conv_w))
    g_q, g_k, g_v = [t.reshape(Bsz, S, GDN_HEADS, GDN_HEAD_DIM) for t in jnp.split(gdn_qkv, 3, axis=-1)]
    g_q = l2_normalize(g_q) * (GDN_HEAD_DIM ** -0.5)
    g_k = l2_normalize(g_k)
    beta = jax.nn.sigmoid(gdn_b.astype(jnp.float32))
    log_decay = -jnp.exp(gdn_a_log.astype(jnp.float32)) * jax.nn.softplus(
        gdn_a.astype(jnp.float32) + gdn_dt_bias.astype(jnp.float32))
    o_gdn = gated_delta_rule_chunked(g_q, g_k, g_v.astype(jnp.float32), log_decay, beta)
    o_gdn = gated_rms_norm(o_gdn, gdn_z.reshape(Bsz, S, GDN_HEADS, GDN_HEAD_DIM), gdn_norm_w)
    o_gdn = o_gdn.reshape(Bsz, S, GDN_WIDTH)

    sc_b, sc_c, sc_h = jnp.split(sc_bch, 3, axis=-1)
    o_sc = sc_b * causal_dwconv(sc_c * sc_h, sc_conv_w)

    mixed = jnp.concatenate([o_sb.astype(h.dtype), o_gdn.astype(h.dtype), o_sc], axis=-1)
    return mixed @ w_out


def setup_inputs(seed: int = 0) -> dict:
    key = jax.random.key(seed)
    ks = jax.random.split(key, 16)

    def nrm(k, shape, scale):
        return scale * jax.random.normal(k, shape, jnp.float32)

    dt = jnp.exp(jax.random.uniform(ks[9], (DEPTH, GDN_HEADS), jnp.float32,
                                    math.log(1e-3), math.log(1e-1)))
    return {
        'x': nrm(ks[0], (BATCH, SEQ, D_MODEL), 1.0),
        'p': nrm(ks[1], (DEPTH, BATCH, SEQ, PLE_DIM), 1.0),
        'ln_g': 1.0 + nrm(ks[2], (DEPTH, 4, D_MODEL), 0.02),
        'ln_b': nrm(ks[3], (DEPTH, 4, D_MODEL), 0.02),
        'ffn_w_in': nrm(ks[4], (DEPTH, 2, D_MODEL, 2 * D_FF), D_MODEL ** -0.5),
        'ffn_w_out': nrm(ks[5], (DEPTH, 2, D_FF, D_MODEL), BETA * D_FF ** -0.5),
        'mix_w_in': nrm(ks[6], (DEPTH, D_MODEL, IN_COLS), D_MODEL ** -0.5),
        'gdn_conv_w': nrm(ks[7], (DEPTH, GDN_CONV, 3 * GDN_WIDTH), GDN_CONV ** -0.5),
        'gdn_a_log': jnp.log(jax.random.uniform(ks[8], (DEPTH, GDN_HEADS), jnp.float32, 1.0, 16.0)),
        'gdn_dt_bias': jnp.log(jnp.expm1(dt)),
        'gdn_norm_w': 1.0 + nrm(ks[10], (DEPTH, GDN_HEAD_DIM), 0.02),
        'sc_conv_w': nrm(ks[11], (DEPTH, SC_CONV, SC_WIDTH), SC_CONV ** -0.5),
        'mix_w_out': nrm(ks[12], (DEPTH, MIX_WIDTH, D_MODEL), BETA * MIX_WIDTH ** -0.5),
        'ple_w_proj': nrm(ks[13], (DEPTH, PLE_DIM, D_MODEL), BETA * PLE_DIM ** -0.5),
        'ple_w_gate': nrm(ks[14], (DEPTH, D_MODEL, D_MODEL), D_MODEL ** -0.5),
        'ple_b_gate': nrm(ks[15], (DEPTH, D_MODEL), 0.02),
    }


def reference(x, p, ln_g, ln_b, ffn_w_in, ffn_w_out, mix_w_in, gdn_conv_w, gdn_a_log,
              gdn_dt_bias, gdn_norm_w, sc_conv_w, mix_w_out, ple_w_proj, ple_w_gate, ple_b_gate):
    for i in range(DEPTH):
        x = layer_norm(ALPHA * x + 0.5 * swiglu(x, ffn_w_in[i, 0], ffn_w_out[i, 0]), ln_g[i, 0], ln_b[i, 0])
        mix = token_mix(x, mix_w_in[i], gdn_conv_w[i], gdn_a_log[i], gdn_dt_bias[i],
                        gdn_norm_w[i], sc_conv_w[i], mix_w_out[i])
        x = layer_norm(ALPHA * x + mix, ln_g[i, 1], ln_b[i, 1])
        x = layer_norm(ALPHA * x + 0.5 * swiglu(x, ffn_w_in[i, 1], ffn_w_out[i, 1]), ln_g[i, 2], ln_b[i, 2])
        ple = jax.nn.sigmoid(x @ ple_w_gate[i] + ple_b_gate[i]) * (p[i] @ ple_w_proj[i])
        x = layer_norm(ALPHA * x + ple, ln_g[i, 3], ln_b[i, 3])
    return x
```

```cpp
#include <hip/hip_runtime.h>
#include <hip/hip_cooperative_groups.h>
#include <cstdio>
#include <cstdint>
namespace cg = cooperative_groups;

#define DI __device__ __forceinline__
typedef unsigned short bf16_t;
typedef short bf16x8 __attribute__((ext_vector_type(8)));
typedef float f32x4 __attribute__((ext_vector_type(4)));
typedef unsigned u32x4 __attribute__((ext_vector_type(4)));
typedef unsigned u32x2 __attribute__((ext_vector_type(2)));
typedef __bf16 bf2_t __attribute__((ext_vector_type(2)));
typedef float f2_t __attribute__((ext_vector_type(2)));

#ifndef PROBE_GEMM2
#define PROBE_GEMM2 0
#endif
#ifndef PROBE_MIX2
#define PROBE_MIX2 0
#endif
#ifndef PROBE_PREP2
#define PROBE_PREP2 0
#endif
#ifndef PROBE_GPREP2
#define PROBE_GPREP2 0
#endif
#ifndef PROBE_SCAN2
#define PROBE_SCAN2 0
#endif
#ifndef PROBE_SBSC2
#define PROBE_SBSC2 0
#endif
#ifndef PROBE_TILES2
#define PROBE_TILES2 0
#endif
#ifndef N_LAUNCH_MODE
#define N_LAUNCH_MODE 1
#endif

constexpr int D = 1024, BATCH = 4, SEQ = 8192, NTOK = BATCH * SEQ, DEPTH = 2;
constexpr int DFF = 2816, PLE = 256;
constexpr int PJ = 3584;
constexpr int PJN = 3840;
constexpr int RB = 128;
constexpr int NRB = NTOK / RB;
constexpr float ALPHA = 1.41421356237f;
constexpr int NTHREADS = 512;

constexpr size_t SZ_W1 = (size_t)2 * DFF * D * 2;
constexpr size_t SZ_W2 = (size_t)D * DFF * 2;
constexpr size_t SZ_WIN = (size_t)PJN * D * 2;
constexpr size_t SZ_WSQ = (size_t)D * D * 2;
constexpr size_t SZ_WP = (size_t)D * PLE * 2;
constexpr size_t OFF_W1 = 0;
constexpr size_t OFF_W2 = OFF_W1 + 4 * SZ_W1;
constexpr size_t OFF_WIN = OFF_W2 + 4 * SZ_W2;
constexpr size_t OFF_WOUT = OFF_WIN + 2 * SZ_WIN;
constexpr size_t OFF_WG = OFF_WOUT + 2 * SZ_WSQ;
constexpr size_t OFF_WP = OFF_WG + 2 * SZ_WSQ;
constexpr size_t OFF_XB = OFF_WP + 2 * SZ_WP;
constexpr size_t OFF_U = OFF_XB + (size_t)NTOK * D * 2;
constexpr size_t OFF_GQ = OFF_U + (size_t)NTOK * PJ * 2;
constexpr size_t OFF_AB = OFF_GQ + (size_t)NTOK * 1536 * 2;
constexpr size_t OFF_GB = OFF_AB + (size_t)NTOK * 8 * 4;
constexpr size_t OFF_GL = OFF_GB + (size_t)NTOK * 8 * 4;
constexpr size_t OFF_BAR = OFF_GL + 2048 * 4;
constexpr size_t OFF_HALO = OFF_BAR + 128;
constexpr size_t WS_END = OFF_HALO + (size_t)NRB * 3 * 1536 * 2;

struct Params {
    const float *x, *p, *ln_g, *ln_b, *ffn_w_in, *ffn_w_out, *mix_w_in, *gdn_conv_w, *gdn_a_log, *gdn_dt_bias, *gdn_norm_w, *sc_conv_w,
        *mix_w_out, *ple_w_proj, *ple_w_gate, *ple_b_gate;
    float* out;
    unsigned char* ws;
    int ph_lo, ph_hi;
};

DI unsigned pk_bf16(float a, float b) { bf2_t v = __builtin_convertvector((f2_t){a, b}, bf2_t); return __builtin_bit_cast(unsigned, v); }
DI float bf_lo(unsigned u) { return __uint_as_float(u << 16); }
DI float bf_hi(unsigned u) { return __uint_as_float(u & 0xffff0000u); }
DI float bf2f(bf16_t h) { return __uint_as_float(((unsigned)h) << 16); }
DI float sigmoidf_(float x) { return __builtin_amdgcn_rcpf(1.0f + __expf(-x)); }
DI float softplusf_(float x) { return fmaxf(x, 0.f) + log1pf(__expf(-fabsf(x))); }
DI float wave_sum(float v) {
#pragma unroll
    for (int o = 32; o >= 1; o >>= 1) v += __shfl_xor(v, o);
    return v;
}

DI int tid_() { int t = threadIdx.x; asm volatile("" : "+v"(t)); return t; }
DI void glds16(const void* gsrc, unsigned lds_dst) {
    unsigned keep;
    asm volatile("s_mov_b32 %0, m0\n\ts_mov_b32 m0, %2\n\ts_nop 0\n\tglobal_load_lds_dwordx4 %1, off\n\ts_mov_b32 m0, %0" : "=&s"(keep) : "v"(gsrc), "s"(lds_dst) : "memory");
}
DI void glds16x6(const void* sa, const void* sb, unsigned va0, unsigned va1, unsigned vb0, unsigned vb1, unsigned vb2, unsigned vb3, unsigned lds_dst) {
    unsigned keep;
    asm volatile("s_mov_b32 %0, m0\n\ts_mov_b32 m0, %9\n\ts_nop 0\n\t"
                 "global_load_lds_dwordx4 %3, %1\n\ts_add_u32 m0, m0, 0x2000\n\ts_nop 0\n\t"
                 "global_load_lds_dwordx4 %4, %1\n\ts_add_u32 m0, m0, 0x2000\n\ts_nop 0\n\t"
                 "global_load_lds_dwordx4 %5, %2\n\ts_add_u32 m0, m0, 0x2000\n\ts_nop 0\n\t"
                 "global_load_lds_dwordx4 %6, %2\n\ts_add_u32 m0, m0, 0x2000\n\ts_nop 0\n\t"
                 "global_load_lds_dwordx4 %7, %2\n\ts_add_u32 m0, m0, 0x2000\n\ts_nop 0\n\t"
                 "global_load_lds_dwordx4 %8, %2\n\ts_mov_b32 m0, %0"
                 : "=&s"(keep) : "s"(sa), "s"(sb), "v"(va0), "v"(va1), "v"(vb0), "v"(vb1), "v"(vb2), "v"(vb3), "s"(lds_dst) : "memory", "scc");
}
DI void glds16x5(const void* sa, const void* sb, unsigned va, unsigned vb0, unsigned vb1, unsigned vb2, unsigned vb3, unsigned lds_dst) {
    unsigned keep;
    asm volatile("s_mov_b32 %0, m0\n\ts_mov_b32 m0, %8\n\ts_nop 0\n\t"
                 "global_load_lds_dwordx4 %3, %1\n\ts_add_u32 m0, m0, 0x2000\n\ts_nop 0\n\t"
                 "global_load_lds_dwordx4 %4, %2\n\ts_add_u32 m0, m0, 0x2000\n\ts_nop 0\n\t"
                 "global_load_lds_dwordx4 %5, %2\n\ts_add_u32 m0, m0, 0x2000\n\ts_nop 0\n\t"
                 "global_load_lds_dwordx4 %6, %2\n\ts_add_u32 m0, m0, 0x2000\n\ts_nop 0\n\t"
                 "global_load_lds_dwordx4 %7, %2\n\ts_mov_b32 m0, %0"
                 : "=&s"(keep) : "s"(sa), "s"(sb), "v"(va), "v"(vb0), "v"(vb1), "v"(vb2), "v"(vb3), "s"(lds_dst) : "memory", "scc");
}
DI void lds_barrier() { asm volatile("s_waitcnt lgkmcnt(0)\n\ts_barrier" ::: "memory"); }
constexpr int LDS_ROW = 144;
constexpr int A_STAGE = 128 * LDS_ROW;
constexpr int B_STAGE = 256 * LDS_ROW;
constexpr int STAGE = A_STAGE + B_STAGE;
constexpr int G3_A = 16384, G3_STAGE = 49152;
constexpr int H5_A = 8192, H5_STAGE = 40960;
constexpr int CHUNK_WAVE_LDS = 18944;
constexpr int SMEM_BYTES = 8 * CHUNK_WAVE_LDS;

DI void gemm_tile(const bf16_t* __restrict__ A, int lda, const bf16_t* __restrict__ Bt, int ldb, int K, unsigned char* smem, f32x4 (&acc)[4][4], bool zero = true) {
    const int tid = tid_(), lane = tid & 63, wid = tid >> 6;
    const int wm = wid >> 2, wn = wid & 3;
#pragma unroll
    for (int i = 0; i < 4; ++i)
#pragma unroll
        for (int j = 0; j < 4; ++j) if (zero) acc[i][j] = (f32x4){0.f, 0.f, 0.f, 0.f};
    const int crow = tid >> 3, ckc = tid & 7;
    const bf16_t* ag = A + (size_t)crow * lda + ckc * 8;
    const bf16_t* bg = Bt + (size_t)crow * ldb + ckc * 8;
    u32x4 ra[2], rb[4];
#pragma unroll
    for (int i = 0; i < 2; ++i) ra[i] = *(const u32x4*)(ag + (size_t)i * 64 * lda);
#pragma unroll
    for (int i = 0; i < 4; ++i) rb[i] = *(const u32x4*)(bg + (size_t)i * 64 * ldb);
    const int soff = crow * LDS_ROW + ckc * 16;
#pragma unroll
    for (int i = 0; i < 2; ++i) *(u32x4*)(smem + soff + i * 64 * LDS_ROW) = ra[i];
#pragma unroll
    for (int i = 0; i < 4; ++i) *(u32x4*)(smem + A_STAGE + soff + i * 64 * LDS_ROW) = rb[i];
    __syncthreads();
    const int nk = K >> 6;
    const int fa = (wm * 64 + (lane & 15)) * LDS_ROW + (lane >> 4) * 16;
    const int fb = A_STAGE + (wn * 64 + (lane & 15)) * LDS_ROW + (lane >> 4) * 16;
    for (int kt = 0; kt < nk; ++kt) {
        const int cur = kt & 1;
        const bool more = (kt + 1 < nk);
        if (more) {
            const int ko = (kt + 1) * 64;
#pragma unroll
            for (int i = 0; i < 2; ++i) ra[i] = *(const u32x4*)(ag + (size_t)i * 64 * lda + ko);
#pragma unroll
            for (int i = 0; i < 4; ++i) rb[i] = *(const u32x4*)(bg + (size_t)i * 64 * ldb + ko);
        }
        const unsigned char* sc = smem + cur * STAGE;
#pragma unroll
        for (int ks = 0; ks < 2; ++ks) {
            bf16x8 af[4], bfr[4];
#pragma unroll
            for (int mt = 0; mt < 4; ++mt) af[mt] = *(const bf16x8*)(sc + fa + mt * 16 * LDS_ROW + ks * 64);
#pragma unroll
            for (int nt = 0; nt < 4; ++nt) bfr[nt] = *(const bf16x8*)(sc + fb + nt * 16 * LDS_ROW + ks * 64);
#pragma unroll
            for (int mt = 0; mt < 4; ++mt)
#pragma unroll
                for (int nt = 0; nt < 4; ++nt) acc[mt][nt] = __builtin_amdgcn_mfma_f32_16x16x32_bf16(bfr[nt], af[mt], acc[mt][nt], 0, 0, 0);
        }
        if (more) {
            unsigned char* sn = smem + (cur ^ 1) * STAGE;
#pragma unroll
            for (int i = 0; i < 2; ++i) *(u32x4*)(sn + soff + i * 64 * LDS_ROW) = ra[i];
#pragma unroll
            for (int i = 0; i < 4; ++i) *(u32x4*)(sn + A_STAGE + soff + i * 64 * LDS_ROW) = rb[i];
        }
        __syncthreads();
    }
}

DI int colmap(int mode, int n) {
    if (mode == 0) return n;
    if (mode == 1) { const int a = (n >> 4) & 7; return (a & 1) * DFF + (n >> 9) * 256 + ((n >> 7) & 3) * 64 + ((n >> 2) & 3) * 16 + (a >> 1) * 4 + (n & 3); }
    if (n < 2816) return n;
    if (n < 3584) return n + 8;
    if (n < 3592) return n - 3584 + 2816;
    return -1;
}
DI void transpose_tile(const float* __restrict__ src, int Nsrc, int K, bf16_t* __restrict__ dst, int mode, int k0, int n0, float* tile  ) {
    const int tid = tid_();
    const int n4 = (tid & 15) * 4;
    const int c = colmap(mode, n0 + n4);
#pragma unroll
    for (int i = 0; i < 2; ++i) {
        const int kk = (tid >> 4) + 32 * i;
        f32x4 v = {0.f, 0.f, 0.f, 0.f};
        if (c >= 0) v = *(const f32x4*)(src + (size_t)(k0 + kk) * Nsrc + c);
        tile[kk * 65 + n4] = v[0]; tile[kk * 65 + n4 + 1] = v[1]; tile[kk * 65 + n4 + 2] = v[2]; tile[kk * 65 + n4 + 3] = v[3];
    }
    __syncthreads();
    const int n = tid >> 3, ks = (tid & 7) * 8;
    u32x4 w;
    w.x = pk_bf16(tile[(ks + 0) * 65 + n], tile[(ks + 1) * 65 + n]);
    w.y = pk_bf16(tile[(ks + 2) * 65 + n], tile[(ks + 3) * 65 + n]);
    w.z = pk_bf16(tile[(ks + 4) * 65 + n], tile[(ks + 5) * 65 + n]);
    w.w = pk_bf16(tile[(ks + 6) * 65 + n], tile[(ks + 7) * 65 + n]);
    *(u32x4*)(dst + ((size_t)((n0 >> 8) * (K >> 6) + (k0 >> 6)) * 256 + (n0 & 255) + n) * 64 + ks) = w;
    __syncthreads();
}
DI void prep_weights(const Params& P, unsigned char* smem, int L, int vb, int nvb, int part  ) {
    float* tile = (float*)smem;
    unsigned char* ws = P.ws;
    constexpr int T_W1 = 16 * 88, T_W2 = 44 * 16, T_WIN = 16 * 60, T_SQ = 16 * 16, T_WP = 4 * 16;
    constexpr int E1 = 2 * T_W1, E2 = E1 + 2 * T_W2, E3 = E2 + T_WIN, E4 = E3 + T_SQ, E5 = E4 + T_SQ, E6 = E5 + T_WP;
    for (int idx = vb; idx < E6; idx += nvb) {
        const bool early = (idx < T_W1) || (idx >= E1 && idx < E1 + T_W2) || (idx >= E2 && idx < E3);
        if (part != 2 && early != (part == 0)) continue;
        if (idx < E1) { const int j = L * 2 + idx / T_W1, t = idx % T_W1; const int kt = t / 88, nt = t % 88;
            transpose_tile(P.ffn_w_in + (size_t)j * D * 2 * DFF, 2 * DFF, D, (bf16_t*)(ws + OFF_W1 + j * SZ_W1), 1, kt * 64, nt * 64, tile); }
        else if (idx < E2) { const int q = idx - E1; const int j = L * 2 + q / T_W2, t = q % T_W2; const int kt = t / 16, nt = t % 16;
            transpose_tile(P.ffn_w_out + (size_t)j * DFF * D, D, DFF, (bf16_t*)(ws + OFF_W2 + j * SZ_W2), 0, kt * 64, nt * 64, tile); }
        else if (idx < E3) { const int t = idx - E2; const int kt = t / 60, nt = t % 60;
            transpose_tile(P.mix_w_in + (size_t)L * D * 3592, 3592, D, (bf16_t*)(ws + OFF_WIN + L * SZ_WIN), 2, kt * 64, nt * 64, tile); }
        else if (idx < E4) { const int t = idx - E3; const int kt = t / 16, nt = t % 16;
            transpose_tile(P.mix_w_out + (size_t)L * D * D, D, D, (bf16_t*)(ws + OFF_WOUT + L * SZ_WSQ), 0, kt * 64, nt * 64, tile); }
        else if (idx < E5) { const int t = idx - E4; const int kt = t / 16, nt = t % 16;
            transpose_tile(P.ple_w_gate + (size_t)L * D * D, D, D, (bf16_t*)(ws + OFF_WG + L * SZ_WSQ), 0, kt * 64, nt * 64, tile); }
        else { const int t = idx - E5; const int kt = t / 16, nt = t % 16;
            transpose_tile(P.ple_w_proj + (size_t)L * PLE * D, D, PLE, (bf16_t*)(ws + OFF_WP + L * SZ_WP), 0, kt * 64, nt * 64, tile); }
    }
}
DI void phase_prep(const Params& P, unsigned char* smem) {
    unsigned char* ws = P.ws;
    prep_weights(P, smem, 0, blockIdx.x, gridDim.x, (gridDim.x <= 64) ? 2 : 0);
    if (gridDim.x <= 64) prep_weights(P, smem, 1, blockIdx.x, gridDim.x, 2);
    if (blockIdx.x == 0 && threadIdx.x == 0) *(unsigned*)(ws + OFF_BAR) = 0u;
    bf16_t* xb = (bf16_t*)(ws + OFF_XB);
    const size_t n4 = (size_t)NTOK * D / 4;
    const int tidp = tid_();
    for (size_t i = (size_t)blockIdx.x * NTHREADS + tidp; i < n4; i += (size_t)gridDim.x * NTHREADS) {
        const f32x4 v = *(const f32x4*)(P.x + i * 4);
        u32x2 w; w.x = pk_bf16(v[0], v[1]); w.y = pk_bf16(v[2], v[3]);
        *(u32x2*)(xb + i * 4) = w;
    }
}

DI void ln_rows(float* xr, bf16_t* xbr, const float* __restrict__ g, const float* __restrict__ b) {
    const int tidl = tid_();
    const int lane = tidl & 63, wid = tidl >> 6;
    f32x4 gv[4], bv[4];
#pragma unroll
    for (int i = 0; i < 4; ++i) { gv[i] = *(const f32x4*)(g + i * 256 + lane * 4); bv[i] = *(const f32x4*)(b + i * 256 + lane * 4); }
    for (int r0 = wid * 16; r0 < wid * 16 + 16; r0 += 4) {
        f32x4 v[4][4];
#pragma unroll
        for (int q = 0; q < 4; ++q)
#pragma unroll
            for (int i = 0; i < 4; ++i) v[q][i] = *(const f32x4*)(xr + (size_t)(r0 + q) * D + i * 256 + lane * 4);
        float s[4], qq[4];
#pragma unroll
        for (int q = 0; q < 4; ++q) {
            s[q] = 0.f;
#pragma unroll
            for (int i = 0; i < 4; ++i) s[q] += (v[q][i][0] + v[q][i][1]) + (v[q][i][2] + v[q][i][3]);
        }
#pragma unroll
        for (int o = 32; o >= 1; o >>= 1)
#pragma unroll
            for (int q = 0; q < 4; ++q) s[q] += __shfl_xor(s[q], o);
#pragma unroll
        for (int q = 0; q < 4; ++q) {
            const float mu = s[q] * (1.0f / D);
            qq[q] = 0.f;
#pragma unroll
            for (int i = 0; i < 4; ++i) { v[q][i] = v[q][i] - mu; qq[q] += (v[q][i][0] * v[q][i][0] + v[q][i][1] * v[q][i][1]) + (v[q][i][2] * v[q][i][2] + v[q][i][3] * v[q][i][3]); }
        }
#pragma unroll
        for (int o = 32; o >= 1; o >>= 1)
#pragma unroll
            for (int q = 0; q < 4; ++q) qq[q] += __shfl_xor(qq[q], o);
#pragma unroll
        for (int q = 0; q < 4; ++q) {
            const float rs = rsqrtf(qq[q] * (1.0f / D) + 1e-5f);
#pragma unroll
            for (int i = 0; i < 4; ++i) {
                const f32x4 o = v[q][i] * rs * gv[i] + bv[i];
                *(f32x4*)(xr + (size_t)(r0 + q) * D + i * 256 + lane * 4) = o;
                u32x2 w; w.x = pk_bf16(o[0], o[1]); w.y = pk_bf16(o[2], o[3]);
                *(u32x2*)(xbr + (size_t)(r0 + q) * D + i * 256 + lane * 4) = w;
            }
        }
    }
}

DI void run_jobs(const Params& P, int rb, int jj_lo, int jj_hi, unsigned char* smem) {
    float* xr = P.out + (size_t)rb * RB * D;
    bf16_t* xbr = (bf16_t*)(P.ws + OFF_XB) + (size_t)rb * RB * D;
    bf16_t* ureg = (bf16_t*)(P.ws + OFF_U) + (size_t)rb * RB * PJ;
    float* pps = (float*)ureg;
    bf16_t* pbf = (bf16_t*)((unsigned char*)ureg + (size_t)RB * D * 4);
    float* ab = (float*)(P.ws + OFF_AB) + (size_t)rb * RB * 8;
    for (int jj = jj_lo; jj < jj_hi; ++jj) {
        const int tid = tid_(), lane = tid & 63, wid = tid >> 6, wm = wid >> 2, wn = wid & 3;
        const int l = jj >> 3, j = jj & 7;
        if (j == 3) {
            const int hh = lane >> 4, cl = (lane & 15) * 8;
            const float* nw = P.gdn_norm_w + (size_t)l * 128 + cl;
            const f32x4 nw0 = *(const f32x4*)nw, nw1 = *(const f32x4*)(nw + 4);
            for (int r0 = wid * 16; r0 < wid * 16 + 16; r0 += 4) {
                u32x4 ov[4], zv[4];
#pragma unroll
                for (int q = 0; q < 4; ++q) {
                    ov[q] = *(const u32x4*)(xbr + (size_t)(r0 + q) * D + 256 + hh * 128 + cl);
                    zv[q] = *(const u32x4*)(ureg + (size_t)(r0 + q) * PJ + 2304 + hh * 128 + cl);
                }
#pragma unroll
                for (int q = 0; q < 4; ++q) {
                    float o[8], z[8];
#pragma unroll
                    for (int e = 0; e < 4; ++e) { o[2 * e] = bf_lo(ov[q][e]); o[2 * e + 1] = bf_hi(ov[q][e]); z[2 * e] = bf_lo(zv[q][e]); z[2 * e + 1] = bf_hi(zv[q][e]); }
                    float ss = 0.f;
#pragma unroll
                    for (int e = 0; e < 8; ++e) ss += o[e] * o[e];
                    ss += __shfl_xor(ss, 1); ss += __shfl_xor(ss, 2); ss += __shfl_xor(ss, 4); ss += __shfl_xor(ss, 8);
                    const float rs = rsqrtf(ss * (1.0f / 128.f) + 1e-6f);
                    float y[8];
#pragma unroll
                    for (int e = 0; e < 8; ++e) y[e] = o[e] * rs * ((e < 4) ? nw0[e & 3] : nw1[e & 3]) * (z[e] * sigmoidf_(z[e]));
                    u32x4 w; w.x = pk_bf16(y[0], y[1]); w.y = pk_bf16(y[2], y[3]); w.z = pk_bf16(y[4], y[5]); w.w = pk_bf16(y[6], y[7]);
                    *(u32x4*)(xbr + (size_t)(r0 + q) * D + 256 + hh * 128 + cl) = w;
                }
            }
            __syncthreads();
        }
        if (j == 6) {
            const float* pin = P.p + ((size_t)l * NTOK + (size_t)rb * RB) * PLE;
            for (int i = tid; i < RB * PLE / 4; i += NTHREADS) {
                const f32x4 v = *(const f32x4*)(pin + (size_t)i * 4);
                u32x2 w; w.x = pk_bf16(v[0], v[1]); w.y = pk_bf16(v[2], v[3]);
                *(u32x2*)(pbf + (size_t)i * 4) = w;
            }
            __syncthreads();
        }
        const bf16_t* A; const bf16_t* Bt; int lda, K, nt;
        if (j == 0 || j == 4) { A = xbr; lda = D; K = D; nt = 22; Bt = (const bf16_t*)(P.ws + OFF_W1 + (size_t)(l * 2 + (j >> 2)) * SZ_W1); }
        else if (j == 1 || j == 5) { A = ureg; lda = DFF; K = DFF; nt = 4; Bt = (const bf16_t*)(P.ws + OFF_W2 + (size_t)(l * 2 + (j >> 2)) * SZ_W2); }
        else if (j == 2) { A = xbr; lda = D; K = D; nt = 14; Bt = (const bf16_t*)(P.ws + OFF_WIN + (size_t)l * SZ_WIN); }
        else if (j == 3) { A = xbr; lda = D; K = D; nt = 4; Bt = (const bf16_t*)(P.ws + OFF_WOUT + (size_t)l * SZ_WSQ); }
        else if (j == 6) { A = pbf; lda = PLE; K = PLE; nt = 4; Bt = (const bf16_t*)(P.ws + OFF_WP + (size_t)l * SZ_WP); }
        else { A = xbr; lda = D; K = D; nt = 4; Bt = (const bf16_t*)(P.ws + OFF_WG + (size_t)l * SZ_WSQ); }
        const float* resid = (jj == 1) ? (P.x + (size_t)rb * RB * D) : xr;
        const float rsc = (j == 3) ? 1.0f : 0.5f;
        const float* bgate = P.ple_b_gate + (size_t)l * D;
        {
            const int nk = K >> 5, nk64 = K >> 6, ntw = nt >> 1, S = ntw * nk;
            const int drow = tid >> 2, kcs = (tid & 3) ^ ((4 - ((tid >> 4) & 3)) & 3);
            const unsigned va = (unsigned)((drow * lda + kcs * 8) * 2);
            const unsigned vb0 = (unsigned)((drow * 64 + kcs * 8) * 2), vb1 = vb0 + 16384u;
            const unsigned vb2 = vb0 + (unsigned)nk64 * 32768u, vb3 = vb2 + 16384u;
            const unsigned lbase = (unsigned)(size_t)smem + (unsigned)__builtin_amdgcn_readfirstlane(wid) * 1024u;
            const int r16 = lane & 15, q4 = lane >> 4;
            const int ko = ((q4 ^ ((4 - (r16 >> 2)) & 3)) << 4);
            const int fa = (wm * 64 + r16) * 64 + ko, fb = H5_A + (wn * 128 + r16) * 64 + ko;
            f32x4 acc[4][8];
#pragma unroll
            for (int i = 0; i < 4; ++i)
#pragma unroll
                for (int jq = 0; jq < 8; ++jq) acc[i][jq] = (f32x4){0.f, 0.f, 0.f, 0.f};
            const int toff = (int)((blockIdx.x & 7u) * (unsigned)ntw) >> 3;
            const int koff = (int)((blockIdx.x >> 3) * (unsigned)nk) >> 5;
            int kp = 0, sp = 0, tp = toff;
            const bf16_t* pbt = Bt + (size_t)toff * 512 * K;
#define ISSUE() do { const int ka_ = (kp + koff >= nk) ? kp + koff - nk : kp + koff; \
                glds16x5(A + ka_ * 32, pbt + (size_t)(ka_ >> 1) * 16384 + (ka_ & 1) * 32, va, vb0, vb1, vb2, vb3, lbase + (unsigned)sp * H5_STAGE); \
                ++kp; if (kp == nk) { kp = 0; ++tp; pbt += (size_t)512 * K; if (tp == ntw) { tp = 0; pbt = Bt; } } sp = (sp == 2) ? 0 : sp + 1; } while (0)
            ISSUE();
            ISSUE();
            ISSUE();
            asm volatile("s_waitcnt vmcnt(10)" ::: "memory");
            lds_barrier();
            int kt = 0, t = toff, st = 0;
            for (int s = 0; s < S; ++s) {
                const unsigned char* sc_ = smem + st * H5_STAGE;
                bf16x8 af[4], bfr[8];
#pragma unroll
                for (int mt = 0; mt < 4; ++mt) af[mt] = *(const bf16x8*)(sc_ + fa + mt * 1024);
#pragma unroll
                for (int n_ = 0; n_ < 8; ++n_) bfr[n_] = *(const bf16x8*)(sc_ + fb + n_ * 1024);
                if (kt == 0) {
#pragma unroll
                    for (int i = 0; i < 4; ++i)
#pragma unroll
                        for (int jq = 0; jq < 8; ++jq) acc[i][jq] = (f32x4){0.f, 0.f, 0.f, 0.f};
                }
#pragma unroll
                for (int mt = 0; mt < 4; ++mt)
#pragma unroll
                    for (int n_ = 0; n_ < 8; ++n_) acc[mt][n_] = __builtin_amdgcn_mfma_f32_16x16x32_bf16(bfr[n_], af[mt], acc[mt][n_], 0, 0, 0);
                if (s + 2 < S) asm volatile("s_waitcnt vmcnt(5)" ::: "memory");
                else asm volatile("s_waitcnt vmcnt(0)" ::: "memory");
                lds_barrier();
                if (s + 3 < S) ISSUE();
                st = (st == 2) ? 0 : st + 1;
                ++kt;
                if (kt == nk) {
                    kt = 0;
                    const int row0 = wm * 64 + r16;
                    const int col0 = t * 512 + wn * 128 + q4 * 4;
                    if (j == 0 || j == 4) {
                        bf16_t* hp = ureg + (size_t)row0 * DFF + t * 256 + wn * 64 + q4 * 16;
#pragma unroll
                        for (int mt = 0; mt < 4; ++mt) {
                            float hv[16];
#pragma unroll
                            for (int pr = 0; pr < 4; ++pr)
#pragma unroll
                                for (int r = 0; r < 4; ++r) { const float g = acc[mt][2 * pr][r]; hv[pr * 4 + r] = g * sigmoidf_(g) * acc[mt][2 * pr + 1][r]; }
                            u32x4 w0, w1;
                            w0.x = pk_bf16(hv[0], hv[1]); w0.y = pk_bf16(hv[2], hv[3]); w0.z = pk_bf16(hv[4], hv[5]); w0.w = pk_bf16(hv[6], hv[7]);
                            w1.x = pk_bf16(hv[8], hv[9]); w1.y = pk_bf16(hv[10], hv[11]); w1.z = pk_bf16(hv[12], hv[13]); w1.w = pk_bf16(hv[14], hv[15]);
                            *(u32x4*)(hp + (size_t)mt * 16 * DFF) = w0;
                            *(u32x4*)(hp + (size_t)mt * 16 * DFF + 8) = w1;
                        }
                    } else if (j == 1 || j == 5 || j == 3) {
#pragma unroll
                        for (int mt = 0; mt < 4; ++mt)
#pragma unroll
                            for (int nn = 0; nn < 8; ++nn) {
                                if ((nn & 3) == 0) asm volatile("" ::: "memory");
                                const size_t o = (size_t)(row0 + mt * 16) * D + col0 + nn * 16;
                                const f32x4 rv = *(const f32x4*)(resid + o);
                                *(f32x4*)(xr + o) = rv * ALPHA + acc[mt][nn] * rsc;
                            }
                    } else if (j == 2) {
#pragma unroll
                        for (int mt = 0; mt < 4; ++mt)
#pragma unroll
                            for (int nn = 0; nn < 8; ++nn) {
                                u32x2 w; w.x = pk_bf16(acc[mt][nn][0], acc[mt][nn][1]); w.y = pk_bf16(acc[mt][nn][2], acc[mt][nn][3]);
                                *(u32x2*)(ureg + (size_t)(row0 + mt * 16) * PJ + col0 + nn * 16) = w;
                            }
                    } else if (j == 6) {
#pragma unroll
                        for (int mt = 0; mt < 4; ++mt)
#pragma unroll
                            for (int nn = 0; nn < 8; ++nn) *(f32x4*)(pps + (size_t)(row0 + mt * 16) * D + col0 + nn * 16) = acc[mt][nn];
                    } else {
#pragma unroll
                        for (int mt = 0; mt < 4; ++mt)
#pragma unroll
                            for (int nn = 0; nn < 8; ++nn) {
                                if ((nn & 1) == 0) asm volatile("" ::: "memory");
                                const size_t o = (size_t)(row0 + mt * 16) * D + col0 + nn * 16;
                                const f32x4 bv = *(const f32x4*)(bgate + col0 + nn * 16);
                                const f32x4 pv = *(const f32x4*)(pps + o);
                                const f32x4 xv = *(const f32x4*)(xr + o);
                                f32x4 ov;
#pragma unroll
                                for (int r = 0; r < 4; ++r) ov[r] = xv[r] * ALPHA + sigmoidf_(acc[mt][nn][r] + bv[r]) * pv[r];
                                *(f32x4*)(xr + o) = ov;
                            }
                    }
                    ++t; if (t == ntw) t = 0;
                }
            }
#undef ISSUE
        }
        if (j == 2) {
            const int r16 = lane & 15, q4 = lane >> 4;
            const bf16_t* arow = xbr + (size_t)(wid * 16 + r16) * D + 8 * q4;
            const bf16_t* wrow = Bt + ((size_t)(14 * 16) * 256 + r16) * 64 + 8 * q4;
            f32x4 c = {0.f, 0.f, 0.f, 0.f};
#pragma unroll 8
            for (int kk = 0; kk < 32; ++kk) {
                const bf16x8 af = *(const bf16x8*)(arow + 32 * kk);
                const bf16x8 wf = *(const bf16x8*)(wrow + (size_t)(kk >> 1) * 16384 + (kk & 1) * 32);
                c = __builtin_amdgcn_mfma_f32_16x16x32_bf16(wf, af, c, 0, 0, 0);
            }
            if (q4 < 2) *(f32x4*)(ab + (size_t)(wid * 16 + r16) * 8 + q4 * 4) = c;
            __syncthreads();
            bf16_t* halo = (bf16_t*)(P.ws + OFF_HALO) + (size_t)rb * 3 * 1536;
            for (int i = tid; i < 3 * 192; i += NTHREADS) {
                const int rr = i / 192, cc = (i % 192) * 8;
                *(u32x4*)(halo + rr * 1536 + cc) = *(const u32x4*)(ureg + (size_t)(125 + rr) * PJ + 768 + cc);
            }
        }
        __syncthreads();
        if (j == 1 || j == 3 || j == 5 || j == 7) {
            const int li = l * 4 + ((j - 1) >> 1);
            ln_rows(xr, xbr, P.ln_g + (size_t)li * D, P.ln_b + (size_t)li * D);
            __syncthreads();
        }
    }
}

DI void phase_gdn_prep(const Params& P, int l) {
    const int tid = tid_(), lane = tid & 63, wid = tid >> 6;
    const int h = lane >> 4, cl = (lane & 15) * 8;
    const bf16_t* proj = (const bf16_t*)(P.ws + OFF_U);
    const bf16_t* halo = (const bf16_t*)(P.ws + OFF_HALO);
    bf16_t* gq = (bf16_t*)(P.ws + OFF_GQ);
    const float* cw = P.gdn_conv_w + (size_t)l * 4 * 1536;
    const float* ab = (const float*)(P.ws + OFF_AB);
    float* gb = (float*)(P.ws + OFF_GB);
    for (int rb = blockIdx.x; rb < NRB; rb += gridDim.x) {
#pragma unroll 2
        for (int itl = wid; itl < 96; itl += 8) {
            const int which = itl % 3, tgl = itl / 3;
            const int t0 = rb * RB + tgl * 4, s0 = t0 & (SEQ - 1);
            const int c = which * 512 + h * 128 + cl;
            f32x4 w[4][2];
#pragma unroll
            for (int i = 0; i < 4; ++i) { w[i][0] = *(const f32x4*)(cw + i * 1536 + c); w[i][1] = *(const f32x4*)(cw + i * 1536 + c + 4); }
            u32x4 x[7];
#pragma unroll
            for (int rr = 0; rr < 7; ++rr) {
                if (tgl == 0 && rr < 3) {
                    if (s0 > 0) x[rr] = *(const u32x4*)(halo + ((size_t)(rb - 1) * 3 + rr) * 1536 + c);
                    else x[rr] = (u32x4){0u, 0u, 0u, 0u};
                } else x[rr] = *(const u32x4*)(proj + (size_t)(t0 - 3 + rr) * PJ + 768 + c);
            }
#pragma unroll
            for (int tk = 0; tk < 4; ++tk) {
                float y[8];
#pragma unroll
                for (int e = 0; e < 8; ++e) y[e] = 0.f;
#pragma unroll
                for (int i = 0; i < 4; ++i)
#pragma unroll
                    for (int jj = 0; jj < 4; ++jj) {
                        y[2 * jj] += w[i][jj >> 1][(2 * jj) & 3] * bf_lo(x[tk + i][jj]);
                        y[2 * jj + 1] += w[i][jj >> 1][(2 * jj + 1) & 3] * bf_hi(x[tk + i][jj]);
                    }
                float ss = 0.f;
#pragma unroll
                for (int e = 0; e < 8; ++e) { y[e] = y[e] * sigmoidf_(y[e]); ss += y[e] * y[e]; }
                if (which < 2) {
                    ss += __shfl_xor(ss, 1); ss += __shfl_xor(ss, 2); ss += __shfl_xor(ss, 4); ss += __shfl_xor(ss, 8);
                    float sc = rsqrtf(ss + 1e-6f);
                    if (which == 0) sc *= 0.08838834764831845f;
#pragma unroll
                    for (int e = 0; e < 8; ++e) y[e] *= sc;
                }
                u32x4 o; o.x = pk_bf16(y[0], y[1]); o.y = pk_bf16(y[2], y[3]); o.z = pk_bf16(y[4], y[5]); o.w = pk_bf16(y[6], y[7]);
                *(u32x4*)(gq + (size_t)(t0 + tk) * 1536 + c) = o;
            }
        }
        {
            const int t = rb * RB + (tid >> 2), hh = tid & 3;
            const float a = ab[(size_t)t * 8 + hh], bl = ab[(size_t)t * 8 + 4 + hh];
            gb[(size_t)t * 8 + hh] = -__expf(P.gdn_a_log[l * 4 + hh]) * softplusf_(a + P.gdn_dt_bias[l * 4 + hh]);
            gb[(size_t)t * 8 + 4 + hh] = sigmoidf_(bl);
        }
    }
}

DI void sc_conv(const Params& P, int l, int vb, int nvb) {
    const bf16_t* proj = (const bf16_t*)(P.ws + OFF_U);
    bf16_t* mixed = (bf16_t*)(P.ws + OFF_XB);
    const float* w = P.sc_conv_w + (size_t)l * 3 * 256;
    const int tids = tid_();
    for (size_t it = (size_t)vb * NTHREADS + tids; it < (size_t)NTOK * 128; it += (size_t)nvb * NTHREADS) {
        const int t = (int)(it >> 7), c = (int)(it & 127) * 2;
        const int s = t & (SEQ - 1);
        float y0 = 0.f, y1 = 0.f;
#pragma unroll
        for (int i = 0; i < 3; ++i) {
            if (s - 2 + i >= 0) {
                const bf16_t* pr = proj + (size_t)(t - 2 + i) * PJ;
                const unsigned cu = *(const unsigned*)(pr + 3072 + c), hu = *(const unsigned*)(pr + 3328 + c);
                y0 += w[i * 256 + c] * (bf_lo(cu) * bf_lo(hu));
                y1 += w[i * 256 + c + 1] * (bf_hi(cu) * bf_hi(hu));
            }
        }
        const unsigned bu = *(const unsigned*)(proj + (size_t)t * PJ + 2816 + c);
        *(unsigned*)(mixed + (size_t)t * D + 768 + c) = pk_bf16(bf_lo(bu) * y0, bf_hi(bu) * y1);
    }
}

DI bf16x8 scale_frag(bf16x8 f, float s) {
    const u32x4 u = __builtin_bit_cast(u32x4, f);
    u32x4 o;
#pragma unroll
    for (int e = 0; e < 4; ++e) o[e] = pk_bf16(bf_lo(u[e]) * s, bf_hi(u[e]) * s);
    return __builtin_bit_cast(bf16x8, o);
}
typedef float f32x16 __attribute__((ext_vector_type(16)));
DI void sb_mfma(const Params& P, int vw, int nvw) {
    const bf16_t* proj = (const bf16_t*)(P.ws + OFF_U);
    bf16_t* mixed = (bf16_t*)(P.ws + OFF_XB);
    for (int it = vw; it < 4096; it += nvw) {
        const int lane = tid_() & 63, c32 = lane & 31, h2 = lane >> 5;
        const int qt = it & 255, h = (it >> 8) & 3, b = it >> 10;
        const size_t Tb = (size_t)b * SEQ, T0 = Tb + 32 * qt;
        bf16x8 qf[4];
#pragma unroll
        for (int ks = 0; ks < 4; ++ks) qf[ks] = scale_frag(*(const bf16x8*)(proj + (T0 + c32) * PJ + h * 64 + 16 * ks + 8 * h2), 0.125f);
        f32x16 O0, O1;
#pragma unroll
        for (int i = 0; i < 16; ++i) { O0[i] = 0.f; O1[i] = 0.f; }
        float carry = 0.f;
        for (int kt = qt; kt >= 0; --kt) {
            const bf16_t* kb = proj + (Tb + 32 * kt + c32) * PJ + 256 + h * 64 + 8 * h2;
            f32x16 S;
#pragma unroll
            for (int i = 0; i < 16; ++i) S[i] = 0.f;
#pragma unroll
            for (int ks = 0; ks < 4; ++ks) S = __builtin_amdgcn_mfma_f32_32x32x16_bf16(*(const bf16x8*)(kb + 16 * ks), qf[ks], S, 0, 0, 0);
            const bf16_t* vb = proj + (Tb + 32 * kt + 4 * h2) * PJ + 512 + h * 64 + c32;
            bf16x8 vf[2][2];
#pragma unroll
            for (int s2 = 0; s2 < 2; ++s2)
#pragma unroll
                for (int nt = 0; nt < 2; ++nt)
#pragma unroll
                    for (int j = 0; j < 8; ++j) vf[s2][nt][j] = (short)vb[(size_t)(16 * s2 + 8 * (j >> 2) + (j & 3)) * PJ + 32 * nt];
            const bool diag = (kt == qt);
            float ls[16], lb[16];
#pragma unroll
            for (int i = 0; i < 16; ++i) {
                const float z = S[i];
                const float sp = fmaxf(z, 0.f) + __logf(1.0f + __expf(-fabsf(z)));
                const int sl = 8 * (i >> 2) + 4 * h2 + (i & 3);
                const bool valid = !diag || (sl < c32);
                lb[i] = valid ? (z - sp) : -1e30f;
                ls[i] = valid ? -sp : 0.f;
            }
            float qs[4], pq[4], ps[4];
#pragma unroll
            for (int g = 0; g < 4; ++g) { qs[g] = (ls[4 * g] + ls[4 * g + 1]) + (ls[4 * g + 2] + ls[4 * g + 3]); pq[g] = __shfl_xor(qs[g], 32); ps[g] = qs[g] + pq[g]; }
            float R[4];
            R[3] = 0.f; R[2] = ps[3]; R[1] = R[2] + ps[2]; R[0] = R[1] + ps[1];
            float att[16];
#pragma unroll
            for (int g = 0; g < 4; ++g) {
                const float suf = carry + R[g] + ((h2 == 0) ? pq[g] : 0.f);
                const float l3 = suf, l2 = l3 + ls[4 * g + 3], l1 = l2 + ls[4 * g + 2], l0 = l1 + ls[4 * g + 1];
                att[4 * g + 3] = __expf(lb[4 * g + 3] + l3);
                att[4 * g + 2] = __expf(lb[4 * g + 2] + l2);
                att[4 * g + 1] = __expf(lb[4 * g + 1] + l1);
                att[4 * g + 0] = __expf(lb[4 * g + 0] + l0);
            }
            carry += R[0] + ps[0];
            bf16x8 af[2];
#pragma unroll
            for (int s2 = 0; s2 < 2; ++s2) {
                u32x4 u;
                u.x = pk_bf16(att[8 * s2 + 0], att[8 * s2 + 1]); u.y = pk_bf16(att[8 * s2 + 2], att[8 * s2 + 3]);
                u.z = pk_bf16(att[8 * s2 + 4], att[8 * s2 + 5]); u.w = pk_bf16(att[8 * s2 + 6], att[8 * s2 + 7]);
                af[s2] = __builtin_bit_cast(bf16x8, u);
            }
#pragma unroll
            for (int s2 = 0; s2 < 2; ++s2) {
                O0 = __builtin_amdgcn_mfma_f32_32x32x16_bf16(af[s2], vf[s2][0], O0, 0, 0, 0);
                O1 = __builtin_amdgcn_mfma_f32_32x32x16_bf16(af[s2], vf[s2][1], O1, 0, 0, 0);
            }
            if (__all(carry < -104.f)) break;
        }
        bf16_t* op = mixed + (T0 + 4 * h2) * D + h * 64 + c32;
#pragma unroll
        for (int i = 0; i < 16; ++i) {
            const int tl = (i & 3) + 8 * (i >> 2);
            op[(size_t)tl * D] = (bf16_t)(pk_bf16(O0[i], 0.f) & 0xffffu);
            op[(size_t)tl * D + 32] = (bf16_t)(pk_bf16(O1[i], 0.f) & 0xffffu);
        }
    }
}

DI void wsync() { asm volatile("s_waitcnt lgkmcnt(0)" ::: "memory"); }
DI void store_T_row(bf16_t* XT, const bf16x8 (&f)[4], float sc, int m, int r16, int q4) {
#pragma unroll
    for (int kk = 0; kk < 4; ++kk) {
        const u32x4 u = __builtin_bit_cast(u32x4, f[kk]);
#pragma unroll
        for (int e = 0; e < 4; ++e) {
            const unsigned w = pk_bf16(bf_lo(u[e]) * sc, bf_hi(u[e]) * sc);
            const int c = 32 * kk + 8 * q4 + 2 * e;
            XT[c * 72 + 16 * m + r16] = (bf16_t)(w & 0xffffu);
            XT[(c + 1) * 72 + 16 * m + r16] = (bf16_t)(w >> 16);
        }
    }
}
DI u32x2 pack4(const f32x4 a) { u32x2 w; w.x = pk_bf16(a[0], a[1]); w.y = pk_bf16(a[2], a[3]); return w; }

DI void phase_gdn_chunk(const Params& P, unsigned char* smem) {
    const int tid0 = tid_(), wid = tid0 >> 6;
    unsigned char* wl = smem + wid * CHUNK_WAVE_LDS;
    float* X = (float*)wl;
    bf16_t* XT = (bf16_t*)wl;
    float* gcs = (float*)(wl + 18432);
    float* bts = gcs + 64;
    bf16_t* gq = (bf16_t*)(P.ws + OFF_GQ);
    bf16_t* proj = (bf16_t*)(P.ws + OFF_U);
    const float* gb = (const float*)(P.ws + OFF_GB);
    float* glw = (float*)(P.ws + OFF_GL);
    for (int it = blockIdx.x * 8 + wid; it < 2048; it += gridDim.x * 8) {
        const int lane = tid_() & 63, r16 = lane & 15, q4 = lane >> 4;
        const int h = it & 3, c = (it >> 2) & 127, b = it >> 9;
        const size_t t0 = (size_t)b * SEQ + (size_t)c * 64;
        float gc = gb[(t0 + lane) * 8 + h];
        const float bt = gb[(t0 + lane) * 8 + 4 + h];
#pragma unroll
        for (int o = 1; o < 64; o <<= 1) { const float v = __shfl_up(gc, o); if (lane >= o) gc += v; }
        gcs[lane] = gc; bts[lane] = bt;
        const float gtot = __shfl(gc, 63);
        if (lane == 0) glw[it] = __expf(gtot);
        wsync();
        bf16x8 kf[4][4];
        {
            const bf16_t* kb = gq + t0 * 1536 + 512 + h * 128 + (size_t)r16 * 1536 + 8 * q4;
#pragma unroll
            for (int m = 0; m < 4; ++m)
#pragma unroll
                for (int kk = 0; kk < 4; ++kk) kf[m][kk] = *(const bf16x8*)(kb + (size_t)m * 16 * 1536 + 32 * kk);
        }
#pragma unroll
        for (int mi = 0; mi < 4; ++mi)
#pragma unroll
            for (int mj = 0; mj <= mi; ++mj) {
                f32x4 a = {0.f, 0.f, 0.f, 0.f};
#pragma unroll
                for (int kk = 0; kk < 4; ++kk) a = __builtin_amdgcn_mfma_f32_16x16x32_bf16(kf[mi][kk], kf[mj][kk], a, 0, 0, 0);
                const int j = 16 * mj + r16;
                const float gj = gcs[j];
                const f32x4 gi = *(const f32x4*)(gcs + 16 * mi + 4 * q4);
                const f32x4 bi = *(const f32x4*)(bts + 16 * mi + 4 * q4);
#pragma unroll
                for (int r = 0; r < 4; ++r) {
                    const int i = 16 * mi + 4 * q4 + r;
                    X[i * 68 + j] = (i > j) ? bi[r] * a[r] * __expf(fminf(gi[r] - gj, 0.f)) : 0.f;
                }
            }
        {
            bf16_t* qb = gq + t0 * 1536 + h * 128 + (size_t)r16 * 1536 + 8 * q4;
#pragma unroll
            for (int mi = 0; mi < 4; ++mi) {
                bf16x8 qf[4];
#pragma unroll
                for (int kk = 0; kk < 4; ++kk) qf[kk] = *(const bf16x8*)(qb + (size_t)mi * 16 * 1536 + 32 * kk);
                const int i = 16 * mi + r16;
                const float gi = gcs[i];
                bf16_t* qkrow = proj + (t0 + i) * PJ + 1792 + h * 128 + 4 * q4;
#pragma unroll
                for (int mj = 0; mj < 4; ++mj) {
                    u32x2 w = {0u, 0u};
                    if (mj <= mi) {
                        f32x4 a = {0.f, 0.f, 0.f, 0.f};
#pragma unroll
                        for (int kk = 0; kk < 4; ++kk) a = __builtin_amdgcn_mfma_f32_16x16x32_bf16(kf[mj][kk], qf[kk], a, 0, 0, 0);
                        const f32x4 gj = *(const f32x4*)(gcs + 16 * mj + 4 * q4);
                        f32x4 v;
#pragma unroll
                        for (int r = 0; r < 4; ++r) { const int j = 16 * mj + 4 * q4 + r; v[r] = (j <= i) ? a[r] * __expf(fminf(gi - gj[r], 0.f)) : 0.f; }
                        w = pack4(v);
                    }
                    *(u32x2*)(qkrow + 16 * mj) = w;
                }
                const float s = __expf(gi);
#pragma unroll
                for (int kk = 0; kk < 4; ++kk) *(bf16x8*)(qb + (size_t)mi * 16 * 1536 + 32 * kk) = scale_frag(qf[kk], s);
            }
        }
        wsync();
        {
            float Tc[64];
#pragma unroll
            for (int i = 0; i < 64; ++i) Tc[i] = 0.f;
            Tc[0] = (lane == 0) ? 1.f : 0.f;
#pragma unroll
            for (int i = 1; i < 64; ++i) {
                float a0 = 0.f, a1 = 0.f, a2 = 0.f, a3 = 0.f;
#pragma unroll
                for (int jj = 0; jj < (i + 3) / 4; ++jj) {
                    const f32x4 m4 = *(const f32x4*)(X + i * 68 + 4 * jj);
                    a0 += m4[0] * Tc[4 * jj]; a1 += m4[1] * Tc[4 * jj + 1]; a2 += m4[2] * Tc[4 * jj + 2]; a3 += m4[3] * Tc[4 * jj + 3];
                }
                Tc[i] = ((lane == i) ? 1.f : 0.f) - ((a0 + a1) + (a2 + a3));
            }
            wsync();
#pragma unroll
            for (int i = 0; i < 64; ++i) X[i * 68 + lane] = Tc[i];
            wsync();
        }
        {
            const bf16_t* kb = gq + t0 * 1536 + 512 + h * 128 + (size_t)r16 * 1536 + 8 * q4;
#pragma unroll
            for (int m = 0; m < 4; ++m)
#pragma unroll
                for (int kk = 0; kk < 4; ++kk) kf[m][kk] = *(const bf16x8*)(kb + (size_t)m * 16 * 1536 + 32 * kk);
        }
        bf16x8 Tf[4][2];
#pragma unroll
        for (int mi = 0; mi < 4; ++mi)
#pragma unroll
            for (int ks = 0; ks < 2; ++ks) {
                const float* xp = X + (16 * mi + r16) * 68 + 32 * ks + 8 * q4;
                const f32x4 a = *(const f32x4*)xp, bb = *(const f32x4*)(xp + 4);
                u32x4 u; u.x = pk_bf16(a[0], a[1]); u.y = pk_bf16(a[2], a[3]); u.z = pk_bf16(bb[0], bb[1]); u.w = pk_bf16(bb[2], bb[3]);
                Tf[mi][ks] = __builtin_bit_cast(bf16x8, u);
            }
        float sk[4];
#pragma unroll
        for (int m = 0; m < 4; ++m) sk[m] = bts[16 * m + r16] * __expf(gcs[16 * m + r16]);
        wsync();
#pragma unroll
        for (int m = 0; m < 4; ++m) store_T_row(XT, kf[m], sk[m], m, r16, q4);
        wsync();
#pragma unroll
        for (int md = 0; md < 8; ++md) {
            bf16x8 af[2];
#pragma unroll
            for (int ks = 0; ks < 2; ++ks) af[ks] = *(const bf16x8*)(XT + (16 * md + r16) * 72 + 32 * ks + 8 * q4);
#pragma unroll
            for (int mi = 0; mi < 4; ++mi) {
                f32x4 a = {0.f, 0.f, 0.f, 0.f};
#pragma unroll
                for (int ks = 0; ks < 2; ++ks) a = __builtin_amdgcn_mfma_f32_16x16x32_bf16(af[ks], Tf[mi][ks], a, 0, 0, 0);
                *(u32x2*)(proj + (t0 + 16 * mi + r16) * PJ + 768 + h * 128 + 16 * md + 4 * q4) = pack4(a);
            }
        }
        wsync();
#pragma unroll
        for (int m = 0; m < 4; ++m) sk[m] = __expf(gtot - gcs[16 * m + r16]);
#pragma unroll
        for (int m = 0; m < 4; ++m) store_T_row(XT, kf[m], sk[m], m, r16, q4);
        wsync();
#pragma unroll
        for (int e = 0; e < 16; ++e) {
            const int q = lane + 64 * e, d = q >> 3, jc = (q & 7) * 8;
            const u32x4 v = *(const u32x4*)(XT + d * 72 + jc);
            *(u32x4*)(proj + (t0 + (d >> 1)) * PJ + 1280 + h * 128 + (d & 1) * 64 + jc) = v;
        }
        wsync();
        {
            const bf16_t* vb = gq + t0 * 1536 + 1024 + h * 128 + (size_t)r16 * 1536 + 8 * q4;
#pragma unroll
            for (int m = 0; m < 4; ++m) {
                bf16x8 vf[4];
#pragma unroll
                for (int kk = 0; kk < 4; ++kk) vf[kk] = *(const bf16x8*)(vb + (size_t)m * 16 * 1536 + 32 * kk);
                store_T_row(XT, vf, bts[16 * m + r16], m, r16, q4);
            }
        }
        wsync();
#pragma unroll
        for (int nt = 0; nt < 8; ++nt) {
            bf16x8 bfv[2];
#pragma unroll
            for (int ks = 0; ks < 2; ++ks) bfv[ks] = *(const bf16x8*)(XT + (16 * nt + r16) * 72 + 32 * ks + 8 * q4);
            const int n = 16 * nt + r16;
#pragma unroll
            for (int mi = 0; mi < 4; ++mi) {
                f32x4 a = {0.f, 0.f, 0.f, 0.f};
#pragma unroll
                for (int ks = 0; ks < 2; ++ks) a = __builtin_amdgcn_mfma_f32_16x16x32_bf16(Tf[mi][ks], bfv[ks], a, 0, 0, 0);
                *(u32x2*)(gq + (t0 + (n >> 1)) * 1536 + 1024 + h * 128 + (n & 1) * 64 + 16 * mi + 4 * q4) = pack4(a);
            }
        }
        wsync();
    }
}

constexpr int SC_W = 0, SC_QD = 16384, SC_QK = 32768, SC_KD = 40960, SC_UT = 57344, SC_STAGE = 61440;
constexpr int SC_ST = 2 * SC_STAGE, SC_VT = SC_ST + 32 * 136 * 2, SC_GL = SC_VT + 32 * 72 * 2;
DI void gdn_scan(const Params& P, int item, unsigned char* smem) {
    const int tid = tid_(), lane = tid & 63, wid = tid >> 6, r16 = lane & 15, q4 = lane >> 4;
    const int ns = (item >> 3) & 3, bh = ((item & 7) << 1) | (item >> 5), h = bh & 3, b = bh >> 2;
    const int mi = wid & 3, nt = wid >> 2, md = wid;
    bf16_t* ST = (bf16_t*)(smem + SC_ST);
    bf16_t* VT = (bf16_t*)(smem + SC_VT);
    float* gls = (float*)(smem + SC_GL);
    const bf16_t* proj = (const bf16_t*)(P.ws + OFF_U);
    const bf16_t* gq = (const bf16_t*)(P.ws + OFF_GQ);
    const float* glw = (const float*)(P.ws + OFF_GL);
    bf16_t* mixed = (bf16_t*)(P.ws + OFF_XB);
    for (int i = tid; i < 32 * 136 / 2; i += NTHREADS) ((unsigned*)ST)[i] = 0u;
    if (tid < 128) gls[tid] = glw[((b * 128 + tid) << 2) + h];
    const size_t tb = (size_t)b * SEQ;
    const int r4 = tid >> 4, k16 = (tid & 15) ^ (r4 & 15), k8 = (tid & 7) ^ (r4 & 7);
    const bf16_t* pw = proj + (tb + r4) * PJ + 768 + h * 128 + k16 * 8;
    const bf16_t* pq = gq + (tb + r4) * 1536 + h * 128 + k16 * 8;
    const bf16_t* pk = proj + (tb + (tid >> 3)) * PJ + 1792 + h * 128 + k8 * 8;
    const bf16_t* pd = proj + (tb + r4) * PJ + 1280 + h * 128 + ((tid >> 3) & 1) * 64 + k8 * 8;
    const int nu = ns * 32 + ((tid >> 3) & 31);
    const bf16_t* pu = gq + (tb + (nu >> 1)) * 1536 + 1024 + h * 128 + (nu & 1) * 64 + (tid & 7) * 8;
    const unsigned lbase = (unsigned)(size_t)smem + (unsigned)__builtin_amdgcn_readfirstlane(wid) * 1024u;
    const bool uwave = (__builtin_amdgcn_readfirstlane(wid) < 4);
#define SC_ISSUE(c_) do { const unsigned dst_ = lbase + (unsigned)((c_) & 1) * SC_STAGE; const size_t o1_ = (size_t)(c_) * 64 * PJ, o2_ = (size_t)(c_) * 64 * 1536; \
        glds16(pw + o1_, dst_ + SC_W); glds16(pw + o1_ + (size_t)32 * PJ, dst_ + SC_W + 8192u); \
        glds16(pq + o2_, dst_ + SC_QD); glds16(pq + o2_ + (size_t)32 * 1536, dst_ + SC_QD + 8192u); \
        glds16(pk + o1_, dst_ + SC_QK); \
        glds16(pd + o1_, dst_ + SC_KD); glds16(pd + o1_ + (size_t)32 * PJ, dst_ + SC_KD + 8192u); \
        if (uwave) glds16(pu + o2_, dst_ + SC_UT); } while (0)
    const int ow = (16 * mi + r16) * 256, oqk = SC_QK + (16 * mi + r16) * 128, okd = SC_KD + (16 * md + r16) * 128;
    const int out = SC_UT + (16 * nt + r16) * 128 + (16 * mi + 4 * q4) * 2;
    const int x8 = r16 >> 1;
    f32x4 accS[2] = {{0.f, 0.f, 0.f, 0.f}, {0.f, 0.f, 0.f, 0.f}};
    SC_ISSUE(0);
    asm volatile("s_waitcnt vmcnt(0)" ::: "memory");
    __syncthreads();
    for (int c = 0; c < 128; ++c) {
        if (c + 1 < 128) SC_ISSUE(c + 1);
        const unsigned char* sg = smem + (c & 1) * SC_STAGE;
        f32x4 aP = {0.f, 0.f, 0.f, 0.f}, aO = {0.f, 0.f, 0.f, 0.f};
#pragma unroll
        for (int kk = 0; kk < 4; ++kk) {
            const bf16x8 sf = *(const bf16x8*)(ST + (16 * nt + r16) * 136 + 32 * kk + 8 * q4);
            const int co = (((4 * kk + q4) ^ r16) << 4);
            const bf16x8 wf = *(const bf16x8*)(sg + SC_W + ow + co);
            const bf16x8 qd = *(const bf16x8*)(sg + SC_QD + ow + co);
            aP = __builtin_amdgcn_mfma_f32_16x16x32_bf16(wf, sf, aP, 0, 0, 0);
            aO = __builtin_amdgcn_mfma_f32_16x16x32_bf16(qd, sf, aO, 0, 0, 0);
        }
        {
            const u32x2 uu = *(const u32x2*)(sg + out);
            f32x4 vn;
            vn[0] = bf_lo(uu.x) - aP[0]; vn[1] = bf_hi(uu.x) - aP[1]; vn[2] = bf_lo(uu.y) - aP[2]; vn[3] = bf_hi(uu.y) - aP[3];
            *(u32x2*)(VT + (16 * nt + r16) * 72 + 16 * mi + 4 * q4) = pack4(vn);
        }
        lds_barrier();
#pragma unroll
        for (int ks = 0; ks < 2; ++ks) {
            const bf16x8 vf = *(const bf16x8*)(VT + (16 * nt + r16) * 72 + 32 * ks + 8 * q4);
            const bf16x8 qk = *(const bf16x8*)(sg + oqk + (((4 * ks + q4) ^ x8) << 4));
            aO = __builtin_amdgcn_mfma_f32_16x16x32_bf16(qk, vf, aO, 0, 0, 0);
        }
        {
            bf16_t* op = mixed + (tb + (size_t)c * 64 + 16 * mi + 4 * q4) * D + 256 + h * 128 + ns * 32 + 16 * nt + r16;
#pragma unroll
            for (int r = 0; r < 4; ++r) op[(size_t)r * D] = (bf16_t)(pk_bf16(aO[r], 0.f) & 0xffffu);
        }
        const float gl = gls[c];
        bf16x8 kd[2];
#pragma unroll
        for (int ks = 0; ks < 2; ++ks) kd[ks] = *(const bf16x8*)(sg + okd + (((4 * ks + q4) ^ x8) << 4));
#pragma unroll
        for (int n2 = 0; n2 < 2; ++n2) {
            accS[n2] = accS[n2] * gl;
#pragma unroll
            for (int ks = 0; ks < 2; ++ks) {
                const bf16x8 vf = *(const bf16x8*)(VT + (16 * n2 + r16) * 72 + 32 * ks + 8 * q4);
                accS[n2] = __builtin_amdgcn_mfma_f32_16x16x32_bf16(kd[ks], vf, accS[n2], 0, 0, 0);
            }
            *(u32x2*)(ST + (16 * n2 + r16) * 136 + 16 * md + 4 * q4) = pack4(accS[n2]);
        }
        asm volatile("s_waitcnt vmcnt(0)" ::: "memory");
        lds_barrier();
    }
#undef SC_ISSUE
    __syncthreads();
}

DI void phase_mix(const Params& P, int l, unsigned char* smem) {
    const int G = gridDim.x;
    for (int it = blockIdx.x; it < 64; it += G) {
        gdn_scan(P, it, smem);
#if PROBE_SCAN2
        __syncthreads();
        gdn_scan(P, it, smem);
#endif
    }
    const int nvb = (G > 64) ? (G - 64) : G;
    const int vb = (G > 64) ? ((int)blockIdx.x - 64) : (int)blockIdx.x;
    if (vb >= 0) {
        sb_mfma(P, vb * 8 + (tid_() >> 6), nvb * 8); sc_conv(P, l, vb, nvb);
#if PROBE_SBSC2
        sb_mfma(P, vb * 8 + (tid_() >> 6), nvb * 8); sc_conv(P, l, vb, nvb);
#endif
        if (l == 0 && G > 64) { __syncthreads(); prep_weights(P, smem, 0, vb, nvb, 1); prep_weights(P, smem, 1, vb, nvb, 2); }
    }
}

DI void grid_bar(unsigned* cnt, unsigned& gen) {
    __syncthreads();
    gen += gridDim.x;
    if (threadIdx.x == 0) {
        __builtin_amdgcn_fence(__ATOMIC_RELEASE, "agent");
        __hip_atomic_fetch_add(cnt, 1u, __ATOMIC_RELAXED, __HIP_MEMORY_SCOPE_AGENT);
        while (__hip_atomic_load(cnt, __ATOMIC_RELAXED, __HIP_MEMORY_SCOPE_AGENT) < gen) __builtin_amdgcn_s_sleep(2);
        __builtin_amdgcn_fence(__ATOMIC_ACQUIRE, "agent");
    }
    __syncthreads();
}

constexpr int NPH = 8;
__global__ void __launch_bounds__(NTHREADS) mega(Params PK) {
    extern __shared__ __attribute__((aligned(16))) unsigned char smem[];
    cg::grid_group grid = cg::this_grid();
    unsigned bar_gen = 0u;
    for (int ph = PK.ph_lo; ph < PK.ph_hi; ++ph) {
        const Params& P = PK;
        if (ph == 0) phase_prep(P, smem);
        else if (ph == 1 || ph == 4 || ph == 7) {
            const int lo = (ph == 1) ? 0 : (ph == 4 ? 3 : 11), hi = (ph == 1) ? 3 : (ph == 4 ? 11 : 16);
            for (int rb = blockIdx.x; rb < NRB; rb += gridDim.x) run_jobs(P, rb, lo, hi, smem);
        }
        else if (ph == 2 || ph == 5) {
            phase_gdn_prep(P, ph == 2 ? 0 : 1);
            __syncthreads();
            phase_gdn_chunk(P, smem);
        }
        else phase_mix(P, ph == 3 ? 0 : 1, smem);
        if (ph + 1 < PK.ph_hi) { if (ph == 0) grid.sync(); else grid_bar((unsigned*)(PK.ws + OFF_BAR), bar_gen); }
    }
}

extern "C" void kernel_launch(void* const* d_in, const int* in_sizes, int n_in, void* d_out, int out_size, void* d_ws, size_t ws_size, hipStream_t stream) {
    static int grid_blocks = 0;
    if (grid_blocks == 0) {
        if (n_in != 16 || out_size != NTOK * D || ws_size < WS_END) {
            fprintf(stderr, "kernel_launch: unexpected shapes / workspace (n_in %d out %d ws %zu need %zu)\n", n_in, out_size, ws_size, (size_t)WS_END);
            grid_blocks = -1; return;
        }
        int dev = 0, cus = 0, per_cu = 0;
        hipGetDevice(&dev);
        hipDeviceGetAttribute(&cus, hipDeviceAttributeMultiprocessorCount, dev);
        if (hipFuncSetAttribute((const void*)mega, hipFuncAttributeMaxDynamicSharedMemorySize, SMEM_BYTES) != hipSuccess) { fprintf(stderr, "hipFuncSetAttribute failed\n"); grid_blocks = -1; return; }
        hipOccupancyMaxActiveBlocksPerMultiprocessor(&per_cu, (const void*)mega, NTHREADS, SMEM_BYTES);
        if (per_cu < 1) per_cu = 1;
        grid_blocks = cus * per_cu;
        if (grid_blocks > NRB) grid_blocks = NRB;
    }
    if (grid_blocks < 0) return;
    Params P{};
    P.x = (const float*)d_in[0]; P.p = (const float*)d_in[1]; P.ln_g = (const float*)d_in[2]; P.ln_b = (const float*)d_in[3];
    P.ffn_w_in = (const float*)d_in[4]; P.ffn_w_out = (const float*)d_in[5]; P.mix_w_in = (const float*)d_in[6]; P.gdn_conv_w = (const float*)d_in[7];
    P.gdn_a_log = (const float*)d_in[8]; P.gdn_dt_bias = (const float*)d_in[9]; P.gdn_norm_w = (const float*)d_in[10]; P.sc_conv_w = (const float*)d_in[11];
    P.mix_w_out = (const float*)d_in[12]; P.ple_w_proj = (const float*)d_in[13]; P.ple_w_gate = (const float*)d_in[14]; P.ple_b_gate = (const float*)d_in[15];
    P.out = (float*)d_out; P.ws = (unsigned char*)d_ws;
#if N_LAUNCH_MODE == 1
    P.ph_lo = 0; P.ph_hi = NPH;
    void* args[] = {&P};
    hipError_t e = hipLaunchCooperativeKernel((const void*)mega, dim3(grid_blocks), dim3(NTHREADS), args, SMEM_BYTES, stream);
    if (e != hipSuccess) fprintf(stderr, "cooperative launch failed: %s (grid %d)\n", hipGetErrorString(e), grid_blocks);
#else
    for (int ph = 0; ph < NPH; ++ph) {
        P.ph_lo = ph; P.ph_hi = ph + 1;
        void* args[] = {&P};
        hipError_t e = hipLaunchCooperativeKernel((const void*)mega, dim3(grid_blocks), dim3(NTHREADS), args, SMEM_BYTES, stream);
        if (e != hipSuccess) fprintf(stderr, "launch failed: %s (grid %d)\n", hipGetErrorString(e), grid_blocks);
    }
#endif
}
```

```cpp
#include <hip/hip_runtime.h>
#include <hip/hip_cooperative_groups.h>
#include <cstdio>
#include <cstdint>
namespace cg = cooperative_groups;

#define DI __device__ __forceinline__
typedef unsigned short bf16_t;
typedef short bf16x8 __attribute__((ext_vector_type(8)));
typedef float f32x4 __attribute__((ext_vector_type(4)));
typedef unsigned u32x4 __attribute__((ext_vector_type(4)));
typedef unsigned u32x2 __attribute__((ext_vector_type(2)));
typedef __bf16 bf2_t __attribute__((ext_vector_type(2)));
typedef float f2_t __attribute__((ext_vector_type(2)));

#ifndef PROBE_GEMM2
#define PROBE_GEMM2 0
#endif
#ifndef PROBE_MIX2
#define PROBE_MIX2 0
#endif
#ifndef PROBE_PREP2
#define PROBE_PREP2 0
#endif
#ifndef PROBE_GPREP2
#define PROBE_GPREP2 0
#endif
#ifndef PROBE_SCAN2
#define PROBE_SCAN2 0
#endif
#ifndef PROBE_SBSC2
#define PROBE_SBSC2 0
#endif
#ifndef PROBE_TILES2
#define PROBE_TILES2 0
#endif
#ifndef N_LAUNCH_MODE
#define N_LAUNCH_MODE 1
#endif

constexpr int D = 1024, BATCH = 4, SEQ = 8192, NTOK = BATCH * SEQ, DEPTH = 2;
constexpr int DFF = 2816, PLE = 256;
constexpr int PJ = 3584;
constexpr int PJN = 3840;
constexpr int RB = 128;
constexpr int NRB = NTOK / RB;
constexpr float ALPHA = 1.41421356237f;
constexpr int NTHREADS = 512;

constexpr size_t SZ_W1 = (size_t)2 * DFF * D * 2;
constexpr size_t SZ_W2 = (size_t)D * DFF * 2;
constexpr size_t SZ_WIN = (size_t)PJN * D * 2;
constexpr size_t SZ_WSQ = (size_t)D * D * 2;
constexpr size_t SZ_WP = (size_t)D * PLE * 2;
constexpr size_t OFF_W1 = 0;
constexpr size_t OFF_W2 = OFF_W1 + 4 * SZ_W1;
constexpr size_t OFF_WIN = OFF_W2 + 4 * SZ_W2;
constexpr size_t OFF_WOUT = OFF_WIN + 2 * SZ_WIN;
constexpr size_t OFF_WG = OFF_WOUT + 2 * SZ_WSQ;
constexpr size_t OFF_WP = OFF_WG + 2 * SZ_WSQ;
constexpr size_t OFF_XB = OFF_WP + 2 * SZ_WP;
constexpr size_t OFF_U = OFF_XB + (size_t)NTOK * D * 2;
constexpr size_t OFF_GQ = OFF_U + (size_t)NTOK * PJ * 2;
constexpr size_t OFF_AB = OFF_GQ + (size_t)NTOK * 1536 * 2;
constexpr size_t OFF_GB = OFF_AB + (size_t)NTOK * 8 * 4;
constexpr size_t OFF_GL = OFF_GB + (size_t)NTOK * 8 * 4;
constexpr size_t OFF_BAR = OFF_GL + 2048 * 4;
constexpr size_t OFF_HALO = OFF_BAR + 128;
constexpr size_t OFF_ST = OFF_HALO + (size_t)NRB * 3 * 1536 * 2;
constexpr size_t WS_END = OFF_ST + (size_t)NTOK * 2 * 4;

struct Params {
    const float *x, *p, *ln_g, *ln_b, *ffn_w_in, *ffn_w_out, *mix_w_in, *gdn_conv_w, *gdn_a_log, *gdn_dt_bias, *gdn_norm_w, *sc_conv_w,
        *mix_w_out, *ple_w_proj, *ple_w_gate, *ple_b_gate;
    float* out;
    unsigned char* ws;
    int ph_lo, ph_hi;
};

DI unsigned pk_bf16(float a, float b) { bf2_t v = __builtin_convertvector((f2_t){a, b}, bf2_t); return __builtin_bit_cast(unsigned, v); }
DI float bf_lo(unsigned u) { return __uint_as_float(u << 16); }
DI float bf_hi(unsigned u) { return __uint_as_float(u & 0xffff0000u); }
DI float bf2f(bf16_t h) { return __uint_as_float(((unsigned)h) << 16); }
DI float sigmoidf_(float x) { return __builtin_amdgcn_rcpf(1.0f + __expf(-x)); }
DI float softplusf_(float x) { return fmaxf(x, 0.f) + log1pf(__expf(-fabsf(x))); }
DI float wave_sum(float v) {
#pragma unroll
    for (int o = 32; o >= 1; o >>= 1) v += __shfl_xor(v, o);
    return v;
}

DI int tid_() { int t = threadIdx.x; asm volatile("" : "+v"(t)); return t; }
DI void glds16(const void* gsrc, unsigned lds_dst) {
    unsigned keep;
    asm volatile("s_mov_b32 %0, m0\n\ts_mov_b32 m0, %2\n\ts_nop 0\n\tglobal_load_lds_dwordx4 %1, off\n\ts_mov_b32 m0, %0" : "=&s"(keep) : "v"(gsrc), "s"(lds_dst) : "memory");
}
DI void glds16x6(const void* sa, const void* sb, unsigned va0, unsigned va1, unsigned vb0, unsigned vb1, unsigned vb2, unsigned vb3, unsigned lds_dst) {
    unsigned keep;
    asm volatile("s_mov_b32 %0, m0\n\ts_mov_b32 m0, %9\n\ts_nop 0\n\t"
                 "global_load_lds_dwordx4 %3, %1\n\ts_add_u32 m0, m0, 0x2000\n\ts_nop 0\n\t"
                 "global_load_lds_dwordx4 %4, %1\n\ts_add_u32 m0, m0, 0x2000\n\ts_nop 0\n\t"
                 "global_load_lds_dwordx4 %5, %2\n\ts_add_u32 m0, m0, 0x2000\n\ts_nop 0\n\t"
                 "global_load_lds_dwordx4 %6, %2\n\ts_add_u32 m0, m0, 0x2000\n\ts_nop 0\n\t"
                 "global_load_lds_dwordx4 %7, %2\n\ts_add_u32 m0, m0, 0x2000\n\ts_nop 0\n\t"
                 "global_load_lds_dwordx4 %8, %2\n\ts_mov_b32 m0, %0"
                 : "=&s"(keep) : "s"(sa), "s"(sb), "v"(va0), "v"(va1), "v"(vb0), "v"(vb1), "v"(vb2), "v"(vb3), "s"(lds_dst) : "memory", "scc");
}
DI void glds16x5(const void* sa, const void* sb, unsigned va, unsigned vb0, unsigned vb1, unsigned vb2, unsigned vb3, unsigned lds_dst) {
    unsigned keep;
    asm volatile("s_mov_b32 %0, m0\n\ts_mov_b32 m0, %8\n\ts_nop 0\n\t"
                 "global_load_lds_dwordx4 %3, %1\n\ts_add_u32 m0, m0, 0x2000\n\ts_nop 0\n\t"
                 "global_load_lds_dwordx4 %4, %2\n\ts_add_u32 m0, m0, 0x2000\n\ts_nop 0\n\t"
                 "global_load_lds_dwordx4 %5, %2\n\ts_add_u32 m0, m0, 0x2000\n\ts_nop 0\n\t"
                 "global_load_lds_dwordx4 %6, %2\n\ts_add_u32 m0, m0, 0x2000\n\ts_nop 0\n\t"
                 "global_load_lds_dwordx4 %7, %2\n\ts_mov_b32 m0, %0"
                 : "=&s"(keep) : "s"(sa), "s"(sb), "v"(va), "v"(vb0), "v"(vb1), "v"(vb2), "v"(vb3), "s"(lds_dst) : "memory", "scc");
}
DI void lds_barrier() { asm volatile("s_waitcnt lgkmcnt(0)\n\ts_barrier" ::: "memory"); }
constexpr int LDS_ROW = 144;
constexpr int A_STAGE = 128 * LDS_ROW;
constexpr int B_STAGE = 256 * LDS_ROW;
constexpr int STAGE = A_STAGE + B_STAGE;
constexpr int G3_A = 16384, G3_STAGE = 49152;
constexpr int H5_A = 8192, H5_STAGE = 40960;
constexpr int CHUNK_WAVE_LDS = 18944;
constexpr int SMEM_BYTES = 8 * CHUNK_WAVE_LDS;

DI void gemm_tile(const bf16_t* __restrict__ A, int lda, const bf16_t* __restrict__ Bt, int ldb, int K, unsigned char* smem, f32x4 (&acc)[4][4], bool zero = true) {
    const int tid = tid_(), lane = tid & 63, wid = tid >> 6;
    const int wm = wid >> 2, wn = wid & 3;
#pragma unroll
    for (int i = 0; i < 4; ++i)
#pragma unroll
        for (int j = 0; j < 4; ++j) if (zero) acc[i][j] = (f32x4){0.f, 0.f, 0.f, 0.f};
    const int crow = tid >> 3, ckc = tid & 7;
    const bf16_t* ag = A + (size_t)crow * lda + ckc * 8;
    const bf16_t* bg = Bt + (size_t)crow * ldb + ckc * 8;
    u32x4 ra[2], rb[4];
#pragma unroll
    for (int i = 0; i < 2; ++i) ra[i] = *(const u32x4*)(ag + (size_t)i * 64 * lda);
#pragma unroll
    for (int i = 0; i < 4; ++i) rb[i] = *(const u32x4*)(bg + (size_t)i * 64 * ldb);
    const int soff = crow * LDS_ROW + ckc * 16;
#pragma unroll
    for (int i = 0; i < 2; ++i) *(u32x4*)(smem + soff + i * 64 * LDS_ROW) = ra[i];
#pragma unroll
    for (int i = 0; i < 4; ++i) *(u32x4*)(smem + A_STAGE + soff + i * 64 * LDS_ROW) = rb[i];
    __syncthreads();
    const int nk = K >> 6;
    const int fa = (wm * 64 + (lane & 15)) * LDS_ROW + (lane >> 4) * 16;
    const int fb = A_STAGE + (wn * 64 + (lane & 15)) * LDS_ROW + (lane >> 4) * 16;
    for (int kt = 0; kt < nk; ++kt) {
        const int cur = kt & 1;
        const bool more = (kt + 1 < nk);
        if (more) {
            const int ko = (kt + 1) * 64;
#pragma unroll
            for (int i = 0; i < 2; ++i) ra[i] = *(const u32x4*)(ag + (size_t)i * 64 * lda + ko);
#pragma unroll
            for (int i = 0; i < 4; ++i) rb[i] = *(const u32x4*)(bg + (size_t)i * 64 * ldb + ko);
        }
        const unsigned char* sc = smem + cur * STAGE;
#pragma unroll
        for (int ks = 0; ks < 2; ++ks) {
            bf16x8 af[4], bfr[4];
#pragma unroll
            for (int mt = 0; mt < 4; ++mt) af[mt] = *(const bf16x8*)(sc + fa + mt * 16 * LDS_ROW + ks * 64);
#pragma unroll
            for (int nt = 0; nt < 4; ++nt) bfr[nt] = *(const bf16x8*)(sc + fb + nt * 16 * LDS_ROW + ks * 64);
#pragma unroll
            for (int mt = 0; mt < 4; ++mt)
#pragma unroll
                for (int nt = 0; nt < 4; ++nt) acc[mt][nt] = __builtin_amdgcn_mfma_f32_16x16x32_bf16(bfr[nt], af[mt], acc[mt][nt], 0, 0, 0);
        }
        if (more) {
            unsigned char* sn = smem + (cur ^ 1) * STAGE;
#pragma unroll
            for (int i = 0; i < 2; ++i) *(u32x4*)(sn + soff + i * 64 * LDS_ROW) = ra[i];
#pragma unroll
            for (int i = 0; i < 4; ++i) *(u32x4*)(sn + A_STAGE + soff + i * 64 * LDS_ROW) = rb[i];
        }
        __syncthreads();
    }
}

DI int colmap(int mode, int n) {
    if (mode == 0) return n;
    if (mode == 1) { const int a = (n >> 4) & 7; return (a & 1) * DFF + (n >> 9) * 256 + ((n >> 7) & 3) * 64 + ((n >> 2) & 3) * 16 + (a >> 1) * 4 + (n & 3); }
    if (n < 2816) return n;
    if (n < 3584) return n + 8;
    if (n < 3592) return n - 3584 + 2816;
    return -1;
}
DI void transpose_tile(const float* __restrict__ src, int Nsrc, int K, bf16_t* __restrict__ dst, int mode, int k0, int n0, float* tile  ) {
    const int tid = tid_();
    const int n4 = (tid & 15) * 4;
    const int c = colmap(mode, n0 + n4);
#pragma unroll
    for (int i = 0; i < 2; ++i) {
        const int kk = (tid >> 4) + 32 * i;
        f32x4 v = {0.f, 0.f, 0.f, 0.f};
        if (c >= 0) v = *(const f32x4*)(src + (size_t)(k0 + kk) * Nsrc + c);
        tile[kk * 65 + n4] = v[0]; tile[kk * 65 + n4 + 1] = v[1]; tile[kk * 65 + n4 + 2] = v[2]; tile[kk * 65 + n4 + 3] = v[3];
    }
    __syncthreads();
    const int n = tid >> 3, ks = (tid & 7) * 8;
    u32x4 w;
    w.x = pk_bf16(tile[(ks + 0) * 65 + n], tile[(ks + 1) * 65 + n]);
    w.y = pk_bf16(tile[(ks + 2) * 65 + n], tile[(ks + 3) * 65 + n]);
    w.z = pk_bf16(tile[(ks + 4) * 65 + n], tile[(ks + 5) * 65 + n]);
    w.w = pk_bf16(tile[(ks + 6) * 65 + n], tile[(ks + 7) * 65 + n]);
    *(u32x4*)(dst + ((size_t)((n0 >> 8) * (K >> 6) + (k0 >> 6)) * 256 + (n0 & 255) + n) * 64 + ks) = w;
    __syncthreads();
}
DI void prep_weights(const Params& P, unsigned char* smem, int L, int vb, int nvb, int part  ) {
    float* tile = (float*)smem;
    unsigned char* ws = P.ws;
    constexpr int T_W1 = 16 * 88, T_W2 = 44 * 16, T_WIN = 16 * 60, T_SQ = 16 * 16, T_WP = 4 * 16;
    constexpr int E1 = 2 * T_W1, E2 = E1 + 2 * T_W2, E3 = E2 + T_WIN, E4 = E3 + T_SQ, E5 = E4 + T_SQ, E6 = E5 + T_WP;
    for (int idx = vb; idx < E6; idx += nvb) {
        const bool early = (idx < T_W1) || (idx >= E1 && idx < E1 + T_W2) || (idx >= E2 && idx < E3);
        if (part != 2 && early != (part == 0)) continue;
        if (idx < E1) { const int j = L * 2 + idx / T_W1, t = idx % T_W1; const int kt = t / 88, nt = t % 88;
            transpose_tile(P.ffn_w_in + (size_t)j * D * 2 * DFF, 2 * DFF, D, (bf16_t*)(ws + OFF_W1 + j * SZ_W1), 1, kt * 64, nt * 64, tile); }
        else if (idx < E2) { const int q = idx - E1; const int j = L * 2 + q / T_W2, t = q % T_W2; const int kt = t / 16, nt = t % 16;
            transpose_tile(P.ffn_w_out + (size_t)j * DFF * D, D, DFF, (bf16_t*)(ws + OFF_W2 + j * SZ_W2), 0, kt * 64, nt * 64, tile); }
        else if (idx < E3) { const int t = idx - E2; const int kt = t / 60, nt = t % 60;
            transpose_tile(P.mix_w_in + (size_t)L * D * 3592, 3592, D, (bf16_t*)(ws + OFF_WIN + L * SZ_WIN), 2, kt * 64, nt * 64, tile); }
        else if (idx < E4) { const int t = idx - E3; const int kt = t / 16, nt = t % 16;
            transpose_tile(P.mix_w_out + (size_t)L * D * D, D, D, (bf16_t*)(ws + OFF_WOUT + L * SZ_WSQ), 0, kt * 64, nt * 64, tile); }
        else if (idx < E5) { const int t = idx - E4; const int kt = t / 16, nt = t % 16;
            transpose_tile(P.ple_w_gate + (size_t)L * D * D, D, D, (bf16_t*)(ws + OFF_WG + L * SZ_WSQ), 0, kt * 64, nt * 64, tile); }
        else { const int t = idx - E5; const int kt = t / 16, nt = t % 16;
            transpose_tile(P.ple_w_proj + (size_t)L * PLE * D, D, PLE, (bf16_t*)(ws + OFF_WP + L * SZ_WP), 0, kt * 64, nt * 64, tile); }
    }
}
DI void phase_prep(const Params& P, unsigned char* smem) {
    unsigned char* ws = P.ws;
    prep_weights(P, smem, 0, blockIdx.x, gridDim.x, (gridDim.x <= 64) ? 2 : 0);
    if (gridDim.x <= 64) prep_weights(P, smem, 1, blockIdx.x, gridDim.x, 2);
    if (blockIdx.x == 0 && threadIdx.x == 0) *(unsigned*)(ws + OFF_BAR) = 0u;
    bf16_t* xb = (bf16_t*)(ws + OFF_XB);
    const size_t n4 = (size_t)NTOK * D / 4;
    const int tidp = tid_();
    for (size_t i = (size_t)blockIdx.x * NTHREADS + tidp; i < n4; i += (size_t)gridDim.x * NTHREADS) {
        const f32x4 v = *(const f32x4*)(P.x + i * 4);
        u32x2 w; w.x = pk_bf16(v[0], v[1]); w.y = pk_bf16(v[2], v[3]);
        *(u32x2*)(xb + i * 4) = w;
    }
}

DI void ln_rows(float* xr, bf16_t* xbr, const float* __restrict__ g, const float* __restrict__ b, float* stp, bool write_f32) {
    const int tidl = tid_();
    const int lane = tidl & 63, wid = tidl >> 6;
    f32x4 gv[4], bv[4];
#pragma unroll
    for (int i = 0; i < 4; ++i) { gv[i] = *(const f32x4*)(g + i * 256 + lane * 4); bv[i] = *(const f32x4*)(b + i * 256 + lane * 4); }
    for (int r0 = wid * 16; r0 < wid * 16 + 16; r0 += 4) {
        f32x4 v[4][4];
#pragma unroll
        for (int q = 0; q < 4; ++q)
#pragma unroll
            for (int i = 0; i < 4; ++i) v[q][i] = *(const f32x4*)(xr + (size_t)(r0 + q) * D + i * 256 + lane * 4);
        float s[4], qq[4];
#pragma unroll
        for (int q = 0; q < 4; ++q) {
            s[q] = 0.f;
#pragma unroll
            for (int i = 0; i < 4; ++i) s[q] += (v[q][i][0] + v[q][i][1]) + (v[q][i][2] + v[q][i][3]);
        }
#pragma unroll
        for (int o = 32; o >= 1; o >>= 1)
#pragma unroll
            for (int q = 0; q < 4; ++q) s[q] += __shfl_xor(s[q], o);
#pragma unroll
        for (int q = 0; q < 4; ++q) {
            const float mu = s[q] * (1.0f / D);
            qq[q] = 0.f;
#pragma unroll
            for (int i = 0; i < 4; ++i) { v[q][i] = v[q][i] - mu; qq[q] += (v[q][i][0] * v[q][i][0] + v[q][i][1] * v[q][i][1]) + (v[q][i][2] * v[q][i][2] + v[q][i][3] * v[q][i][3]); }
        }
#pragma unroll
        for (int o = 32; o >= 1; o >>= 1)
#pragma unroll
            for (int q = 0; q < 4; ++q) qq[q] += __shfl_xor(qq[q], o);
#pragma unroll
        for (int q = 0; q < 4; ++q) {
            const float rs = rsqrtf(qq[q] * (1.0f / D) + 1e-5f);
            if (lane == 0) { stp[(r0 + q) * 2] = s[q] * (1.0f / D); stp[(r0 + q) * 2 + 1] = rs; }
#pragma unroll
            for (int i = 0; i < 4; ++i) {
                const f32x4 o = v[q][i] * rs * gv[i] + bv[i];
                if (write_f32) *(f32x4*)(xr + (size_t)(r0 + q) * D + i * 256 + lane * 4) = o;
                u32x2 w; w.x = pk_bf16(o[0], o[1]); w.y = pk_bf16(o[2], o[3]);
                *(u32x2*)(xbr + (size_t)(r0 + q) * D + i * 256 + lane * 4) = w;
            }
        }
    }
}

DI void run_jobs(const Params& P, int rb, int jj_lo, int jj_hi, unsigned char* smem) {
    float* xr = P.out + (size_t)rb * RB * D;
    bf16_t* xbr = (bf16_t*)(P.ws + OFF_XB) + (size_t)rb * RB * D;
    bf16_t* ureg = (bf16_t*)(P.ws + OFF_U) + (size_t)rb * RB * PJ;
    float* pps = (float*)ureg;
    bf16_t* pbf = (bf16_t*)((unsigned char*)ureg + (size_t)RB * D * 4);
    float* ab = (float*)(P.ws + OFF_AB) + (size_t)rb * RB * 8;
    for (int jj = jj_lo; jj < jj_hi; ++jj) {
        const int tid = tid_(), lane = tid & 63, wid = tid >> 6, wm = wid >> 2, wn = wid & 3;
        const int l = jj >> 3, j = jj & 7;
        if (j == 3) {
            const int hh = lane >> 4, cl = (lane & 15) * 8;
            const float* nw = P.gdn_norm_w + (size_t)l * 128 + cl;
            const f32x4 nw0 = *(const f32x4*)nw, nw1 = *(const f32x4*)(nw + 4);
            for (int r0 = wid * 16; r0 < wid * 16 + 16; r0 += 4) {
                u32x4 ov[4], zv[4];
#pragma unroll
                for (int q = 0; q < 4; ++q) {
                    ov[q] = *(const u32x4*)(xbr + (size_t)(r0 + q) * D + 256 + hh * 128 + cl);
                    zv[q] = *(const u32x4*)(ureg + (size_t)(r0 + q) * PJ + 2304 + hh * 128 + cl);
                }
#pragma unroll
                for (int q = 0; q < 4; ++q) {
                    float o[8], z[8];
#pragma unroll
                    for (int e = 0; e < 4; ++e) { o[2 * e] = bf_lo(ov[q][e]); o[2 * e + 1] = bf_hi(ov[q][e]); z[2 * e] = bf_lo(zv[q][e]); z[2 * e + 1] = bf_hi(zv[q][e]); }
                    float ss = 0.f;
#pragma unroll
                    for (int e = 0; e < 8; ++e) ss += o[e] * o[e];
                    ss += __shfl_xor(ss, 1); ss += __shfl_xor(ss, 2); ss += __shfl_xor(ss, 4); ss += __shfl_xor(ss, 8);
                    const float rs = rsqrtf(ss * (1.0f / 128.f) + 1e-6f);
                    float y[8];
#pragma unroll
                    for (int e = 0; e < 8; ++e) y[e] = o[e] * rs * ((e < 4) ? nw0[e & 3] : nw1[e & 3]) * (z[e] * sigmoidf_(z[e]));
                    u32x4 w; w.x = pk_bf16(y[0], y[1]); w.y = pk_bf16(y[2], y[3]); w.z = pk_bf16(y[4], y[5]); w.w = pk_bf16(y[6], y[7]);
                    *(u32x4*)(xbr + (size_t)(r0 + q) * D + 256 + hh * 128 + cl) = w;
                }
            }
            __syncthreads();
        }
        if (j == 6) {
            const float* pin = P.p + ((size_t)l * NTOK + (size_t)rb * RB) * PLE;
            for (int i = tid; i < RB * PLE / 4; i += NTHREADS) {
                const f32x4 v = *(const f32x4*)(pin + (size_t)i * 4);
                u32x2 w; w.x = pk_bf16(v[0], v[1]); w.y = pk_bf16(v[2], v[3]);
                *(u32x2*)(pbf + (size_t)i * 4) = w;
            }
            __syncthreads();
        }
        const bf16_t* A; const bf16_t* Bt; int lda, K, nt;
        if (j == 0 || j == 4) { A = xbr; lda = D; K = D; nt = 22; Bt = (const bf16_t*)(P.ws + OFF_W1 + (size_t)(l * 2 + (j >> 2)) * SZ_W1); }
        else if (j == 1 || j == 5) { A = ureg; lda = DFF; K = DFF; nt = 4; Bt = (const bf16_t*)(P.ws + OFF_W2 + (size_t)(l * 2 + (j >> 2)) * SZ_W2); }
        else if (j == 2) { A = xbr; lda = D; K = D; nt = 14; Bt = (const bf16_t*)(P.ws + OFF_WIN + (size_t)l * SZ_WIN); }
        else if (j == 3) { A = xbr; lda = D; K = D; nt = 4; Bt = (const bf16_t*)(P.ws + OFF_WOUT + (size_t)l * SZ_WSQ); }
        else if (j == 6) { A = pbf; lda = PLE; K = PLE; nt = 4; Bt = (const bf16_t*)(P.ws + OFF_WP + (size_t)l * SZ_WP); }
        else { A = xbr; lda = D; K = D; nt = 4; Bt = (const bf16_t*)(P.ws + OFF_WG + (size_t)l * SZ_WSQ); }
        const float* resid = (jj == 1) ? (P.x + (size_t)rb * RB * D) : xr;
        const float rsc = (j == 3) ? 1.0f : 0.5f;
        const float* bgate = P.ple_b_gate + (size_t)l * D;
        float* stp = (float*)(P.ws + OFF_ST) + (size_t)rb * RB * 2;
        const bool rec = (j == 1 || j == 3 || j == 5 || j == 7) && (jj != 1);
        const int lsrc = (j == 1) ? (l * 4 - 1) : (l * 4 + ((j - 3) >> 1));
        const float* lng = P.ln_g + (size_t)(rec ? lsrc : 0) * D;
        const float* lnb = P.ln_b + (size_t)(rec ? lsrc : 0) * D;
        {
            const int nk = K >> 5, nk64 = K >> 6, ntw = nt >> 1, S = ntw * nk;
            const int drow = tid >> 2, kcs = (tid & 3) ^ ((4 - ((tid >> 4) & 3)) & 3);
            const unsigned va = (unsigned)((drow * lda + kcs * 8) * 2);
            const unsigned vb0 = (unsigned)((drow * 64 + kcs * 8) * 2), vb1 = vb0 + 16384u;
            const unsigned vb2 = vb0 + (unsigned)nk64 * 32768u, vb3 = vb2 + 16384u;
            const unsigned lbase = (unsigned)(size_t)smem + (unsigned)__builtin_amdgcn_readfirstlane(wid) * 1024u;
            const int r16 = lane & 15, q4 = lane >> 4;
            const int ko = ((q4 ^ ((4 - (r16 >> 2)) & 3)) << 4);
            const int fa = (wm * 64 + r16) * 64 + ko, fb = H5_A + (wn * 128 + r16) * 64 + ko;
            f32x4 acc[4][8];
#pragma unroll
            for (int i = 0; i < 4; ++i)
#pragma unroll
                for (int jq = 0; jq < 8; ++jq) acc[i][jq] = (f32x4){0.f, 0.f, 0.f, 0.f};
            const int toff = (int)((blockIdx.x & 7u) * (unsigned)ntw) >> 3;
            const int koff = (int)((blockIdx.x >> 3) * (unsigned)nk) >> 5;
            int kp = 0, sp = 0, tp = toff;
            const bf16_t* pbt = Bt + (size_t)toff * 512 * K;
#define ISSUE() do { const int ka_ = (kp + koff >= nk) ? kp + koff - nk : kp + koff; \
                glds16x5(A + ka_ * 32, pbt + (size_t)(ka_ >> 1) * 16384 + (ka_ & 1) * 32, va, vb0, vb1, vb2, vb3, lbase + (unsigned)sp * H5_STAGE); \
                ++kp; if (kp == nk) { kp = 0; ++tp; pbt += (size_t)512 * K; if (tp == ntw) { tp = 0; pbt = Bt; } } sp = (sp == 2) ? 0 : sp + 1; } while (0)
            ISSUE();
            ISSUE();
            ISSUE();
            asm volatile("s_waitcnt vmcnt(10)" ::: "memory");
            lds_barrier();
            int kt = 0, t = toff, st = 0;
            for (int s = 0; s < S; ++s) {
                const unsigned char* sc_ = smem + st * H5_STAGE;
                bf16x8 af[4], bfr[8];
#pragma unroll
                for (int mt = 0; mt < 4; ++mt) af[mt] = *(const bf16x8*)(sc_ + fa + mt * 1024);
#pragma unroll
                for (int n_ = 0; n_ < 8; ++n_) bfr[n_] = *(const bf16x8*)(sc_ + fb + n_ * 1024);
                if (kt == 0) {
#pragma unroll
                    for (int i = 0; i < 4; ++i)
#pragma unroll
                        for (int jq = 0; jq < 8; ++jq) acc[i][jq] = (f32x4){0.f, 0.f, 0.f, 0.f};
                }
#pragma unroll
                for (int mt = 0; mt < 4; ++mt)
#pragma unroll
                    for (int n_ = 0; n_ < 8; ++n_) acc[mt][n_] = __builtin_amdgcn_mfma_f32_16x16x32_bf16(bfr[n_], af[mt], acc[mt][n_], 0, 0, 0);
                if (s + 2 < S) asm volatile("s_waitcnt vmcnt(5)" ::: "memory");
                else asm volatile("s_waitcnt vmcnt(0)" ::: "memory");
                lds_barrier();
                if (s + 3 < S) ISSUE();
                st = (st == 2) ? 0 : st + 1;
                ++kt;
                if (kt == nk) {
                    kt = 0;
                    const int row0 = wm * 64 + r16;
                    const int col0 = t * 512 + wn * 128 + q4 * 4;
                    if (j == 0 || j == 4) {
                        bf16_t* hp = ureg + (size_t)row0 * DFF + t * 256 + wn * 64 + q4 * 16;
#pragma unroll
                        for (int mt = 0; mt < 4; ++mt) {
                            float hv[16];
#pragma unroll
                            for (int pr = 0; pr < 4; ++pr)
#pragma unroll
                                for (int r = 0; r < 4; ++r) { const float g = acc[mt][2 * pr][r]; hv[pr * 4 + r] = g * sigmoidf_(g) * acc[mt][2 * pr + 1][r]; }
                            u32x4 w0, w1;
                            w0.x = pk_bf16(hv[0], hv[1]); w0.y = pk_bf16(hv[2], hv[3]); w0.z = pk_bf16(hv[4], hv[5]); w0.w = pk_bf16(hv[6], hv[7]);
                            w1.x = pk_bf16(hv[8], hv[9]); w1.y = pk_bf16(hv[10], hv[11]); w1.z = pk_bf16(hv[12], hv[13]); w1.w = pk_bf16(hv[14], hv[15]);
                            *(u32x4*)(hp + (size_t)mt * 16 * DFF) = w0;
                            *(u32x4*)(hp + (size_t)mt * 16 * DFF + 8) = w1;
                        }
                    } else if (j == 1 || j == 5 || j == 3) {
#pragma unroll
                        for (int mt = 0; mt < 4; ++mt)
#pragma unroll
                            for (int nn = 0; nn < 8; ++nn) {
                                if ((nn & 3) == 0) asm volatile("" ::: "memory");
                                const size_t o = (size_t)(row0 + mt * 16) * D + col0 + nn * 16;
                                f32x4 rv = *(const f32x4*)(resid + o);
                                if (rec) {
                                    const float mu = stp[(row0 + mt * 16) * 2], rs = stp[(row0 + mt * 16) * 2 + 1];
                                    rv = (rv - mu) * rs * *(const f32x4*)(lng + col0 + nn * 16) + *(const f32x4*)(lnb + col0 + nn * 16);
                                }
                                *(f32x4*)(xr + o) = rv * ALPHA + acc[mt][nn] * rsc;
                            }
                    } else if (j == 2) {
#pragma unroll
                        for (int mt = 0; mt < 4; ++mt)
#pragma unroll
                            for (int nn = 0; nn < 8; ++nn) {
                                u32x2 w; w.x = pk_bf16(acc[mt][nn][0], acc[mt][nn][1]); w.y = pk_bf16(acc[mt][nn][2], acc[mt][nn][3]);
                                *(u32x2*)(ureg + (size_t)(row0 + mt * 16) * PJ + col0 + nn * 16) = w;
                            }
                    } else if (j == 6) {
#pragma unroll
                        for (int mt = 0; mt < 4; ++mt)
#pragma unroll
                            for (int nn = 0; nn < 8; ++nn) *(f32x4*)(pps + (size_t)(row0 + mt * 16) * D + col0 + nn * 16) = acc[mt][nn];
                    } else {
#pragma unroll
                        for (int mt = 0; mt < 4; ++mt)
#pragma unroll
                            for (int nn = 0; nn < 8; ++nn) {
                                if ((nn & 1) == 0) asm volatile("" ::: "memory");
                                const size_t o = (size_t)(row0 + mt * 16) * D + col0 + nn * 16;
                                const f32x4 bv = *(const f32x4*)(bgate + col0 + nn * 16);
                                const f32x4 pv = *(const f32x4*)(pps + o);
                                f32x4 xv = *(const f32x4*)(xr + o);
                                {
                                    const float mu = stp[(row0 + mt * 16) * 2], rs = stp[(row0 + mt * 16) * 2 + 1];
                                    xv = (xv - mu) * rs * *(const f32x4*)(lng + col0 + nn * 16) + *(const f32x4*)(lnb + col0 + nn * 16);
                                }
                                f32x4 ov;
#pragma unroll
                                for (int r = 0; r < 4; ++r) ov[r] = xv[r] * ALPHA + sigmoidf_(acc[mt][nn][r] + bv[r]) * pv[r];
                                *(f32x4*)(xr + o) = ov;
                            }
                    }
                    ++t; if (t == ntw) t = 0;
                }
            }
#undef ISSUE
        }
        if (j == 2) {
            const int r16 = lane & 15, q4 = lane >> 4;
            const bf16_t* arow = xbr + (size_t)(wid * 16 + r16) * D + 8 * q4;
            const bf16_t* wrow = Bt + ((size_t)(14 * 16) * 256 + r16) * 64 + 8 * q4;
            f32x4 c = {0.f, 0.f, 0.f, 0.f};
#pragma unroll 8
            for (int kk = 0; kk < 32; ++kk) {
                const bf16x8 af = *(const bf16x8*)(arow + 32 * kk);
                const bf16x8 wf = *(const bf16x8*)(wrow + (size_t)(kk >> 1) * 16384 + (kk & 1) * 32);
                c = __builtin_amdgcn_mfma_f32_16x16x32_bf16(wf, af, c, 0, 0, 0);
            }
            if (q4 < 2) *(f32x4*)(ab + (size_t)(wid * 16 + r16) * 8 + q4 * 4) = c;
            __syncthreads();
            bf16_t* halo = (bf16_t*)(P.ws + OFF_HALO) + (size_t)rb * 3 * 1536;
            for (int i = tid; i < 3 * 192; i += NTHREADS) {
                const int rr = i / 192, cc = (i % 192) * 8;
                *(u32x4*)(halo + rr * 1536 + cc) = *(const u32x4*)(ureg + (size_t)(125 + rr) * PJ + 768 + cc);
            }
        }
        __syncthreads();
        if (j == 1 || j == 3 || j == 5 || j == 7) {
            const int li = l * 4 + ((j - 1) >> 1);
            ln_rows(xr, xbr, P.ln_g + (size_t)li * D, P.ln_b + (size_t)li * D, stp, jj == 15);
            __syncthreads();
        }
    }
}

DI void phase_gdn_prep(const Params& P, int l) {
    const int tid = tid_(), lane = tid & 63, wid = tid >> 6;
    const int h = lane >> 4, cl = (lane & 15) * 8;
    const bf16_t* proj = (const bf16_t*)(P.ws + OFF_U);
    const bf16_t* halo = (const bf16_t*)(P.ws + OFF_HALO);
    bf16_t* gq = (bf16_t*)(P.ws + OFF_GQ);
    const float* cw = P.gdn_conv_w + (size_t)l * 4 * 1536;
    const float* ab = (const float*)(P.ws + OFF_AB);
    float* gb = (float*)(P.ws + OFF_GB);
    for (int rb = blockIdx.x; rb < NRB; rb += gridDim.x) {
        for (int itl = wid; itl < 96; itl += 8) {
            const int which = itl % 3, tgl = itl / 3;
            const int t0 = rb * RB + tgl * 4, s0 = t0 & (SEQ - 1);
            const int c = which * 512 + h * 128 + cl;
            f32x4 w[4][2];
#pragma unroll
            for (int i = 0; i < 4; ++i) { w[i][0] = *(const f32x4*)(cw + i * 1536 + c); w[i][1] = *(const f32x4*)(cw + i * 1536 + c + 4); }
            u32x4 x[7];
#pragma unroll
            for (int rr = 0; rr < 7; ++rr) {
                if (tgl == 0 && rr < 3) {
                    if (s0 > 0) x[rr] = *(const u32x4*)(halo + ((size_t)(rb - 1) * 3 + rr) * 1536 + c);
                    else x[rr] = (u32x4){0u, 0u, 0u, 0u};
                } else x[rr] = *(const u32x4*)(proj + (size_t)(t0 - 3 + rr) * PJ + 768 + c);
            }
#pragma unroll
            for (int tk = 0; tk < 4; ++tk) {
                float y[8];
#pragma unroll
                for (int e = 0; e < 8; ++e) y[e] = 0.f;
#pragma unroll
                for (int i = 0; i < 4; ++i)
#pragma unroll
                    for (int jj = 0; jj < 4; ++jj) {
                        y[2 * jj] += w[i][jj >> 1][(2 * jj) & 3] * bf_lo(x[tk + i][jj]);
                        y[2 * jj + 1] += w[i][jj >> 1][(2 * jj + 1) & 3] * bf_hi(x[tk + i][jj]);
                    }
                float ss = 0.f;
#pragma unroll
                for (int e = 0; e < 8; ++e) { y[e] = y[e] * sigmoidf_(y[e]); ss += y[e] * y[e]; }
                if (which < 2) {
                    ss += __shfl_xor(ss, 1); ss += __shfl_xor(ss, 2); ss += __shfl_xor(ss, 4); ss += __shfl_xor(ss, 8);
                    float sc = rsqrtf(ss + 1e-6f);
                    if (which == 0) sc *= 0.08838834764831845f;
#pragma unroll
                    for (int e = 0; e < 8; ++e) y[e] *= sc;
                }
                u32x4 o; o.x = pk_bf16(y[0], y[1]); o.y = pk_bf16(y[2], y[3]); o.z = pk_bf16(y[4], y[5]); o.w = pk_bf16(y[6], y[7]);
                *(u32x4*)(gq + (size_t)(t0 + tk) * 1536 + c) = o;
            }
        }
        {
            const int t = rb * RB + (tid >> 2), hh = tid & 3;
            const float a = ab[(size_t)t * 8 + hh], bl = ab[(size_t)t * 8 + 4 + hh];
            gb[(size_t)t * 8 + hh] = -__expf(P.gdn_a_log[l * 4 + hh]) * softplusf_(a + P.gdn_dt_bias[l * 4 + hh]);
            gb[(size_t)t * 8 + 4 + hh] = sigmoidf_(bl);
        }
    }
}

DI void sc_conv(const Params& P, int l, int vb, int nvb) {
    const bf16_t* proj = (const bf16_t*)(P.ws + OFF_U);
    bf16_t* mixed = (bf16_t*)(P.ws + OFF_XB);
    const float* w = P.sc_conv_w + (size_t)l * 3 * 256;
    const int tids = tid_();
    for (size_t it = (size_t)vb * NTHREADS + tids; it < (size_t)NTOK * 128; it += (size_t)nvb * NTHREADS) {
        const int t = (int)(it >> 7), c = (int)(it & 127) * 2;
        const int s = t & (SEQ - 1);
        float y0 = 0.f, y1 = 0.f;
#pragma unroll
        for (int i = 0; i < 3; ++i) {
            if (s - 2 + i >= 0) {
                const bf16_t* pr = proj + (size_t)(t - 2 + i) * PJ;
                const unsigned cu = *(const unsigned*)(pr + 3072 + c), hu = *(const unsigned*)(pr + 3328 + c);
                y0 += w[i * 256 + c] * (bf_lo(cu) * bf_lo(hu));
                y1 += w[i * 256 + c + 1] * (bf_hi(cu) * bf_hi(hu));
            }
        }
        const unsigned bu = *(const unsigned*)(proj + (size_t)t * PJ + 2816 + c);
        *(unsigned*)(mixed + (size_t)t * D + 768 + c) = pk_bf16(bf_lo(bu) * y0, bf_hi(bu) * y1);
    }
}

DI bf16x8 scale_frag(bf16x8 f, float s) {
    const u32x4 u = __builtin_bit_cast(u32x4, f);
    u32x4 o;
#pragma unroll
    for (int e = 0; e < 4; ++e) o[e] = pk_bf16(bf_lo(u[e]) * s, bf_hi(u[e]) * s);
    return __builtin_bit_cast(bf16x8, o);
}
typedef float f32x16 __attribute__((ext_vector_type(16)));
DI void sb_mfma(const Params& P, int vw, int nvw) {
    const bf16_t* proj = (const bf16_t*)(P.ws + OFF_U);
    bf16_t* mixed = (bf16_t*)(P.ws + OFF_XB);
    for (int it = vw; it < 4096; it += nvw) {
        const int lane = tid_() & 63, c32 = lane & 31, h2 = lane >> 5;
        const int qt = it & 255, h = (it >> 8) & 3, b = it >> 10;
        const size_t Tb = (size_t)b * SEQ, T0 = Tb + 32 * qt;
        bf16x8 qf[4];
#pragma unroll
        for (int ks = 0; ks < 4; ++ks) qf[ks] = scale_frag(*(const bf16x8*)(proj + (T0 + c32) * PJ + h * 64 + 16 * ks + 8 * h2), 0.125f);
        f32x16 O0, O1;
#pragma unroll
        for (int i = 0; i < 16; ++i) { O0[i] = 0.f; O1[i] = 0.f; }
        float carry = 0.f;
        for (int kt = qt; kt >= 0; --kt) {
            const bf16_t* kb = proj + (Tb + 32 * kt + c32) * PJ + 256 + h * 64 + 8 * h2;
            f32x16 S;
#pragma unroll
            for (int i = 0; i < 16; ++i) S[i] = 0.f;
#pragma unroll
            for (int ks = 0; ks < 4; ++ks) S = __builtin_amdgcn_mfma_f32_32x32x16_bf16(*(const bf16x8*)(kb + 16 * ks), qf[ks], S, 0, 0, 0);
            const bf16_t* vb = proj + (Tb + 32 * kt + 4 * h2) * PJ + 512 + h * 64 + c32;
            bf16x8 vf[2][2];
#pragma unroll
            for (int s2 = 0; s2 < 2; ++s2)
#pragma unroll
                for (int nt = 0; nt < 2; ++nt)
#pragma unroll
                    for (int j = 0; j < 8; ++j) vf[s2][nt][j] = (short)vb[(size_t)(16 * s2 + 8 * (j >> 2) + (j & 3)) * PJ + 32 * nt];
            const bool diag = (kt == qt);
            float ls[16], lb[16];
#pragma unroll
            for (int i = 0; i < 16; ++i) {
                const float z = S[i];
                const float sp = fmaxf(z, 0.f) + __logf(1.0f + __expf(-fabsf(z)));
                const int sl = 8 * (i >> 2) + 4 * h2 + (i & 3);
                const bool valid = !diag || (sl < c32);
                lb[i] = valid ? (z - sp) : -1e30f;
                ls[i] = valid ? -sp : 0.f;
            }
            float qs[4], pq[4], ps[4];
#pragma unroll
            for (int g = 0; g < 4; ++g) { qs[g] = (ls[4 * g] + ls[4 * g + 1]) + (ls[4 * g + 2] + ls[4 * g + 3]); pq[g] = __shfl_xor(qs[g], 32); ps[g] = qs[g] + pq[g]; }
            float R[4];
            R[3] = 0.f; R[2] = ps[3]; R[1] = R[2] + ps[2]; R[0] = R[1] + ps[1];
            float att[16];
#pragma unroll
            for (int g = 0; g < 4; ++g) {
                const float suf = carry + R[g] + ((h2 == 0) ? pq[g] : 0.f);
                const float l3 = suf, l2 = l3 + ls[4 * g + 3], l1 = l2 + ls[4 * g + 2], l0 = l1 + ls[4 * g + 1];
                att[4 * g + 3] = __expf(lb[4 * g + 3] + l3);
                att[4 * g + 2] = __expf(lb[4 * g + 2] + l2);
                att[4 * g + 1] = __expf(lb[4 * g + 1] + l1);
                att[4 * g + 0] = __expf(lb[4 * g + 0] + l0);
            }
            carry += R[0] + ps[0];
            bf16x8 af[2];
#pragma unroll
            for (int s2 = 0; s2 < 2; ++s2) {
                u32x4 u;
                u.x = pk_bf16(att[8 * s2 + 0], att[8 * s2 + 1]); u.y = pk_bf16(att[8 * s2 + 2], att[8 * s2 + 3]);
                u.z = pk_bf16(att[8 * s2 + 4], att[8 * s2 + 5]); u.w = pk_bf16(att[8 * s2 + 6], att[8 * s2 + 7]);
                af[s2] = __builtin_bit_cast(bf16x8, u);
            }
#pragma unroll
            for (int s2 = 0; s2 < 2; ++s2) {
                O0 = __builtin_amdgcn_mfma_f32_32x32x16_bf16(af[s2], vf[s2][0], O0, 0, 0, 0);
                O1 = __builtin_amdgcn_mfma_f32_32x32x16_bf16(af[s2], vf[s2][1], O1, 0, 0, 0);
            }
            if (__all(carry < -104.f)) break;
        }
        bf16_t* op = mixed + (T0 + 4 * h2) * D + h * 64 + c32;
#pragma unroll
        for (int i = 0; i < 16; ++i) {
            const int tl = (i & 3) + 8 * (i >> 2);
            op[(size_t)tl * D] = (bf16_t)(pk_bf16(O0[i], 0.f) & 0xffffu);
            op[(size_t)tl * D + 32] = (bf16_t)(pk_bf16(O1[i], 0.f) & 0xffffu);
        }
    }
}

DI void wsync() { asm volatile("s_waitcnt lgkmcnt(0)" ::: "memory"); }
DI void store_T_row(bf16_t* XT, const bf16x8 (&f)[4], float sc, int m, int r16, int q4) {
#pragma unroll
    for (int kk = 0; kk < 4; ++kk) {
        const u32x4 u = __builtin_bit_cast(u32x4, f[kk]);
#pragma unroll
        for (int e = 0; e < 4; ++e) {
            const unsigned w = pk_bf16(bf_lo(u[e]) * sc, bf_hi(u[e]) * sc);
            const int c = 32 * kk + 8 * q4 + 2 * e;
            XT[c * 72 + 16 * m + r16] = (bf16_t)(w & 0xffffu);
            XT[(c + 1) * 72 + 16 * m + r16] = (bf16_t)(w >> 16);
        }
    }
}
DI u32x2 pack4(const f32x4 a) { u32x2 w; w.x = pk_bf16(a[0], a[1]); w.y = pk_bf16(a[2], a[3]); return w; }

DI void phase_gdn_chunk(const Params& P, unsigned char* smem) {
    const int tid0 = tid_(), wid = tid0 >> 6;
    unsigned char* wl = smem + wid * CHUNK_WAVE_LDS;
    float* X = (float*)wl;
    bf16_t* XT = (bf16_t*)wl;
    float* gcs = (float*)(wl + 18432);
    float* bts = gcs + 64;
    bf16_t* gq = (bf16_t*)(P.ws + OFF_GQ);
    bf16_t* proj = (bf16_t*)(P.ws + OFF_U);
    const float* gb = (const float*)(P.ws + OFF_GB);
    float* glw = (float*)(P.ws + OFF_GL);
    for (int it = blockIdx.x * 8 + wid; it < 2048; it += gridDim.x * 8) {
        const int lane = tid_() & 63, r16 = lane & 15, q4 = lane >> 4;
        const int h = it & 3, c = (it >> 2) & 127, b = it >> 9;
        const size_t t0 = (size_t)b * SEQ + (size_t)c * 64;
        float gc = gb[(t0 + lane) * 8 + h];
        const float bt = gb[(t0 + lane) * 8 + 4 + h];
#pragma unroll
        for (int o = 1; o < 64; o <<= 1) { const float v = __shfl_up(gc, o); if (lane >= o) gc += v; }
        gcs[lane] = gc; bts[lane] = bt;
        const float gtot = __shfl(gc, 63);
        if (lane == 0) glw[it] = __expf(gtot);
        wsync();
        bf16x8 kf[4][4];
        {
            const bf16_t* kb = gq + t0 * 1536 + 512 + h * 128 + (size_t)r16 * 1536 + 8 * q4;
#pragma unroll
            for (int m = 0; m < 4; ++m)
#pragma unroll
                for (int kk = 0; kk < 4; ++kk) kf[m][kk] = *(const bf16x8*)(kb + (size_t)m * 16 * 1536 + 32 * kk);
        }
#pragma unroll
        for (int mi = 0; mi < 4; ++mi)
#pragma unroll
            for (int mj = 0; mj <= mi; ++mj) {
                f32x4 a = {0.f, 0.f, 0.f, 0.f};
#pragma unroll
                for (int kk = 0; kk < 4; ++kk) a = __builtin_amdgcn_mfma_f32_16x16x32_bf16(kf[mi][kk], kf[mj][kk], a, 0, 0, 0);
                const int j = 16 * mj + r16;
                const float gj = gcs[j];
                const f32x4 gi = *(const f32x4*)(gcs + 16 * mi + 4 * q4);
                const f32x4 bi = *(const f32x4*)(bts + 16 * mi + 4 * q4);
#pragma unroll
                for (int r = 0; r < 4; ++r) {
                    const int i = 16 * mi + 4 * q4 + r;
                    X[i * 68 + j] = (i > j) ? bi[r] * a[r] * __expf(fminf(gi[r] - gj, 0.f)) : 0.f;
                }
            }
        {
            bf16_t* qb = gq + t0 * 1536 + h * 128 + (size_t)r16 * 1536 + 8 * q4;
#pragma unroll
            for (int mi = 0; mi < 4; ++mi) {
                bf16x8 qf[4];
#pragma unroll
                for (int kk = 0; kk < 4; ++kk) qf[kk] = *(const bf16x8*)(qb + (size_t)mi * 16 * 1536 + 32 * kk);
                const int i = 16 * mi + r16;
                const float gi = gcs[i];
                bf16_t* qkrow = proj + (t0 + i) * PJ + 1792 + h * 128 + 4 * q4;
#pragma unroll
                for (int mj = 0; mj < 4; ++mj) {
                    u32x2 w = {0u, 0u};
                    if (mj <= mi) {
                        f32x4 a = {0.f, 0.f, 0.f, 0.f};
#pragma unroll
                        for (int kk = 0; kk < 4; ++kk) a = __builtin_amdgcn_mfma_f32_16x16x32_bf16(kf[mj][kk], qf[kk], a, 0, 0, 0);
                        const f32x4 gj = *(const f32x4*)(gcs + 16 * mj + 4 * q4);
                        f32x4 v;
#pragma unroll
                        for (int r = 0; r < 4; ++r) { const int j = 16 * mj + 4 * q4 + r; v[r] = (j <= i) ? a[r] * __expf(fminf(gi - gj[r], 0.f)) : 0.f; }
                        w = pack4(v);
                    }
                    *(u32x2*)(qkrow + 16 * mj) = w;
                }
                const float s = __expf(gi);
#pragma unroll
                for (int kk = 0; kk < 4; ++kk) *(bf16x8*)(qb + (size_t)mi * 16 * 1536 + 32 * kk) = scale_frag(qf[kk], s);
            }
        }
        wsync();
        {
            float Tc[64];
#pragma unroll
            for (int i = 0; i < 64; ++i) Tc[i] = 0.f;
            Tc[0] = (lane == 0) ? 1.f : 0.f;
#pragma unroll
            for (int i = 1; i < 64; ++i) {
                float a0 = 0.f, a1 = 0.f, a2 = 0.f, a3 = 0.f;
#pragma unroll
                for (int jj = 0; jj < (i + 3) / 4; ++jj) {
                    const f32x4 m4 = *(const f32x4*)(X + i * 68 + 4 * jj);
                    a0 += m4[0] * Tc[4 * jj]; a1 += m4[1] * Tc[4 * jj + 1]; a2 += m4[2] * Tc[4 * jj + 2]; a3 += m4[3] * Tc[4 * jj + 3];
                }
                Tc[i] = ((lane == i) ? 1.f : 0.f) - ((a0 + a1) + (a2 + a3));
            }
            wsync();
#pragma unroll
            for (int i = 0; i < 64; ++i) X[i * 68 + lane] = Tc[i];
            wsync();
        }
        {
            const bf16_t* kb = gq + t0 * 1536 + 512 + h * 128 + (size_t)r16 * 1536 + 8 * q4;
#pragma unroll
            for (int m = 0; m < 4; ++m)
#pragma unroll
                for (int kk = 0; kk < 4; ++kk) kf[m][kk] = *(const bf16x8*)(kb + (size_t)m * 16 * 1536 + 32 * kk);
        }
        bf16x8 Tf[4][2];
#pragma unroll
        for (int mi = 0; mi < 4; ++mi)
#pragma unroll
            for (int ks = 0; ks < 2; ++ks) {
                const float* xp = X + (16 * mi + r16) * 68 + 32 * ks + 8 * q4;
                const f32x4 a = *(const f32x4*)xp, bb = *(const f32x4*)(xp + 4);
                u32x4 u; u.x = pk_bf16(a[0], a[1]); u.y = pk_bf16(a[2], a[3]); u.z = pk_bf16(bb[0], bb[1]); u.w = pk_bf16(bb[2], bb[3]);
                Tf[mi][ks] = __builtin_bit_cast(bf16x8, u);
            }
        float sk[4];
#pragma unroll
        for (int m = 0; m < 4; ++m) sk[m] = bts[16 * m + r16] * __expf(gcs[16 * m + r16]);
        wsync();
#pragma unroll
        for (int m = 0; m < 4; ++m) store_T_row(XT, kf[m], sk[m], m, r16, q4);
        wsync();
#pragma unroll
        for (int md = 0; md < 8; ++md) {
            bf16x8 af[2];
#pragma unroll
            for (int ks = 0; ks < 2; ++ks) af[ks] = *(const bf16x8*)(XT + (16 * md + r16) * 72 + 32 * ks + 8 * q4);
#pragma unroll
            for (int mi = 0; mi < 4; ++mi) {
                f32x4 a = {0.f, 0.f, 0.f, 0.f};
#pragma unroll
                for (int ks = 0; ks < 2; ++ks) a = __builtin_amdgcn_mfma_f32_16x16x32_bf16(af[ks], Tf[mi][ks], a, 0, 0, 0);
                *(u32x2*)(proj + (t0 + 16 * mi + r16) * PJ + 768 + h * 128 + 16 * md + 4 * q4) = pack4(a);
            }
        }
        wsync();
#pragma unroll
        for (int m = 0; m < 4; ++m) sk[m] = __expf(gtot - gcs[16 * m + r16]);
#pragma unroll
        for (int m = 0; m < 4; ++m) store_T_row(XT, kf[m], sk[m], m, r16, q4);
        wsync();
#pragma unroll
        for (int e = 0; e < 16; ++e) {
            const int q = lane + 64 * e, d = q >> 3, jc = (q & 7) * 8;
            const u32x4 v = *(const u32x4*)(XT + d * 72 + jc);
            *(u32x4*)(proj + (t0 + (d >> 1)) * PJ + 1280 + h * 128 + (d & 1) * 64 + jc) = v;
        }
        wsync();
        {
            const bf16_t* vb = gq + t0 * 1536 + 1024 + h * 128 + (size_t)r16 * 1536 + 8 * q4;
#pragma unroll
            for (int m = 0; m < 4; ++m) {
                bf16x8 vf[4];
#pragma unroll
                for (int kk = 0; kk < 4; ++kk) vf[kk] = *(const bf16x8*)(vb + (size_t)m * 16 * 1536 + 32 * kk);
                store_T_row(XT, vf, bts[16 * m + r16], m, r16, q4);
            }
        }
        wsync();
#pragma unroll
        for (int nt = 0; nt < 8; ++nt) {
            bf16x8 bfv[2];
#pragma unroll
            for (int ks = 0; ks < 2; ++ks) bfv[ks] = *(const bf16x8*)(XT + (16 * nt + r16) * 72 + 32 * ks + 8 * q4);
            const int n = 16 * nt + r16;
#pragma unroll
            for (int mi = 0; mi < 4; ++mi) {
                f32x4 a = {0.f, 0.f, 0.f, 0.f};
#pragma unroll
                for (int ks = 0; ks < 2; ++ks) a = __builtin_amdgcn_mfma_f32_16x16x32_bf16(Tf[mi][ks], bfv[ks], a, 0, 0, 0);
                *(u32x2*)(gq + (t0 + (n >> 1)) * 1536 + 1024 + h * 128 + (n & 1) * 64 + 16 * mi + 4 * q4) = pack4(a);
            }
        }
        wsync();
    }
}

constexpr int SC_W = 0, SC_QD = 16384, SC_QK = 32768, SC_KD = 40960, SC_UT = 57344, SC_STAGE = 61440;
constexpr int SC_ST = 2 * SC_STAGE, SC_VT = SC_ST + 32 * 136 * 2, SC_GL = SC_VT + 32 * 72 * 2;
DI void gdn_scan(const Params& P, int item, unsigned char* smem) {
    const int tid = tid_(), lane = tid & 63, wid = tid >> 6, r16 = lane & 15, q4 = lane >> 4;
    const int ns = (item >> 3) & 3, bh = ((item & 7) << 1) | (item >> 5), h = bh & 3, b = bh >> 2;
    const int mi = wid & 3, nt = wid >> 2, md = wid;
    bf16_t* ST = (bf16_t*)(smem + SC_ST);
    bf16_t* VT = (bf16_t*)(smem + SC_VT);
    float* gls = (float*)(smem + SC_GL);
    const bf16_t* proj = (const bf16_t*)(P.ws + OFF_U);
    const bf16_t* gq = (const bf16_t*)(P.ws + OFF_GQ);
    const float* glw = (const float*)(P.ws + OFF_GL);
    bf16_t* mixed = (bf16_t*)(P.ws + OFF_XB);
    for (int i = tid; i < 32 * 136 / 2; i += NTHREADS) ((unsigned*)ST)[i] = 0u;
    if (tid < 128) gls[tid] = glw[((b * 128 + tid) << 2) + h];
    const size_t tb = (size_t)b * SEQ;
    const int r4 = tid >> 4, k16 = (tid & 15) ^ (r4 & 15), k8 = (tid & 7) ^ (r4 & 7);
    const bf16_t* pw = proj + (tb + r4) * PJ + 768 + h * 128 + k16 * 8;
    const bf16_t* pq = gq + (tb + r4) * 1536 + h * 128 + k16 * 8;
    const bf16_t* pk = proj + (tb + (tid >> 3)) * PJ + 1792 + h * 128 + k8 * 8;
    const bf16_t* pd = proj + (tb + r4) * PJ + 1280 + h * 128 + ((tid >> 3) & 1) * 64 + k8 * 8;
    const int nu = ns * 32 + ((tid >> 3) & 31);
    const bf16_t* pu = gq + (tb + (nu >> 1)) * 1536 + 1024 + h * 128 + (nu & 1) * 64 + (tid & 7) * 8;
    const unsigned lbase = (unsigned)(size_t)smem + (unsigned)__builtin_amdgcn_readfirstlane(wid) * 1024u;
    const bool uwave = (__builtin_amdgcn_readfirstlane(wid) < 4);
#define SC_ISSUE(c_) do { const unsigned dst_ = lbase + (unsigned)((c_) & 1) * SC_STAGE; const size_t o1_ = (size_t)(c_) * 64 * PJ, o2_ = (size_t)(c_) * 64 * 1536; \
        glds16(pw + o1_, dst_ + SC_W); glds16(pw + o1_ + (size_t)32 * PJ, dst_ + SC_W + 8192u); \
        glds16(pq + o2_, dst_ + SC_QD); glds16(pq + o2_ + (size_t)32 * 1536, dst_ + SC_QD + 8192u); \
        glds16(pk + o1_, dst_ + SC_QK); \
        glds16(pd + o1_, dst_ + SC_KD); glds16(pd + o1_ + (size_t)32 * PJ, dst_ + SC_KD + 8192u); \
        if (uwave) glds16(pu + o2_, dst_ + SC_UT); } while (0)
    const int ow = (16 * mi + r16) * 256, oqk = SC_QK + (16 * mi + r16) * 128, okd = SC_KD + (16 * md + r16) * 128;
    const int out = SC_UT + (16 * nt + r16) * 128 + (16 * mi + 4 * q4) * 2;
    const int x8 = r16 >> 1;
    f32x4 accS[2] = {{0.f, 0.f, 0.f, 0.f}, {0.f, 0.f, 0.f, 0.f}};
    SC_ISSUE(0);
    asm volatile("s_waitcnt vmcnt(0)" ::: "memory");
    __syncthreads();
    for (int c = 0; c < 128; ++c) {
        if (c + 1 < 128) SC_ISSUE(c + 1);
        const unsigned char* sg = smem + (c & 1) * SC_STAGE;
        f32x4 aP = {0.f, 0.f, 0.f, 0.f}, aO = {0.f, 0.f, 0.f, 0.f};
#pragma unroll
        for (int kk = 0; kk < 4; ++kk) {
            const bf16x8 sf = *(const bf16x8*)(ST + (16 * nt + r16) * 136 + 32 * kk + 8 * q4);
            const int co = (((4 * kk + q4) ^ r16) << 4);
            const bf16x8 wf = *(const bf16x8*)(sg + SC_W + ow + co);
            const bf16x8 qd = *(const bf16x8*)(sg + SC_QD + ow + co);
            aP = __builtin_amdgcn_mfma_f32_16x16x32_bf16(wf, sf, aP, 0, 0, 0);
            aO = __builtin_amdgcn_mfma_f32_16x16x32_bf16(qd, sf, aO, 0, 0, 0);
        }
        {
            const u32x2 uu = *(const u32x2*)(sg + out);
            f32x4 vn;
            vn[0] = bf_lo(uu.x) - aP[0]; vn[1] = bf_hi(uu.x) - aP[1]; vn[2] = bf_lo(uu.y) - aP[2]; vn[3] = bf_hi(uu.y) - aP[3];
            *(u32x2*)(VT + (16 * nt + r16) * 72 + 16 * mi + 4 * q4) = pack4(vn);
        }
        lds_barrier();
#pragma unroll
        for (int ks = 0; ks < 2; ++ks) {
            const bf16x8 vf = *(const bf16x8*)(VT + (16 * nt + r16) * 72 + 32 * ks + 8 * q4);
            const bf16x8 qk = *(const bf16x8*)(sg + oqk + (((4 * ks + q4) ^ x8) << 4));
            aO = __builtin_amdgcn_mfma_f32_16x16x32_bf16(qk, vf, aO, 0, 0, 0);
        }
        {
            bf16_t* op = mixed + (tb + (size_t)c * 64 + 16 * mi + 4 * q4) * D + 256 + h * 128 + ns * 32 + 16 * nt + r16;
#pragma unroll
            for (int r = 0; r < 4; ++r) op[(size_t)r * D] = (bf16_t)(pk_bf16(aO[r], 0.f) & 0xffffu);
        }
        const float gl = gls[c];
        bf16x8 kd[2];
#pragma unroll
        for (int ks = 0; ks < 2; ++ks) kd[ks] = *(const bf16x8*)(sg + okd + (((4 * ks + q4) ^ x8) << 4));
#pragma unroll
        for (int n2 = 0; n2 < 2; ++n2) {
            accS[n2] = accS[n2] * gl;
#pragma unroll
            for (int ks = 0; ks < 2; ++ks) {
                const bf16x8 vf = *(const bf16x8*)(VT + (16 * n2 + r16) * 72 + 32 * ks + 8 * q4);
                accS[n2] = __builtin_amdgcn_mfma_f32_16x16x32_bf16(kd[ks], vf, accS[n2], 0, 0, 0);
            }
            *(u32x2*)(ST + (16 * n2 + r16) * 136 + 16 * md + 4 * q4) = pack4(accS[n2]);
        }
        asm volatile("s_waitcnt vmcnt(0)" ::: "memory");
        lds_barrier();
    }
#undef SC_ISSUE
    __syncthreads();
}

DI void phase_mix(const Params& P, int l, unsigned char* smem) {
    const int G = gridDim.x;
    for (int it = blockIdx.x; it < 64; it += G) {
        gdn_scan(P, it, smem);
#if PROBE_SCAN2
        __syncthreads();
        gdn_scan(P, it, smem);
#endif
    }
    const int nvb = (G > 64) ? (G - 64) : G;
    const int vb = (G > 64) ? ((int)blockIdx.x - 64) : (int)blockIdx.x;
    if (vb >= 0) {
        sb_mfma(P, vb * 8 + (tid_() >> 6), nvb * 8); sc_conv(P, l, vb, nvb);
#if PROBE_SBSC2
        sb_mfma(P, vb * 8 + (tid_() >> 6), nvb * 8); sc_conv(P, l, vb, nvb);
#endif
        if (l == 0 && G > 64) { __syncthreads(); prep_weights(P, smem, 0, vb, nvb, 1); prep_weights(P, smem, 1, vb, nvb, 2); }
    }
}

DI void grid_bar(unsigned* cnt, unsigned& gen) {
    __syncthreads();
    gen += gridDim.x;
    if (threadIdx.x == 0) {
        __builtin_amdgcn_fence(__ATOMIC_RELEASE, "agent");
        __hip_atomic_fetch_add(cnt, 1u, __ATOMIC_RELAXED, __HIP_MEMORY_SCOPE_AGENT);
        while (__hip_atomic_load(cnt, __ATOMIC_RELAXED, __HIP_MEMORY_SCOPE_AGENT) < gen) __builtin_amdgcn_s_sleep(2);
        __builtin_amdgcn_fence(__ATOMIC_ACQUIRE, "agent");
    }
    __syncthreads();
}

constexpr int NPH = 8;
__global__ void __launch_bounds__(NTHREADS) mega(Params PK) {
    extern __shared__ __attribute__((aligned(16))) unsigned char smem[];
    cg::grid_group grid = cg::this_grid();
    unsigned bar_gen = 0u;
    for (int ph = PK.ph_lo; ph < PK.ph_hi; ++ph) {
        const Params& P = PK;
        if (ph == 0) phase_prep(P, smem);
        else if (ph == 1 || ph == 4 || ph == 7) {
            const int lo = (ph == 1) ? 0 : (ph == 4 ? 3 : 11), hi = (ph == 1) ? 3 : (ph == 4 ? 11 : 16);
            for (int rb = blockIdx.x; rb < NRB; rb += gridDim.x) run_jobs(P, rb, lo, hi, smem);
        }
        else if (ph == 2 || ph == 5) {
            phase_gdn_prep(P, ph == 2 ? 0 : 1);
            __syncthreads();
            phase_gdn_chunk(P, smem);
        }
        else phase_mix(P, ph == 3 ? 0 : 1, smem);
        if (ph + 1 < PK.ph_hi) { if (ph == 0) grid.sync(); else grid_bar((unsigned*)(PK.ws + OFF_BAR), bar_gen); }
    }
}

extern "C" void kernel_launch(void* const* d_in, const int* in_sizes, int n_in, void* d_out, int out_size, void* d_ws, size_t ws_size, hipStream_t stream) {
    static int grid_blocks = 0;
    if (grid_blocks == 0) {
        if (n_in != 16 || out_size != NTOK * D || ws_size < WS_END) {
            fprintf(stderr, "kernel_launch: unexpected shapes / workspace (n_in %d out %d ws %zu need %zu)\n", n_in, out_size, ws_size, (size_t)WS_END);
            grid_blocks = -1; return;
        }
        int dev = 0, cus = 0, per_cu = 0;
        hipGetDevice(&dev);
        hipDeviceGetAttribute(&cus, hipDeviceAttributeMultiprocessorCount, dev);
        if (hipFuncSetAttribute((const void*)mega, hipFuncAttributeMaxDynamicSharedMemorySize, SMEM_BYTES) != hipSuccess) { fprintf(stderr, "hipFuncSetAttribute failed\n"); grid_blocks = -1; return; }
        hipOccupancyMaxActiveBlocksPerMultiprocessor(&per_cu, (const void*)mega, NTHREADS, SMEM_BYTES);
        if (per_cu < 1) per_cu = 1;
        grid_blocks = cus * per_cu;
        if (grid_blocks > NRB) grid_blocks = NRB;
    }
    if (grid_blocks < 0) return;
    Params P{};
    P.x = (const float*)d_in[0]; P.p = (const float*)d_in[1]; P.ln_g = (const float*)d_in[2]; P.ln_b = (const float*)d_in[3];
    P.ffn_w_in = (const float*)d_in[4]; P.ffn_w_out = (const float*)d_in[5]; P.mix_w_in = (const float*)d_in[6]; P.gdn_conv_w = (const float*)d_in[7];
    P.gdn_a_log = (const float*)d_in[8]; P.gdn_dt_bias = (const float*)d_in[9]; P.gdn_norm_w = (const float*)d_in[10]; P.sc_conv_w = (const float*)d_in[11];
    P.mix_w_out = (const float*)d_in[12]; P.ple_w_proj = (const float*)d_in[13]; P.ple_w_gate = (const float*)d_in[14]; P.ple_b_gate = (const float*)d_in[15];
    P.out = (float*)d_out; P.ws = (unsigned char*)d_ws;
#if N_LAUNCH_MODE == 1
    P.ph_lo = 0; P.ph_hi = NPH;
    void* args[] = {&P};
    hipError_t e = hipLaunchCooperativeKernel((const void*)mega, dim3(grid_blocks), dim3(NTHREADS), args, SMEM_BYTES, stream);
    if (e != hipSuccess) fprintf(stderr, "cooperative launch failed: %s (grid %d)\n", hipGetErrorString(e), grid_blocks);
#else
    for (int ph = 0; ph < NPH; ++ph) {
        P.ph_lo = ph; P.ph_hi = ph + 1;
        void* args[] = {&P};
        hipError_t e = hipLaunchCooperativeKernel((const void*)mega, dim3(grid_blocks), dim3(NTHREADS), args, SMEM_BYTES, stream);
        if (e != hipSuccess) fprintf(stderr, "launch failed: %s (grid %d)\n", hipGetErrorString(e), grid_blocks);
    }
#endif
}
```

```cpp
#include <hip/hip_runtime.h>
#include <hip/hip_cooperative_groups.h>
#include <cstdio>
#include <cstdint>
namespace cg = cooperative_groups;

#define DI __device__ __forceinline__
typedef unsigned short bf16_t;
typedef short bf16x8 __attribute__((ext_vector_type(8)));
typedef float f32x4 __attribute__((ext_vector_type(4)));
typedef unsigned u32x4 __attribute__((ext_vector_type(4)));
typedef unsigned u32x2 __attribute__((ext_vector_type(2)));
typedef __bf16 bf2_t __attribute__((ext_vector_type(2)));
typedef float f2_t __attribute__((ext_vector_type(2)));

#ifndef PROBE_GEMM2
#define PROBE_GEMM2 0
#endif
#ifndef PROBE_MIX2
#define PROBE_MIX2 0
#endif
#ifndef PROBE_PREP2
#define PROBE_PREP2 0
#endif
#ifndef PROBE_GPREP2
#define PROBE_GPREP2 0
#endif
#ifndef PROBE_SCAN2
#define PROBE_SCAN2 0
#endif
#ifndef PROBE_SBSC2
#define PROBE_SBSC2 0
#endif
#ifndef PROBE_TILES2
#define PROBE_TILES2 0
#endif
#ifndef N_LAUNCH_MODE
#define N_LAUNCH_MODE 1
#endif

constexpr int D = 1024, BATCH = 4, SEQ = 8192, NTOK = BATCH * SEQ, DEPTH = 2;
constexpr int DFF = 2816, PLE = 256;
constexpr int PJ = 3584;
constexpr int PJN = 3840;
constexpr int RB = 128;
constexpr int NRB = NTOK / RB;
constexpr float ALPHA = 1.41421356237f;
constexpr int NTHREADS = 512;

constexpr size_t SZ_W1 = (size_t)2 * DFF * D * 2;
constexpr size_t SZ_W2 = (size_t)D * DFF * 2;
constexpr size_t SZ_WIN = (size_t)PJN * D * 2;
constexpr size_t SZ_WSQ = (size_t)D * D * 2;
constexpr size_t SZ_WP = (size_t)D * PLE * 2;
constexpr size_t OFF_W1 = 0;
constexpr size_t OFF_W2 = OFF_W1 + 4 * SZ_W1;
constexpr size_t OFF_WIN = OFF_W2 + 4 * SZ_W2;
constexpr size_t OFF_WOUT = OFF_WIN + 2 * SZ_WIN;
constexpr size_t OFF_WG = OFF_WOUT + 2 * SZ_WSQ;
constexpr size_t OFF_WP = OFF_WG + 2 * SZ_WSQ;
constexpr size_t OFF_XB = OFF_WP + 2 * SZ_WP;
constexpr size_t OFF_U = OFF_XB + (size_t)NTOK * D * 2;
constexpr size_t OFF_GQ = OFF_U + (size_t)NTOK * PJ * 2;
constexpr size_t OFF_AB = OFF_GQ + (size_t)NTOK * 1536 * 2;
constexpr size_t OFF_GB = OFF_AB + (size_t)NTOK * 8 * 4;
constexpr size_t OFF_GL = OFF_GB + (size_t)NTOK * 8 * 4;
constexpr size_t OFF_BAR = OFF_GL + 2048 * 4;
constexpr size_t OFF_HALO = OFF_BAR + 128;
constexpr size_t OFF_ST = OFF_HALO + (size_t)NRB * 3 * 1536 * 2;
constexpr size_t WS_END = OFF_ST + (size_t)NTOK * 2 * 4;

struct Params {
    const float *x, *p, *ln_g, *ln_b, *ffn_w_in, *ffn_w_out, *mix_w_in, *gdn_conv_w, *gdn_a_log, *gdn_dt_bias, *gdn_norm_w, *sc_conv_w,
        *mix_w_out, *ple_w_proj, *ple_w_gate, *ple_b_gate;
    float* out;
    unsigned char* ws;
    int ph_lo, ph_hi;
};

DI unsigned pk_bf16(float a, float b) { bf2_t v = __builtin_convertvector((f2_t){a, b}, bf2_t); return __builtin_bit_cast(unsigned, v); }
DI float bf_lo(unsigned u) { return __uint_as_float(u << 16); }
DI float bf_hi(unsigned u) { return __uint_as_float(u & 0xffff0000u); }
DI float bf2f(bf16_t h) { return __uint_as_float(((unsigned)h) << 16); }
DI float sigmoidf_(float x) { return __builtin_amdgcn_rcpf(1.0f + __expf(-x)); }
DI float softplusf_(float x) { return fmaxf(x, 0.f) + log1pf(__expf(-fabsf(x))); }
DI float wave_sum(float v) {
#pragma unroll
    for (int o = 32; o >= 1; o >>= 1) v += __shfl_xor(v, o);
    return v;
}

DI int tid_() { int t = threadIdx.x; asm volatile("" : "+v"(t)); return t; }
DI void glds16(const void* gsrc, unsigned lds_dst) {
    unsigned keep;
    asm volatile("s_mov_b32 %0, m0\n\ts_mov_b32 m0, %2\n\ts_nop 0\n\tglobal_load_lds_dwordx4 %1, off\n\ts_mov_b32 m0, %0" : "=&s"(keep) : "v"(gsrc), "s"(lds_dst) : "memory");
}
DI void glds16x6(const void* sa, const void* sb, unsigned va0, unsigned va1, unsigned vb0, unsigned vb1, unsigned vb2, unsigned vb3, unsigned lds_dst) {
    unsigned keep;
    asm volatile("s_mov_b32 %0, m0\n\ts_mov_b32 m0, %9\n\ts_nop 0\n\t"
                 "global_load_lds_dwordx4 %3, %1\n\ts_add_u32 m0, m0, 0x2000\n\ts_nop 0\n\t"
                 "global_load_lds_dwordx4 %4, %1\n\ts_add_u32 m0, m0, 0x2000\n\ts_nop 0\n\t"
                 "global_load_lds_dwordx4 %5, %2\n\ts_add_u32 m0, m0, 0x2000\n\ts_nop 0\n\t"
                 "global_load_lds_dwordx4 %6, %2\n\ts_add_u32 m0, m0, 0x2000\n\ts_nop 0\n\t"
                 "global_load_lds_dwordx4 %7, %2\n\ts_add_u32 m0, m0, 0x2000\n\ts_nop 0\n\t"
                 "global_load_lds_dwordx4 %8, %2\n\ts_mov_b32 m0, %0"
                 : "=&s"(keep) : "s"(sa), "s"(sb), "v"(va0), "v"(va1), "v"(vb0), "v"(vb1), "v"(vb2), "v"(vb3), "s"(lds_dst) : "memory", "scc");
}
DI void glds16x5(const void* sa, const void* sb, unsigned va, unsigned vb0, unsigned vb1, unsigned vb2, unsigned vb3, unsigned lds_dst) {
    unsigned keep;
    asm volatile("s_mov_b32 %0, m0\n\ts_mov_b32 m0, %8\n\ts_nop 0\n\t"
                 "global_load_lds_dwordx4 %3, %1\n\ts_add_u32 m0, m0, 0x2000\n\ts_nop 0\n\t"
                 "global_load_lds_dwordx4 %4, %2\n\ts_add_u32 m0, m0, 0x2000\n\ts_nop 0\n\t"
                 "global_load_lds_dwordx4 %5, %2\n\ts_add_u32 m0, m0, 0x2000\n\ts_nop 0\n\t"
                 "global_load_lds_dwordx4 %6, %2\n\ts_add_u32 m0, m0, 0x2000\n\ts_nop 0\n\t"
                 "global_load_lds_dwordx4 %7, %2\n\ts_mov_b32 m0, %0"
                 : "=&s"(keep) : "s"(sa), "s"(sb), "v"(va), "v"(vb0), "v"(vb1), "v"(vb2), "v"(vb3), "s"(lds_dst) : "memory", "scc");
}
DI void lds_barrier() { asm volatile("s_waitcnt lgkmcnt(0)\n\ts_barrier" ::: "memory"); }
constexpr int LDS_ROW = 144;
constexpr int A_STAGE = 128 * LDS_ROW;
constexpr int B_STAGE = 256 * LDS_ROW;
constexpr int STAGE = A_STAGE + B_STAGE;
constexpr int G3_A = 16384, G3_STAGE = 49152;
constexpr int H5_A = 8192, H5_STAGE = 40960;
constexpr int CHUNK_WAVE_LDS = 18944;
constexpr int SMEM_BYTES = 8 * CHUNK_WAVE_LDS;

DI void gemm_tile(const bf16_t* __restrict__ A, int lda, const bf16_t* __restrict__ Bt, int ldb, int K, unsigned char* smem, f32x4 (&acc)[4][4], bool zero = true) {
    const int tid = tid_(), lane = tid & 63, wid = tid >> 6;
    const int wm = wid >> 2, wn = wid & 3;
#pragma unroll
    for (int i = 0; i < 4; ++i)
#pragma unroll
        for (int j = 0; j < 4; ++j) if (zero) acc[i][j] = (f32x4){0.f, 0.f, 0.f, 0.f};
    const int crow = tid >> 3, ckc = tid & 7;
    const bf16_t* ag = A + (size_t)crow * lda + ckc * 8;
    const bf16_t* bg = Bt + (size_t)crow * ldb + ckc * 8;
    u32x4 ra[2], rb[4];
#pragma unroll
    for (int i = 0; i < 2; ++i) ra[i] = *(const u32x4*)(ag + (size_t)i * 64 * lda);
#pragma unroll
    for (int i = 0; i < 4; ++i) rb[i] = *(const u32x4*)(bg + (size_t)i * 64 * ldb);
    const int soff = crow * LDS_ROW + ckc * 16;
#pragma unroll
    for (int i = 0; i < 2; ++i) *(u32x4*)(smem + soff + i * 64 * LDS_ROW) = ra[i];
#pragma unroll
    for (int i = 0; i < 4; ++i) *(u32x4*)(smem + A_STAGE + soff + i * 64 * LDS_ROW) = rb[i];
    __syncthreads();
    const int nk = K >> 6;
    const int fa = (wm * 64 + (lane & 15)) * LDS_ROW + (lane >> 4) * 16;
    const int fb = A_STAGE + (wn * 64 + (lane & 15)) * LDS_ROW + (lane >> 4) * 16;
    for (int kt = 0; kt < nk; ++kt) {
        const int cur = kt & 1;
        const bool more = (kt + 1 < nk);
        if (more) {
            const int ko = (kt + 1) * 64;
#pragma unroll
            for (int i = 0; i < 2; ++i) ra[i] = *(const u32x4*)(ag + (size_t)i * 64 * lda + ko);
#pragma unroll
            for (int i = 0; i < 4; ++i) rb[i] = *(const u32x4*)(bg + (size_t)i * 64 * ldb + ko);
        }
        const unsigned char* sc = smem + cur * STAGE;
#pragma unroll
        for (int ks = 0; ks < 2; ++ks) {
            bf16x8 af[4], bfr[4];
#pragma unroll
            for (int mt = 0; mt < 4; ++mt) af[mt] = *(const bf16x8*)(sc + fa + mt * 16 * LDS_ROW + ks * 64);
#pragma unroll
            for (int nt = 0; nt < 4; ++nt) bfr[nt] = *(const bf16x8*)(sc + fb + nt * 16 * LDS_ROW + ks * 64);
#pragma unroll
            for (int mt = 0; mt < 4; ++mt)
#pragma unroll
                for (int nt = 0; nt < 4; ++nt) acc[mt][nt] = __builtin_amdgcn_mfma_f32_16x16x32_bf16(bfr[nt], af[mt], acc[mt][nt], 0, 0, 0);
        }
        if (more) {
            unsigned char* sn = smem + (cur ^ 1) * STAGE;
#pragma unroll
            for (int i = 0; i < 2; ++i) *(u32x4*)(sn + soff + i * 64 * LDS_ROW) = ra[i];
#pragma unroll
            for (int i = 0; i < 4; ++i) *(u32x4*)(sn + A_STAGE + soff + i * 64 * LDS_ROW) = rb[i];
        }
        __syncthreads();
    }
}

DI int colmap(int mode, int n) {
    if (mode == 0) return n;
    if (mode == 1) { const int a = (n >> 4) & 7; return (a & 1) * DFF + (n >> 9) * 256 + ((n >> 7) & 3) * 64 + ((n >> 2) & 3) * 16 + (a >> 1) * 4 + (n & 3); }
    if (n < 2816) return n;
    if (n < 3584) return n + 8;
    if (n < 3592) return n - 3584 + 2816;
    return -1;
}
DI void transpose_tile(const float* __restrict__ src, int Nsrc, int K, bf16_t* __restrict__ dst, int mode, int k0, int n0, float* tile  ) {
    const int tid = tid_();
    const int n4 = (tid & 15) * 4;
    const int c = colmap(mode, n0 + n4);
#pragma unroll
    for (int i = 0; i < 2; ++i) {
        const int kk = (tid >> 4) + 32 * i;
        f32x4 v = {0.f, 0.f, 0.f, 0.f};
        if (c >= 0) v = *(const f32x4*)(src + (size_t)(k0 + kk) * Nsrc + c);
        tile[kk * 65 + n4] = v[0]; tile[kk * 65 + n4 + 1] = v[1]; tile[kk * 65 + n4 + 2] = v[2]; tile[kk * 65 + n4 + 3] = v[3];
    }
    __syncthreads();
    const int n = tid >> 3, ks = (tid & 7) * 8;
    u32x4 w;
    w.x = pk_bf16(tile[(ks + 0) * 65 + n], tile[(ks + 1) * 65 + n]);
    w.y = pk_bf16(tile[(ks + 2) * 65 + n], tile[(ks + 3) * 65 + n]);
    w.z = pk_bf16(tile[(ks + 4) * 65 + n], tile[(ks + 5) * 65 + n]);
    w.w = pk_bf16(tile[(ks + 6) * 65 + n], tile[(ks + 7) * 65 + n]);
    *(u32x4*)(dst + ((size_t)((n0 >> 8) * (K >> 6) + (k0 >> 6)) * 256 + (n0 & 255) + n) * 64 + ks) = w;
    __syncthreads();
}
DI void prep_weights(const Params& P, unsigned char* smem, int L, int vb, int nvb, int part  ) {
    float* tile = (float*)smem;
    unsigned char* ws = P.ws;
    constexpr int T_W1 = 16 * 88, T_W2 = 44 * 16, T_WIN = 16 * 60, T_SQ = 16 * 16, T_WP = 4 * 16;
    constexpr int E1 = 2 * T_W1, E2 = E1 + 2 * T_W2, E3 = E2 + T_WIN, E4 = E3 + T_SQ, E5 = E4 + T_SQ, E6 = E5 + T_WP;
    for (int idx = vb; idx < E6; idx += nvb) {
        const bool early = (idx < T_W1) || (idx >= E1 && idx < E1 + T_W2) || (idx >= E2 && idx < E3);
        if (part != 2 && early != (part == 0)) continue;
        if (idx < E1) { const int j = L * 2 + idx / T_W1, t = idx % T_W1; const int kt = t / 88, nt = t % 88;
            transpose_tile(P.ffn_w_in + (size_t)j * D * 2 * DFF, 2 * DFF, D, (bf16_t*)(ws + OFF_W1 + j * SZ_W1), 1, kt * 64, nt * 64, tile); }
        else if (idx < E2) { const int q = idx - E1; const int j = L * 2 + q / T_W2, t = q % T_W2; const int kt = t / 16, nt = t % 16;
            transpose_tile(P.ffn_w_out + (size_t)j * DFF * D, D, DFF, (bf16_t*)(ws + OFF_W2 + j * SZ_W2), 0, kt * 64, nt * 64, tile); }
        else if (idx < E3) { const int t = idx - E2; const int kt = t / 60, nt = t % 60;
            transpose_tile(P.mix_w_in + (size_t)L * D * 3592, 3592, D, (bf16_t*)(ws + OFF_WIN + L * SZ_WIN), 2, kt * 64, nt * 64, tile); }
        else if (idx < E4) { const int t = idx - E3; const int kt = t / 16, nt = t % 16;
            transpose_tile(P.mix_w_out + (size_t)L * D * D, D, D, (bf16_t*)(ws + OFF_WOUT + L * SZ_WSQ), 0, kt * 64, nt * 64, tile); }
        else if (idx < E5) { const int t = idx - E4; const int kt = t / 16, nt = t % 16;
            transpose_tile(P.ple_w_gate + (size_t)L * D * D, D, D, (bf16_t*)(ws + OFF_WG + L * SZ_WSQ), 0, kt * 64, nt * 64, tile); }
        else { const int t = idx - E5; const int kt = t / 16, nt = t % 16;
            transpose_tile(P.ple_w_proj + (size_t)L * PLE * D, D, PLE, (bf16_t*)(ws + OFF_WP + L * SZ_WP), 0, kt * 64, nt * 64, tile); }
    }
}
DI void phase_prep(const Params& P, unsigned char* smem) {
    unsigned char* ws = P.ws;
    prep_weights(P, smem, 0, blockIdx.x, gridDim.x, (gridDim.x <= 64) ? 2 : 0);
    if (gridDim.x <= 64) prep_weights(P, smem, 1, blockIdx.x, gridDim.x, 2);
    if (blockIdx.x == 0 && threadIdx.x == 0) *(unsigned*)(ws + OFF_BAR) = 0u;
    bf16_t* xb = (bf16_t*)(ws + OFF_XB);
    const size_t n4 = (size_t)NTOK * D / 4;
    const int tidp = tid_();
    for (size_t i = (size_t)blockIdx.x * NTHREADS + tidp; i < n4; i += (size_t)gridDim.x * NTHREADS) {
        const f32x4 v = *(const f32x4*)(P.x + i * 4);
        u32x2 w; w.x = pk_bf16(v[0], v[1]); w.y = pk_bf16(v[2], v[3]);
        *(u32x2*)(xb + i * 4) = w;
    }
}

DI void ln_rows(float* xr, bf16_t* xbr, const float* __restrict__ g, const float* __restrict__ b, float* stp, bool write_f32) {
    const int tidl = tid_();
    const int lane = tidl & 63, wid = tidl >> 6;
    f32x4 gv[4], bv[4];
#pragma unroll
    for (int i = 0; i < 4; ++i) { gv[i] = *(const f32x4*)(g + i * 256 + lane * 4); bv[i] = *(const f32x4*)(b + i * 256 + lane * 4); }
    for (int r0 = wid * 16; r0 < wid * 16 + 16; r0 += 4) {
        f32x4 v[4][4];
#pragma unroll
        for (int q = 0; q < 4; ++q)
#pragma unroll
            for (int i = 0; i < 4; ++i) v[q][i] = *(const f32x4*)(xr + (size_t)(r0 + q) * D + i * 256 + lane * 4);
        float s[4], qq[4];
#pragma unroll
        for (int q = 0; q < 4; ++q) {
            s[q] = 0.f;
#pragma unroll
            for (int i = 0; i < 4; ++i) s[q] += (v[q][i][0] + v[q][i][1]) + (v[q][i][2] + v[q][i][3]);
        }
#pragma unroll
        for (int o = 32; o >= 1; o >>= 1)
#pragma unroll
            for (int q = 0; q < 4; ++q) s[q] += __shfl_xor(s[q], o);
#pragma unroll
        for (int q = 0; q < 4; ++q) {
            const float mu = s[q] * (1.0f / D);
            qq[q] = 0.f;
#pragma unroll
            for (int i = 0; i < 4; ++i) { v[q][i] = v[q][i] - mu; qq[q] += (v[q][i][0] * v[q][i][0] + v[q][i][1] * v[q][i][1]) + (v[q][i][2] * v[q][i][2] + v[q][i][3] * v[q][i][3]); }
        }
#pragma unroll
        for (int o = 32; o >= 1; o >>= 1)
#pragma unroll
            for (int q = 0; q < 4; ++q) qq[q] += __shfl_xor(qq[q], o);
#pragma unroll
        for (int q = 0; q < 4; ++q) {
            const float rs = rsqrtf(qq[q] * (1.0f / D) + 1e-5f);
            if (lane == 0) { stp[(r0 + q) * 2] = s[q] * (1.0f / D); stp[(r0 + q) * 2 + 1] = rs; }
#pragma unroll
            for (int i = 0; i < 4; ++i) {
                const f32x4 o = v[q][i] * rs * gv[i] + bv[i];
                if (write_f32) *(f32x4*)(xr + (size_t)(r0 + q) * D + i * 256 + lane * 4) = o;
                if (!write_f32) {
                    u32x2 w; w.x = pk_bf16(o[0], o[1]); w.y = pk_bf16(o[2], o[3]);
                    *(u32x2*)(xbr + (size_t)(r0 + q) * D + i * 256 + lane * 4) = w;
                }
            }
        }
    }
}

DI void run_jobs(const Params& P, int rb, int jj_lo, int jj_hi, unsigned char* smem) {
    float* xr = P.out + (size_t)rb * RB * D;
    bf16_t* xbr = (bf16_t*)(P.ws + OFF_XB) + (size_t)rb * RB * D;
    bf16_t* ureg = (bf16_t*)(P.ws + OFF_U) + (size_t)rb * RB * PJ;
    float* pps = (float*)ureg;
    bf16_t* pbf = (bf16_t*)((unsigned char*)ureg + (size_t)RB * D * 4);
    float* ab = (float*)(P.ws + OFF_AB) + (size_t)rb * RB * 8;
    for (int jj = jj_lo; jj < jj_hi; ++jj) {
        const int tid = tid_(), lane = tid & 63, wid = tid >> 6, wm = wid >> 2, wn = wid & 3;
        const int l = jj >> 3, j = jj & 7;
        if (j == 3) {
            const int hh = lane >> 4, cl = (lane & 15) * 8;
            const float* nw = P.gdn_norm_w + (size_t)l * 128 + cl;
            const f32x4 nw0 = *(const f32x4*)nw, nw1 = *(const f32x4*)(nw + 4);
            for (int r0 = wid * 16; r0 < wid * 16 + 16; r0 += 4) {
                u32x4 ov[4], zv[4];
#pragma unroll
                for (int q = 0; q < 4; ++q) {
                    ov[q] = *(const u32x4*)(xbr + (size_t)(r0 + q) * D + 256 + hh * 128 + cl);
                    zv[q] = *(const u32x4*)(ureg + (size_t)(r0 + q) * PJ + 2304 + hh * 128 + cl);
                }
#pragma unroll
                for (int q = 0; q < 4; ++q) {
                    float o[8], z[8];
#pragma unroll
                    for (int e = 0; e < 4; ++e) { o[2 * e] = bf_lo(ov[q][e]); o[2 * e + 1] = bf_hi(ov[q][e]); z[2 * e] = bf_lo(zv[q][e]); z[2 * e + 1] = bf_hi(zv[q][e]); }
                    float ss = 0.f;
#pragma unroll
                    for (int e = 0; e < 8; ++e) ss += o[e] * o[e];
                    ss += __shfl_xor(ss, 1); ss += __shfl_xor(ss, 2); ss += __shfl_xor(ss, 4); ss += __shfl_xor(ss, 8);
                    const float rs = rsqrtf(ss * (1.0f / 128.f) + 1e-6f);
                    float y[8];
#pragma unroll
                    for (int e = 0; e < 8; ++e) y[e] = o[e] * rs * ((e < 4) ? nw0[e & 3] : nw1[e & 3]) * (z[e] * sigmoidf_(z[e]));
                    u32x4 w; w.x = pk_bf16(y[0], y[1]); w.y = pk_bf16(y[2], y[3]); w.z = pk_bf16(y[4], y[5]); w.w = pk_bf16(y[6], y[7]);
                    *(u32x4*)(xbr + (size_t)(r0 + q) * D + 256 + hh * 128 + cl) = w;
                }
            }
            __syncthreads();
        }
        if (j == 6) {
            const float* pin = P.p + ((size_t)l * NTOK + (size_t)rb * RB) * PLE;
            for (int i = tid; i < RB * PLE / 4; i += NTHREADS) {
                const f32x4 v = *(const f32x4*)(pin + (size_t)i * 4);
                u32x2 w; w.x = pk_bf16(v[0], v[1]); w.y = pk_bf16(v[2], v[3]);
                *(u32x2*)(pbf + (size_t)i * 4) = w;
            }
            __syncthreads();
        }
        const bf16_t* A; const bf16_t* Bt; int lda, K, nt;
        if (j == 0 || j == 4) { A = xbr; lda = D; K = D; nt = 22; Bt = (const bf16_t*)(P.ws + OFF_W1 + (size_t)(l * 2 + (j >> 2)) * SZ_W1); }
        else if (j == 1 || j == 5) { A = ureg; lda = DFF; K = DFF; nt = 4; Bt = (const bf16_t*)(P.ws + OFF_W2 + (size_t)(l * 2 + (j >> 2)) * SZ_W2); }
        else if (j == 2) { A = xbr; lda = D; K = D; nt = 14; Bt = (const bf16_t*)(P.ws + OFF_WIN + (size_t)l * SZ_WIN); }
        else if (j == 3) { A = xbr; lda = D; K = D; nt = 4; Bt = (const bf16_t*)(P.ws + OFF_WOUT + (size_t)l * SZ_WSQ); }
        else if (j == 6) { A = pbf; lda = PLE; K = PLE; nt = 4; Bt = (const bf16_t*)(P.ws + OFF_WP + (size_t)l * SZ_WP); }
        else { A = xbr; lda = D; K = D; nt = 4; Bt = (const bf16_t*)(P.ws + OFF_WG + (size_t)l * SZ_WSQ); }
        const float* resid = (jj == 1) ? (P.x + (size_t)rb * RB * D) : xr;
        const float rsc = (j == 3) ? 1.0f : 0.5f;
        const float* bgate = P.ple_b_gate + (size_t)l * D;
        float* stp = (float*)(P.ws + OFF_ST) + (size_t)rb * RB * 2;
        const bool rec = (j == 1 || j == 3 || j == 5 || j == 7) && (jj != 1);
        const int lsrc = (j == 1) ? (l * 4 - 1) : (l * 4 + ((j - 3) >> 1));
        const float* lng = P.ln_g + (size_t)(rec ? lsrc : 0) * D;
        const float* lnb = P.ln_b + (size_t)(rec ? lsrc : 0) * D;
        {
            const int nk = K >> 5, nk64 = K >> 6, ntw = nt >> 1, S = ntw * nk;
            const int drow = tid >> 2, kcs = (tid & 3) ^ ((4 - ((tid >> 4) & 3)) & 3);
            const unsigned va = (unsigned)((drow * lda + kcs * 8) * 2);
            const unsigned vb0 = (unsigned)((drow * 64 + kcs * 8) * 2), vb1 = vb0 + 16384u;
            const unsigned vb2 = vb0 + (unsigned)nk64 * 32768u, vb3 = vb2 + 16384u;
            const unsigned lbase = (unsigned)(size_t)smem + (unsigned)__builtin_amdgcn_readfirstlane(wid) * 1024u;
            const int r16 = lane & 15, q4 = lane >> 4;
            const int ko = ((q4 ^ ((4 - (r16 >> 2)) & 3)) << 4);
            const int fa = (wm * 64 + r16) * 64 + ko, fb = H5_A + (wn * 128 + r16) * 64 + ko;
            f32x4 acc[4][8];
#pragma unroll
            for (int i = 0; i < 4; ++i)
#pragma unroll
                for (int jq = 0; jq < 8; ++jq) acc[i][jq] = (f32x4){0.f, 0.f, 0.f, 0.f};
            const int toff = (int)((blockIdx.x & 7u) * (unsigned)ntw) >> 3;
            const int koff = (int)((blockIdx.x >> 3) * (unsigned)nk) >> 5;
            int kp = 0, sp = 0, tp = toff;
            const bf16_t* pbt = Bt + (size_t)toff * 512 * K;
#define ISSUE() do { const int ka_ = (kp + koff >= nk) ? kp + koff - nk : kp + koff; \
                glds16x5(A + ka_ * 32, pbt + (size_t)(ka_ >> 1) * 16384 + (ka_ & 1) * 32, va, vb0, vb1, vb2, vb3, lbase + (unsigned)sp * H5_STAGE); \
                ++kp; if (kp == nk) { kp = 0; ++tp; pbt += (size_t)512 * K; if (tp == ntw) { tp = 0; pbt = Bt; } } sp = (sp == 2) ? 0 : sp + 1; } while (0)
            ISSUE();
            ISSUE();
            ISSUE();
            asm volatile("s_waitcnt vmcnt(10)" ::: "memory");
            lds_barrier();
            int kt = 0, t = toff, st = 0;
            for (int s = 0; s < S; ++s) {
                const unsigned char* sc_ = smem + st * H5_STAGE;
                bf16x8 af[4], bfr[8];
#pragma unroll
                for (int mt = 0; mt < 4; ++mt) af[mt] = *(const bf16x8*)(sc_ + fa + mt * 1024);
#pragma unroll
                for (int n_ = 0; n_ < 8; ++n_) bfr[n_] = *(const bf16x8*)(sc_ + fb + n_ * 1024);
                if (kt == 0) {
#pragma unroll
                    for (int i = 0; i < 4; ++i)
#pragma unroll
                        for (int jq = 0; jq < 8; ++jq) acc[i][jq] = (f32x4){0.f, 0.f, 0.f, 0.f};
                }
#pragma unroll
                for (int mt = 0; mt < 4; ++mt)
#pragma unroll
                    for (int n_ = 0; n_ < 8; ++n_) acc[mt][n_] = __builtin_amdgcn_mfma_f32_16x16x32_bf16(bfr[n_], af[mt], acc[mt][n_], 0, 0, 0);
                if (s + 2 < S) asm volatile("s_waitcnt vmcnt(5)" ::: "memory");
                else asm volatile("s_waitcnt vmcnt(0)" ::: "memory");
                lds_barrier();
                if (s + 3 < S) ISSUE();
                st = (st == 2) ? 0 : st + 1;
                ++kt;
                if (kt == nk) {
                    kt = 0;
                    const int row0 = wm * 64 + r16;
                    const int col0 = t * 512 + wn * 128 + q4 * 4;
                    if (j == 0 || j == 4) {
                        bf16_t* hp = ureg + (size_t)row0 * DFF + t * 256 + wn * 64 + q4 * 16;
#pragma unroll
                        for (int mt = 0; mt < 4; ++mt) {
                            float hv[16];
#pragma unroll
                            for (int pr = 0; pr < 4; ++pr)
#pragma unroll
                                for (int r = 0; r < 4; ++r) { const float g = acc[mt][2 * pr][r]; hv[pr * 4 + r] = g * sigmoidf_(g) * acc[mt][2 * pr + 1][r]; }
                            u32x4 w0, w1;
                            w0.x = pk_bf16(hv[0], hv[1]); w0.y = pk_bf16(hv[2], hv[3]); w0.z = pk_bf16(hv[4], hv[5]); w0.w = pk_bf16(hv[6], hv[7]);
                            w1.x = pk_bf16(hv[8], hv[9]); w1.y = pk_bf16(hv[10], hv[11]); w1.z = pk_bf16(hv[12], hv[13]); w1.w = pk_bf16(hv[14], hv[15]);
                            *(u32x4*)(hp + (size_t)mt * 16 * DFF) = w0;
                            *(u32x4*)(hp + (size_t)mt * 16 * DFF + 8) = w1;
                        }
                    } else if (j == 1 || j == 5 || j == 3) {
#pragma unroll
                        for (int mt = 0; mt < 4; ++mt)
#pragma unroll
                            for (int nn = 0; nn < 8; ++nn) {
                                if ((nn & 3) == 0) asm volatile("" ::: "memory");
                                const size_t o = (size_t)(row0 + mt * 16) * D + col0 + nn * 16;
                                f32x4 rv = *(const f32x4*)(resid + o);
                                if (rec) {
                                    const float mu = stp[(row0 + mt * 16) * 2], rs = stp[(row0 + mt * 16) * 2 + 1];
                                    rv = (rv - mu) * rs * *(const f32x4*)(lng + col0 + nn * 16) + *(const f32x4*)(lnb + col0 + nn * 16);
                                }
                                *(f32x4*)(xr + o) = rv * ALPHA + acc[mt][nn] * rsc;
                            }
                    } else if (j == 2) {
#pragma unroll
                        for (int mt = 0; mt < 4; ++mt)
#pragma unroll
                            for (int nn = 0; nn < 8; ++nn) {
                                u32x2 w; w.x = pk_bf16(acc[mt][nn][0], acc[mt][nn][1]); w.y = pk_bf16(acc[mt][nn][2], acc[mt][nn][3]);
                                *(u32x2*)(ureg + (size_t)(row0 + mt * 16) * PJ + col0 + nn * 16) = w;
                            }
                    } else if (j == 6) {
#pragma unroll
                        for (int mt = 0; mt < 4; ++mt)
#pragma unroll
                            for (int nn = 0; nn < 8; ++nn) *(f32x4*)(pps + (size_t)(row0 + mt * 16) * D + col0 + nn * 16) = acc[mt][nn];
                    } else {
#pragma unroll
                        for (int mt = 0; mt < 4; ++mt)
#pragma unroll
                            for (int nn = 0; nn < 8; ++nn) {
                                if ((nn & 1) == 0) asm volatile("" ::: "memory");
                                const size_t o = (size_t)(row0 + mt * 16) * D + col0 + nn * 16;
                                const f32x4 bv = *(const f32x4*)(bgate + col0 + nn * 16);
                                const f32x4 pv = *(const f32x4*)(pps + o);
                                f32x4 xv = *(const f32x4*)(xr + o);
                                {
                                    const float mu = stp[(row0 + mt * 16) * 2], rs = stp[(row0 + mt * 16) * 2 + 1];
                                    xv = (xv - mu) * rs * *(const f32x4*)(lng + col0 + nn * 16) + *(const f32x4*)(lnb + col0 + nn * 16);
                                }
                                f32x4 ov;
#pragma unroll
                                for (int r = 0; r < 4; ++r) ov[r] = xv[r] * ALPHA + sigmoidf_(acc[mt][nn][r] + bv[r]) * pv[r];
                                *(f32x4*)(xr + o) = ov;
                            }
                    }
                    ++t; if (t == ntw) t = 0;
                }
            }
#undef ISSUE
        }
        if (j == 2) {
            const int r16 = lane & 15, q4 = lane >> 4;
            const bf16_t* arow = xbr + (size_t)(wid * 16 + r16) * D + 8 * q4;
            const bf16_t* wrow = Bt + ((size_t)(14 * 16) * 256 + r16) * 64 + 8 * q4;
            f32x4 c = {0.f, 0.f, 0.f, 0.f};
#pragma unroll 8
            for (int kk = 0; kk < 32; ++kk) {
                const bf16x8 af = *(const bf16x8*)(arow + 32 * kk);
                const bf16x8 wf = *(const bf16x8*)(wrow + (size_t)(kk >> 1) * 16384 + (kk & 1) * 32);
                c = __builtin_amdgcn_mfma_f32_16x16x32_bf16(wf, af, c, 0, 0, 0);
            }
            if (q4 < 2) *(f32x4*)(ab + (size_t)(wid * 16 + r16) * 8 + q4 * 4) = c;
            __syncthreads();
            bf16_t* halo = (bf16_t*)(P.ws + OFF_HALO) + (size_t)rb * 3 * 1536;
            for (int i = tid; i < 3 * 192; i += NTHREADS) {
                const int rr = i / 192, cc = (i % 192) * 8;
                *(u32x4*)(halo + rr * 1536 + cc) = *(const u32x4*)(ureg + (size_t)(125 + rr) * PJ + 768 + cc);
            }
        }
        __syncthreads();
        if (j == 1 || j == 3 || j == 5 || j == 7) {
            const int li = l * 4 + ((j - 1) >> 1);
            ln_rows(xr, xbr, P.ln_g + (size_t)li * D, P.ln_b + (size_t)li * D, stp, jj == 15);
            __syncthreads();
        }
    }
}

DI void phase_gdn_prep(const Params& P, int l) {
    const int tid = tid_(), lane = tid & 63, wid = tid >> 6;
    const int h = lane >> 4, cl = (lane & 15) * 8;
    const bf16_t* proj = (const bf16_t*)(P.ws + OFF_U);
    const bf16_t* halo = (const bf16_t*)(P.ws + OFF_HALO);
    bf16_t* gq = (bf16_t*)(P.ws + OFF_GQ);
    const float* cw = P.gdn_conv_w + (size_t)l * 4 * 1536;
    const float* ab = (const float*)(P.ws + OFF_AB);
    float* gb = (float*)(P.ws + OFF_GB);
    for (int rb = blockIdx.x; rb < NRB; rb += gridDim.x) {
        for (int itl = wid; itl < 96; itl += 8) {
            const int which = itl % 3, tgl = itl / 3;
            const int t0 = rb * RB + tgl * 4, s0 = t0 & (SEQ - 1);
            const int c = which * 512 + h * 128 + cl;
            f32x4 w[4][2];
#pragma unroll
            for (int i = 0; i < 4; ++i) { w[i][0] = *(const f32x4*)(cw + i * 1536 + c); w[i][1] = *(const f32x4*)(cw + i * 1536 + c + 4); }
            u32x4 x[7];
#pragma unroll
            for (int rr = 0; rr < 7; ++rr) {
                if (tgl == 0 && rr < 3) {
                    if (s0 > 0) x[rr] = *(const u32x4*)(halo + ((size_t)(rb - 1) * 3 + rr) * 1536 + c);
                    else x[rr] = (u32x4){0u, 0u, 0u, 0u};
                } else x[rr] = *(const u32x4*)(proj + (size_t)(t0 - 3 + rr) * PJ + 768 + c);
            }
#pragma unroll
            for (int tk = 0; tk < 4; ++tk) {
                float y[8];
#pragma unroll
                for (int e = 0; e < 8; ++e) y[e] = 0.f;
#pragma unroll
                for (int i = 0; i < 4; ++i)
#pragma unroll
                    for (int jj = 0; jj < 4; ++jj) {
                        y[2 * jj] += w[i][jj >> 1][(2 * jj) & 3] * bf_lo(x[tk + i][jj]);
                        y[2 * jj + 1] += w[i][jj >> 1][(2 * jj + 1) & 3] * bf_hi(x[tk + i][jj]);
                    }
                float ss = 0.f;
#pragma unroll
                for (int e = 0; e < 8; ++e) { y[e] = y[e] * sigmoidf_(y[e]); ss += y[e] * y[e]; }
                if (which < 2) {
                    ss += __shfl_xor(ss, 1); ss += __shfl_xor(ss, 2); ss += __shfl_xor(ss, 4); ss += __shfl_xor(ss, 8);
                    float sc = rsqrtf(ss + 1e-6f);
                    if (which == 0) sc *= 0.08838834764831845f;
#pragma unroll
                    for (int e = 0; e < 8; ++e) y[e] *= sc;
                }
                u32x4 o; o.x = pk_bf16(y[0], y[1]); o.y = pk_bf16(y[2], y[3]); o.z = pk_bf16(y[4], y[5]); o.w = pk_bf16(y[6], y[7]);
                *(u32x4*)(gq + (size_t)(t0 + tk) * 1536 + c) = o;
            }
        }
        {
            const int t = rb * RB + (tid >> 2), hh = tid & 3;
            const float a = ab[(size_t)t * 8 + hh], bl = ab[(size_t)t * 8 + 4 + hh];
            gb[(size_t)t * 8 + hh] = -__expf(P.gdn_a_log[l * 4 + hh]) * softplusf_(a + P.gdn_dt_bias[l * 4 + hh]);
            gb[(size_t)t * 8 + 4 + hh] = sigmoidf_(bl);
        }
    }
}

DI void sc_conv(const Params& P, int l, int vb, int nvb) {
    const bf16_t* proj = (const bf16_t*)(P.ws + OFF_U);
    bf16_t* mixed = (bf16_t*)(P.ws + OFF_XB);
    const float* w = P.sc_conv_w + (size_t)l * 3 * 256;
    const int tids = tid_();
    for (size_t it = (size_t)vb * NTHREADS + tids; it < (size_t)NTOK * 128; it += (size_t)nvb * NTHREADS) {
        const int t = (int)(it >> 7), c = (int)(it & 127) * 2;
        const int s = t & (SEQ - 1);
        float y0 = 0.f, y1 = 0.f;
#pragma unroll
        for (int i = 0; i < 3; ++i) {
            if (s - 2 + i >= 0) {
                const bf16_t* pr = proj + (size_t)(t - 2 + i) * PJ;
                const unsigned cu = *(const unsigned*)(pr + 3072 + c), hu = *(const unsigned*)(pr + 3328 + c);
                y0 += w[i * 256 + c] * (bf_lo(cu) * bf_lo(hu));
                y1 += w[i * 256 + c + 1] * (bf_hi(cu) * bf_hi(hu));
            }
        }
        const unsigned bu = *(const unsigned*)(proj + (size_t)t * PJ + 2816 + c);
        *(unsigned*)(mixed + (size_t)t * D + 768 + c) = pk_bf16(bf_lo(bu) * y0, bf_hi(bu) * y1);
    }
}

DI bf16x8 scale_frag(bf16x8 f, float s) {
    const u32x4 u = __builtin_bit_cast(u32x4, f);
    u32x4 o;
#pragma unroll
    for (int e = 0; e < 4; ++e) o[e] = pk_bf16(bf_lo(u[e]) * s, bf_hi(u[e]) * s);
    return __builtin_bit_cast(bf16x8, o);
}
typedef float f32x16 __attribute__((ext_vector_type(16)));
DI void sb_mfma(const Params& P, int vw, int nvw) {
    const bf16_t* proj = (const bf16_t*)(P.ws + OFF_U);
    bf16_t* mixed = (bf16_t*)(P.ws + OFF_XB);
    for (int it = vw; it < 4096; it += nvw) {
        const int lane = tid_() & 63, c32 = lane & 31, h2 = lane >> 5;
        const int qt = it & 255, h = (it >> 8) & 3, b = it >> 10;
        const size_t Tb = (size_t)b * SEQ, T0 = Tb + 32 * qt;
        bf16x8 qf[4];
#pragma unroll
        for (int ks = 0; ks < 4; ++ks) qf[ks] = scale_frag(*(const bf16x8*)(proj + (T0 + c32) * PJ + h * 64 + 16 * ks + 8 * h2), 0.125f);
        f32x16 O0, O1;
#pragma unroll
        for (int i = 0; i < 16; ++i) { O0[i] = 0.f; O1[i] = 0.f; }
        float carry = 0.f;
        for (int kt = qt; kt >= 0; --kt) {
            const bf16_t* kb = proj + (Tb + 32 * kt + c32) * PJ + 256 + h * 64 + 8 * h2;
            f32x16 S;
#pragma unroll
            for (int i = 0; i < 16; ++i) S[i] = 0.f;
#pragma unroll
            for (int ks = 0; ks < 4; ++ks) S = __builtin_amdgcn_mfma_f32_32x32x16_bf16(*(const bf16x8*)(kb + 16 * ks), qf[ks], S, 0, 0, 0);
            const bf16_t* vb = proj + (Tb + 32 * kt + 4 * h2) * PJ + 512 + h * 64 + c32;
            bf16x8 vf[2][2];
#pragma unroll
            for (int s2 = 0; s2 < 2; ++s2)
#pragma unroll
                for (int nt = 0; nt < 2; ++nt)
#pragma unroll
                    for (int j = 0; j < 8; ++j) vf[s2][nt][j] = (short)vb[(size_t)(16 * s2 + 8 * (j >> 2) + (j & 3)) * PJ + 32 * nt];
            const bool diag = (kt == qt);
            float ls[16], lb[16];
#pragma unroll
            for (int i = 0; i < 16; ++i) {
                const float z = S[i];
                const float sp = fmaxf(z, 0.f) + __logf(1.0f + __expf(-fabsf(z)));
                const int sl = 8 * (i >> 2) + 4 * h2 + (i & 3);
                const bool valid = !diag || (sl < c32);
                lb[i] = valid ? (z - sp) : -1e30f;
                ls[i] = valid ? -sp : 0.f;
            }
            float qs[4], pq[4], ps[4];
#pragma unroll
            for (int g = 0; g < 4; ++g) { qs[g] = (ls[4 * g] + ls[4 * g + 1]) + (ls[4 * g + 2] + ls[4 * g + 3]); pq[g] = __shfl_xor(qs[g], 32); ps[g] = qs[g] + pq[g]; }
            float R[4];
            R[3] = 0.f; R[2] = ps[3]; R[1] = R[2] + ps[2]; R[0] = R[1] + ps[1];
            float att[16];
#pragma unroll
            for (int g = 0; g < 4; ++g) {
                const float suf = carry + R[g] + ((h2 == 0) ? pq[g] : 0.f);
                const float l3 = suf, l2 = l3 + ls[4 * g + 3], l1 = l2 + ls[4 * g + 2], l0 = l1 + ls[4 * g + 1];
                att[4 * g + 3] = __expf(lb[4 * g + 3] + l3);
                att[4 * g + 2] = __expf(lb[4 * g + 2] + l2);
                att[4 * g + 1] = __expf(lb[4 * g + 1] + l1);
                att[4 * g + 0] = __expf(lb[4 * g + 0] + l0);
            }
            carry += R[0] + ps[0];
            bf16x8 af[2];
#pragma unroll
            for (int s2 = 0; s2 < 2; ++s2) {
                u32x4 u;
                u.x = pk_bf16(att[8 * s2 + 0], att[8 * s2 + 1]); u.y = pk_bf16(att[8 * s2 + 2], att[8 * s2 + 3]);
                u.z = pk_bf16(att[8 * s2 + 4], att[8 * s2 + 5]); u.w = pk_bf16(att[8 * s2 + 6], att[8 * s2 + 7]);
                af[s2] = __builtin_bit_cast(bf16x8, u);
            }
#pragma unroll
            for (int s2 = 0; s2 < 2; ++s2) {
                O0 = __builtin_amdgcn_mfma_f32_32x32x16_bf16(af[s2], vf[s2][0], O0, 0, 0, 0);
                O1 = __builtin_amdgcn_mfma_f32_32x32x16_bf16(af[s2], vf[s2][1], O1, 0, 0, 0);
            }
            if (__all(carry < -104.f)) break;
        }
        bf16_t* op = mixed + (T0 + 4 * h2) * D + h * 64 + c32;
#pragma unroll
        for (int i = 0; i < 16; ++i) {
            const int tl = (i & 3) + 8 * (i >> 2);
            op[(size_t)tl * D] = (bf16_t)(pk_bf16(O0[i], 0.f) & 0xffffu);
            op[(size_t)tl * D + 32] = (bf16_t)(pk_bf16(O1[i], 0.f) & 0xffffu);
        }
    }
}

DI void wsync() { asm volatile("s_waitcnt lgkmcnt(0)" ::: "memory"); }
DI void store_T_row(bf16_t* XT, const bf16x8 (&f)[4], float sc, int m, int r16, int q4) {
#pragma unroll
    for (int kk = 0; kk < 4; ++kk) {
        const u32x4 u = __builtin_bit_cast(u32x4, f[kk]);
#pragma unroll
        for (int e = 0; e < 4; ++e) {
            const unsigned w = pk_bf16(bf_lo(u[e]) * sc, bf_hi(u[e]) * sc);
            const int c = 32 * kk + 8 * q4 + 2 * e;
            XT[c * 72 + 16 * m + r16] = (bf16_t)(w & 0xffffu);
            XT[(c + 1) * 72 + 16 * m + r16] = (bf16_t)(w >> 16);
        }
    }
}
DI u32x2 pack4(const f32x4 a) { u32x2 w; w.x = pk_bf16(a[0], a[1]); w.y = pk_bf16(a[2], a[3]); return w; }

DI void phase_gdn_chunk(const Params& P, unsigned char* smem) {
    const int tid0 = tid_(), wid = tid0 >> 6;
    unsigned char* wl = smem + wid * CHUNK_WAVE_LDS;
    float* X = (float*)wl;
    bf16_t* XT = (bf16_t*)wl;
    float* gcs = (float*)(wl + 18432);
    float* bts = gcs + 64;
    bf16_t* gq = (bf16_t*)(P.ws + OFF_GQ);
    bf16_t* proj = (bf16_t*)(P.ws + OFF_U);
    const float* gb = (const float*)(P.ws + OFF_GB);
    float* glw = (float*)(P.ws + OFF_GL);
    for (int it = blockIdx.x * 8 + wid; it < 2048; it += gridDim.x * 8) {
        const int lane = tid_() & 63, r16 = lane & 15, q4 = lane >> 4;
        const int h = it & 3, c = (it >> 2) & 127, b = it >> 9;
        const size_t t0 = (size_t)b * SEQ + (size_t)c * 64;
        float gc = gb[(t0 + lane) * 8 + h];
        const float bt = gb[(t0 + lane) * 8 + 4 + h];
#pragma unroll
        for (int o = 1; o < 64; o <<= 1) { const float v = __shfl_up(gc, o); if (lane >= o) gc += v; }
        gcs[lane] = gc; bts[lane] = bt;
        const float gtot = __shfl(gc, 63);
        if (lane == 0) glw[it] = __expf(gtot);
        wsync();
        bf16x8 kf[4][4];
        {
            const bf16_t* kb = gq + t0 * 1536 + 512 + h * 128 + (size_t)r16 * 1536 + 8 * q4;
#pragma unroll
            for (int m = 0; m < 4; ++m)
#pragma unroll
                for (int kk = 0; kk < 4; ++kk) kf[m][kk] = *(const bf16x8*)(kb + (size_t)m * 16 * 1536 + 32 * kk);
        }
#pragma unroll
        for (int mi = 0; mi < 4; ++mi)
#pragma unroll
            for (int mj = 0; mj <= mi; ++mj) {
                f32x4 a = {0.f, 0.f, 0.f, 0.f};
#pragma unroll
                for (int kk = 0; kk < 4; ++kk) a = __builtin_amdgcn_mfma_f32_16x16x32_bf16(kf[mi][kk], kf[mj][kk], a, 0, 0, 0);
                const int j = 16 * mj + r16;
                const float gj = gcs[j];
                const f32x4 gi = *(const f32x4*)(gcs + 16 * mi + 4 * q4);
                const f32x4 bi = *(const f32x4*)(bts + 16 * mi + 4 * q4);
#pragma unroll
                for (int r = 0; r < 4; ++r) {
                    const int i = 16 * mi + 4 * q4 + r;
                    X[i * 68 + j] = (i > j) ? bi[r] * a[r] * __expf(fminf(gi[r] - gj, 0.f)) : 0.f;
                }
            }
        {
            bf16_t* qb = gq + t0 * 1536 + h * 128 + (size_t)r16 * 1536 + 8 * q4;
#pragma unroll
            for (int mi = 0; mi < 4; ++mi) {
                bf16x8 qf[4];
#pragma unroll
                for (int kk = 0; kk < 4; ++kk) qf[kk] = *(const bf16x8*)(qb + (size_t)mi * 16 * 1536 + 32 * kk);
                const int i = 16 * mi + r16;
                const float gi = gcs[i];
                bf16_t* qkrow = proj + (t0 + i) * PJ + 1792 + h * 128 + 4 * q4;
#pragma unroll
                for (int mj = 0; mj < 4; ++mj) {
                    u32x2 w = {0u, 0u};
                    if (mj <= mi) {
                        f32x4 a = {0.f, 0.f, 0.f, 0.f};
#pragma unroll
                        for (int kk = 0; kk < 4; ++kk) a = __builtin_amdgcn_mfma_f32_16x16x32_bf16(kf[mj][kk], qf[kk], a, 0, 0, 0);
                        const f32x4 gj = *(const f32x4*)(gcs + 16 * mj + 4 * q4);
                        f32x4 v;
#pragma unroll
                        for (int r = 0; r < 4; ++r) { const int j = 16 * mj + 4 * q4 + r; v[r] = (j <= i) ? a[r] * __expf(fminf(gi - gj[r], 0.f)) : 0.f; }
                        w = pack4(v);
                    }
                    *(u32x2*)(qkrow + 16 * mj) = w;
                }
                const float s = __expf(gi);
#pragma unroll
                for (int kk = 0; kk < 4; ++kk) *(bf16x8*)(qb + (size_t)mi * 16 * 1536 + 32 * kk) = scale_frag(qf[kk], s);
            }
        }
        wsync();
        {
            float Tc[64];
#pragma unroll
            for (int i = 0; i < 64; ++i) Tc[i] = 0.f;
            Tc[0] = (lane == 0) ? 1.f : 0.f;
#pragma unroll
            for (int i = 1; i < 64; ++i) {
                float a0 = 0.f, a1 = 0.f, a2 = 0.f, a3 = 0.f;
#pragma unroll
                for (int jj = 0; jj < (i + 3) / 4; ++jj) {
                    const f32x4 m4 = *(const f32x4*)(X + i * 68 + 4 * jj);
                    a0 += m4[0] * Tc[4 * jj]; a1 += m4[1] * Tc[4 * jj + 1]; a2 += m4[2] * Tc[4 * jj + 2]; a3 += m4[3] * Tc[4 * jj + 3];
                }
                Tc[i] = ((lane == i) ? 1.f : 0.f) - ((a0 + a1) + (a2 + a3));
            }
            wsync();
#pragma unroll
            for (int i = 0; i < 64; ++i) X[i * 68 + lane] = Tc[i];
            wsync();
        }
        {
            const bf16_t* kb = gq + t0 * 1536 + 512 + h * 128 + (size_t)r16 * 1536 + 8 * q4;
#pragma unroll
            for (int m = 0; m < 4; ++m)
#pragma unroll
                for (int kk = 0; kk < 4; ++kk) kf[m][kk] = *(const bf16x8*)(kb + (size_t)m * 16 * 1536 + 32 * kk);
        }
        bf16x8 Tf[4][2];
#pragma unroll
        for (int mi = 0; mi < 4; ++mi)
#pragma unroll
            for (int ks = 0; ks < 2; ++ks) {
                const float* xp = X + (16 * mi + r16) * 68 + 32 * ks + 8 * q4;
                const f32x4 a = *(const f32x4*)xp, bb = *(const f32x4*)(xp + 4);
                u32x4 u; u.x = pk_bf16(a[0], a[1]); u.y = pk_bf16(a[2], a[3]); u.z = pk_bf16(bb[0], bb[1]); u.w = pk_bf16(bb[2], bb[3]);
                Tf[mi][ks] = __builtin_bit_cast(bf16x8, u);
            }
        float sk[4];
#pragma unroll
        for (int m = 0; m < 4; ++m) sk[m] = bts[16 * m + r16] * __expf(gcs[16 * m + r16]);
        wsync();
#pragma unroll
        for (int m = 0; m < 4; ++m) store_T_row(XT, kf[m], sk[m], m, r16, q4);
        wsync();
#pragma unroll
        for (int md = 0; md < 8; ++md) {
            bf16x8 af[2];
#pragma unroll
            for (int ks = 0; ks < 2; ++ks) af[ks] = *(const bf16x8*)(XT + (16 * md + r16) * 72 + 32 * ks + 8 * q4);
#pragma unroll
            for (int mi = 0; mi < 4; ++mi) {
                f32x4 a = {0.f, 0.f, 0.f, 0.f};
#pragma unroll
                for (int ks = 0; ks < 2; ++ks) a = __builtin_amdgcn_mfma_f32_16x16x32_bf16(af[ks], Tf[mi][ks], a, 0, 0, 0);
                *(u32x2*)(proj + (t0 + 16 * mi + r16) * PJ + 768 + h * 128 + 16 * md + 4 * q4) = pack4(a);
            }
        }
        wsync();
#pragma unroll
        for (int m = 0; m < 4; ++m) sk[m] = __expf(gtot - gcs[16 * m + r16]);
#pragma unroll
        for (int m = 0; m < 4; ++m) store_T_row(XT, kf[m], sk[m], m, r16, q4);
        wsync();
#pragma unroll
        for (int e = 0; e < 16; ++e) {
            const int q = lane + 64 * e, d = q >> 3, jc = (q & 7) * 8;
            const u32x4 v = *(const u32x4*)(XT + d * 72 + jc);
            *(u32x4*)(proj + (t0 + (d >> 1)) * PJ + 1280 + h * 128 + (d & 1) * 64 + jc) = v;
        }
        wsync();
        {
            const bf16_t* vb = gq + t0 * 1536 + 1024 + h * 128 + (size_t)r16 * 1536 + 8 * q4;
#pragma unroll
            for (int m = 0; m < 4; ++m) {
                bf16x8 vf[4];
#pragma unroll
                for (int kk = 0; kk < 4; ++kk) vf[kk] = *(const bf16x8*)(vb + (size_t)m * 16 * 1536 + 32 * kk);
                store_T_row(XT, vf, bts[16 * m + r16], m, r16, q4);
            }
        }
        wsync();
#pragma unroll
        for (int nt = 0; nt < 8; ++nt) {
            bf16x8 bfv[2];
#pragma unroll
            for (int ks = 0; ks < 2; ++ks) bfv[ks] = *(const bf16x8*)(XT + (16 * nt + r16) * 72 + 32 * ks + 8 * q4);
            const int n = 16 * nt + r16;
#pragma unroll
            for (int mi = 0; mi < 4; ++mi) {
                f32x4 a = {0.f, 0.f, 0.f, 0.f};
#pragma unroll
                for (int ks = 0; ks < 2; ++ks) a = __builtin_amdgcn_mfma_f32_16x16x32_bf16(Tf[mi][ks], bfv[ks], a, 0, 0, 0);
                *(u32x2*)(gq + (t0 + (n >> 1)) * 1536 + 1024 + h * 128 + (n & 1) * 64 + 16 * mi + 4 * q4) = pack4(a);
            }
        }
        wsync();
    }
}

constexpr int SC_W = 0, SC_QD = 16384, SC_QK = 32768, SC_KD = 40960, SC_UT = 57344, SC_STAGE = 61440;
constexpr int SC_ST = 2 * SC_STAGE, SC_VT = SC_ST + 32 * 136 * 2, SC_GL = SC_VT + 32 * 72 * 2;
DI void gdn_scan(const Params& P, int item, unsigned char* smem) {
    const int tid = tid_(), lane = tid & 63, wid = tid >> 6, r16 = lane & 15, q4 = lane >> 4;
    const int ns = (item >> 3) & 3, bh = ((item & 7) << 1) | (item >> 5), h = bh & 3, b = bh >> 2;
    const int mi = wid & 3, nt = wid >> 2, md = wid;
    bf16_t* ST = (bf16_t*)(smem + SC_ST);
    bf16_t* VT = (bf16_t*)(smem + SC_VT);
    float* gls = (float*)(smem + SC_GL);
    const bf16_t* proj = (const bf16_t*)(P.ws + OFF_U);
    const bf16_t* gq = (const bf16_t*)(P.ws + OFF_GQ);
    const float* glw = (const float*)(P.ws + OFF_GL);
    bf16_t* mixed = (bf16_t*)(P.ws + OFF_XB);
    for (int i = tid; i < 32 * 136 / 2; i += NTHREADS) ((unsigned*)ST)[i] = 0u;
    if (tid < 128) gls[tid] = glw[((b * 128 + tid) << 2) + h];
    const size_t tb = (size_t)b * SEQ;
    const int r4 = tid >> 4, k16 = (tid & 15) ^ (r4 & 15), k8 = (tid & 7) ^ (r4 & 7);
    const bf16_t* pw = proj + (tb + r4) * PJ + 768 + h * 128 + k16 * 8;
    const bf16_t* pq = gq + (tb + r4) * 1536 + h * 128 + k16 * 8;
    const bf16_t* pk = proj + (tb + (tid >> 3)) * PJ + 1792 + h * 128 + k8 * 8;
    const bf16_t* pd = proj + (tb + r4) * PJ + 1280 + h * 128 + ((tid >> 3) & 1) * 64 + k8 * 8;
    const int nu = ns * 32 + ((tid >> 3) & 31);
    const bf16_t* pu = gq + (tb + (nu >> 1)) * 1536 + 1024 + h * 128 + (nu & 1) * 64 + (tid & 7) * 8;
    const unsigned lbase = (unsigned)(size_t)smem + (unsigned)__builtin_amdgcn_readfirstlane(wid) * 1024u;
    const bool uwave = (__builtin_amdgcn_readfirstlane(wid) < 4);
#define SC_ISSUE(c_) do { const unsigned dst_ = lbase + (unsigned)((c_) & 1) * SC_STAGE; const size_t o1_ = (size_t)(c_) * 64 * PJ, o2_ = (size_t)(c_) * 64 * 1536; \
        glds16(pw + o1_, dst_ + SC_W); glds16(pw + o1_ + (size_t)32 * PJ, dst_ + SC_W + 8192u); \
        glds16(pq + o2_, dst_ + SC_QD); glds16(pq + o2_ + (size_t)32 * 1536, dst_ + SC_QD + 8192u); \
        glds16(pk + o1_, dst_ + SC_QK); \
        glds16(pd + o1_, dst_ + SC_KD); glds16(pd + o1_ + (size_t)32 * PJ, dst_ + SC_KD + 8192u); \
        if (uwave) glds16(pu + o2_, dst_ + SC_UT); } while (0)
    const int ow = (16 * mi + r16) * 256, oqk = SC_QK + (16 * mi + r16) * 128, okd = SC_KD + (16 * md + r16) * 128;
    const int out = SC_UT + (16 * nt + r16) * 128 + (16 * mi + 4 * q4) * 2;
    const int x8 = r16 >> 1;
    f32x4 accS[2] = {{0.f, 0.f, 0.f, 0.f}, {0.f, 0.f, 0.f, 0.f}};
    SC_ISSUE(0);
    asm volatile("s_waitcnt vmcnt(0)" ::: "memory");
    __syncthreads();
    for (int c = 0; c < 128; ++c) {
        if (c + 1 < 128) SC_ISSUE(c + 1);
        const unsigned char* sg = smem + (c & 1) * SC_STAGE;
        f32x4 aP = {0.f, 0.f, 0.f, 0.f}, aO = {0.f, 0.f, 0.f, 0.f};
#pragma unroll
        for (int kk = 0; kk < 4; ++kk) {
            const bf16x8 sf = *(const bf16x8*)(ST + (16 * nt + r16) * 136 + 32 * kk + 8 * q4);
            const int co = (((4 * kk + q4) ^ r16) << 4);
            const bf16x8 wf = *(const bf16x8*)(sg + SC_W + ow + co);
            const bf16x8 qd = *(const bf16x8*)(sg + SC_QD + ow + co);
            aP = __builtin_amdgcn_mfma_f32_16x16x32_bf16(wf, sf, aP, 0, 0, 0);
            aO = __builtin_amdgcn_mfma_f32_16x16x32_bf16(qd, sf, aO, 0, 0, 0);
        }
        {
            const u32x2 uu = *(const u32x2*)(sg + out);
            f32x4 vn;
            vn[0] = bf_lo(uu.x) - aP[0]; vn[1] = bf_hi(uu.x) - aP[1]; vn[2] = bf_lo(uu.y) - aP[2]; vn[3] = bf_hi(uu.y) - aP[3];
            *(u32x2*)(VT + (16 * nt + r16) * 72 + 16 * mi + 4 * q4) = pack4(vn);
        }
        lds_barrier();
#pragma unroll
        for (int ks = 0; ks < 2; ++ks) {
            const bf16x8 vf = *(const bf16x8*)(VT + (16 * nt + r16) * 72 + 32 * ks + 8 * q4);
            const bf16x8 qk = *(const bf16x8*)(sg + oqk + (((4 * ks + q4) ^ x8) << 4));
            aO = __builtin_amdgcn_mfma_f32_16x16x32_bf16(qk, vf, aO, 0, 0, 0);
        }
        {
            bf16_t* op = mixed + (tb + (size_t)c * 64 + 16 * mi + 4 * q4) * D + 256 + h * 128 + ns * 32 + 16 * nt + r16;
#pragma unroll
            for (int r = 0; r < 4; ++r) op[(size_t)r * D] = (bf16_t)(pk_bf16(aO[r], 0.f) & 0xffffu);
        }
        const float gl = gls[c];
        bf16x8 kd[2];
#pragma unroll
        for (int ks = 0; ks < 2; ++ks) kd[ks] = *(const bf16x8*)(sg + okd + (((4 * ks + q4) ^ x8) << 4));
#pragma unroll
        for (int n2 = 0; n2 < 2; ++n2) {
            accS[n2] = accS[n2] * gl;
#pragma unroll
            for (int ks = 0; ks < 2; ++ks) {
                const bf16x8 vf = *(const bf16x8*)(VT + (16 * n2 + r16) * 72 + 32 * ks + 8 * q4);
                accS[n2] = __builtin_amdgcn_mfma_f32_16x16x32_bf16(kd[ks], vf, accS[n2], 0, 0, 0);
            }
            *(u32x2*)(ST + (16 * n2 + r16) * 136 + 16 * md + 4 * q4) = pack4(accS[n2]);
        }
        asm volatile("s_waitcnt vmcnt(0)" ::: "memory");
        lds_barrier();
    }
#undef SC_ISSUE
    __syncthreads();
}

DI void phase_mix(const Params& P, int l, unsigned char* smem) {
    const int G = gridDim.x;
    for (int it = blockIdx.x; it < 64; it += G) {
        gdn_scan(P, it, smem);
#if PROBE_SCAN2
        __syncthreads();
        gdn_scan(P, it, smem);
#endif
    }
    const int nvb = (G > 64) ? (G - 64) : G;
    const int vb = (G > 64) ? ((int)blockIdx.x - 64) : (int)blockIdx.x;
    if (vb >= 0) {
        sb_mfma(P, vb * 8 + (tid_() >> 6), nvb * 8); sc_conv(P, l, vb, nvb);
#if PROBE_SBSC2
        sb_mfma(P, vb * 8 + (tid_() >> 6), nvb * 8); sc_conv(P, l, vb, nvb);
#endif
        if (l == 0 && G > 64) { __syncthreads(); prep_weights(P, smem, 0, vb, nvb, 1); prep_weights(P, smem, 1, vb, nvb, 2); }
    }
}

DI void grid_bar(unsigned* cnt, unsigned& gen) {
    __syncthreads();
    gen += gridDim.x;
    if (threadIdx.x == 0) {
        __builtin_amdgcn_fence(__ATOMIC_RELEASE, "agent");
        __hip_atomic_fetch_add(cnt, 1u, __ATOMIC_RELAXED, __HIP_MEMORY_SCOPE_AGENT);
        while (__hip_atomic_load(cnt, __ATOMIC_RELAXED, __HIP_MEMORY_SCOPE_AGENT) < gen) __builtin_amdgcn_s_sleep(2);
        __builtin_amdgcn_fence(__ATOMIC_ACQUIRE, "agent");
    }
    __syncthreads();
}

constexpr int NPH = 8;
__global__ void __launch_bounds__(NTHREADS) mega(Params PK) {
    extern __shared__ __attribute__((aligned(16))) unsigned char smem[];
    cg::grid_group grid = cg::this_grid();
    unsigned bar_gen = 0u;
    for (int ph = PK.ph_lo; ph < PK.ph_hi; ++ph) {
        const Params& P = PK;
        if (ph == 0) phase_prep(P, smem);
        else if (ph == 1 || ph == 4 || ph == 7) {
            const int lo = (ph == 1) ? 0 : (ph == 4 ? 3 : 11), hi = (ph == 1) ? 3 : (ph == 4 ? 11 : 16);
            for (int rb = blockIdx.x; rb < NRB; rb += gridDim.x) run_jobs(P, rb, lo, hi, smem);
        }
        else if (ph == 2 || ph == 5) {
            phase_gdn_prep(P, ph == 2 ? 0 : 1);
            __syncthreads();
            phase_gdn_chunk(P, smem);
        }
        else phase_mix(P, ph == 3 ? 0 : 1, smem);
        if (ph + 1 < PK.ph_hi) { if (ph == 0) grid.sync(); else grid_bar((unsigned*)(PK.ws + OFF_BAR), bar_gen); }
    }
}

extern "C" void kernel_launch(void* const* d_in, const int* in_sizes, int n_in, void* d_out, int out_size, void* d_ws, size_t ws_size, hipStream_t stream) {
    static int grid_blocks = 0;
    if (grid_blocks == 0) {
        if (n_in != 16 || out_size != NTOK * D || ws_size < WS_END) {
            fprintf(stderr, "kernel_launch: unexpected shapes / workspace (n_in %d out %d ws %zu need %zu)\n", n_in, out_size, ws_size, (size_t)WS_END);
            grid_blocks = -1; return;
        }
        int dev = 0, cus = 0, per_cu = 0;
        hipGetDevice(&dev);
        hipDeviceGetAttribute(&cus, hipDeviceAttributeMultiprocessorCount, dev);
        if (hipFuncSetAttribute((const void*)mega, hipFuncAttributeMaxDynamicSharedMemorySize, SMEM_BYTES) != hipSuccess) { fprintf(stderr, "hipFuncSetAttribute failed\n"); grid_blocks = -1; return; }
        hipOccupancyMaxActiveBlocksPerMultiprocessor(&per_cu, (const void*)mega, NTHREADS, SMEM_BYTES);
        if (per_cu < 1) per_cu = 1;
        grid_blocks = cus * per_cu;
        if (grid_blocks > NRB) grid_blocks = NRB;
    }
    if (grid_blocks < 0) return;
    Params P{};
    P.x = (const float*)d_in[0]; P.p = (const float*)d_in[1]; P.ln_g = (const float*)d_in[2]; P.ln_b = (const float*)d_in[3];
    P.ffn_w_in = (const float*)d_in[4]; P.ffn_w_out = (const float*)d_in[5]; P.mix_w_in = (const float*)d_in[6]; P.gdn_conv_w = (const float*)d_in[7];
    P.gdn_a_log = (const float*)d_in[8]; P.gdn_dt_bias = (const float*)d_in[9]; P.gdn_norm_w = (const float*)d_in[10]; P.sc_conv_w = (const float*)d_in[11];
    P.mix_w_out = (const float*)d_in[12]; P.ple_w_proj = (const float*)d_in[13]; P.ple_w_gate = (const float*)d_in[14]; P.ple_b_gate = (const float*)d_in[15];
    P.out = (float*)d_out; P.ws = (unsigned char*)d_ws;
#if N_LAUNCH_MODE == 1
    P.ph_lo = 0; P.ph_hi = NPH;
    void* args[] = {&P};
    hipError_t e = hipLaunchCooperativeKernel((const void*)mega, dim3(grid_blocks), dim3(NTHREADS), args, SMEM_BYTES, stream);
    if (e != hipSuccess) fprintf(stderr, "cooperative launch failed: %s (grid %d)\n", hipGetErrorString(e), grid_blocks);
#else
    for (int ph = 0; ph < NPH; ++ph) {
        P.ph_lo = ph; P.ph_hi = ph + 1;
        void* args[] = {&P};
        hipError_t e = hipLaunchCooperativeKernel((const void*)mega, dim3(grid_blocks), dim3(NTHREADS), args, SMEM_BYTES, stream);
        if (e != hipSuccess) fprintf(stderr, "launch failed: %s (grid %d)\n", hipGetErrorString(e), grid_blocks);
    }
#endif
}
```

```cpp
#include <hip/hip_runtime.h>
#include <hip/hip_cooperative_groups.h>
#include <cstdio>
#include <cstdint>
namespace cg = cooperative_groups;

#define DI __device__ __forceinline__
typedef unsigned short bf16_t;
typedef short bf16x8 __attribute__((ext_vector_type(8)));
typedef float f32x4 __attribute__((ext_vector_type(4)));
typedef unsigned u32x4 __attribute__((ext_vector_type(4)));
typedef unsigned u32x2 __attribute__((ext_vector_type(2)));
typedef __bf16 bf2_t __attribute__((ext_vector_type(2)));
typedef float f2_t __attribute__((ext_vector_type(2)));

#ifndef PROBE_GEMM2
#define PROBE_GEMM2 0
#endif
#ifndef PROBE_MIX2
#define PROBE_MIX2 0
#endif
#ifndef PROBE_PREP2
#define PROBE_PREP2 0
#endif
#ifndef PROBE_GPREP2
#define PROBE_GPREP2 0
#endif
#ifndef PROBE_SCAN2
#define PROBE_SCAN2 0
#endif
#ifndef PROBE_SBSC2
#define PROBE_SBSC2 0
#endif
#ifndef PROBE_TILES2
#define PROBE_TILES2 0
#endif
#ifndef N_LAUNCH_MODE
#define N_LAUNCH_MODE 1
#endif

constexpr int D = 1024, BATCH = 4, SEQ = 8192, NTOK = BATCH * SEQ, DEPTH = 2;
constexpr int DFF = 2816, PLE = 256;
constexpr int PJ = 3584;
constexpr int PJN = 3840;
constexpr int RB = 128;
constexpr int NRB = NTOK / RB;
constexpr float ALPHA = 1.41421356237f;
constexpr int NTHREADS = 512;

constexpr size_t SZ_W1 = (size_t)2 * DFF * D * 2;
constexpr size_t SZ_W2 = (size_t)D * DFF * 2;
constexpr size_t SZ_WIN = (size_t)PJN * D * 2;
constexpr size_t SZ_WSQ = (size_t)D * D * 2;
constexpr size_t SZ_WP = (size_t)D * PLE * 2;
constexpr size_t OFF_W1 = 0;
constexpr size_t OFF_W2 = OFF_W1 + 4 * SZ_W1;
constexpr size_t OFF_WIN = OFF_W2 + 4 * SZ_W2;
constexpr size_t OFF_WOUT = OFF_WIN + 2 * SZ_WIN;
constexpr size_t OFF_WG = OFF_WOUT + 2 * SZ_WSQ;
constexpr size_t OFF_WP = OFF_WG + 2 * SZ_WSQ;
constexpr size_t OFF_XB = OFF_WP + 2 * SZ_WP;
constexpr size_t OFF_U = OFF_XB + (size_t)NTOK * D * 2;
constexpr size_t OFF_GQ = OFF_U + (size_t)NTOK * PJ * 2;
constexpr size_t OFF_AB = OFF_GQ + (size_t)NTOK * 1536 * 2;
constexpr size_t OFF_GB = OFF_AB + (size_t)NTOK * 8 * 4;
constexpr size_t OFF_GL = OFF_GB + (size_t)NTOK * 8 * 4;
constexpr size_t OFF_BAR = OFF_GL + 2048 * 4;
constexpr size_t OFF_HALO = OFF_BAR + 128;
constexpr size_t OFF_ST = OFF_HALO + (size_t)NRB * 3 * 1536 * 2;
constexpr size_t WS_END = OFF_ST + (size_t)NTOK * 2 * 4;

struct Params {
    const float *x, *p, *ln_g, *ln_b, *ffn_w_in, *ffn_w_out, *mix_w_in, *gdn_conv_w, *gdn_a_log, *gdn_dt_bias, *gdn_norm_w, *sc_conv_w,
        *mix_w_out, *ple_w_proj, *ple_w_gate, *ple_b_gate;
    float* out;
    unsigned char* ws;
    int ph_lo, ph_hi;
};

DI unsigned pk_bf16(float a, float b) { bf2_t v = __builtin_convertvector((f2_t){a, b}, bf2_t); return __builtin_bit_cast(unsigned, v); }
DI float bf_lo(unsigned u) { return __uint_as_float(u << 16); }
DI float bf_hi(unsigned u) { return __uint_as_float(u & 0xffff0000u); }
DI float bf2f(bf16_t h) { return __uint_as_float(((unsigned)h) << 16); }
DI float sigmoidf_(float x) { return __builtin_amdgcn_rcpf(1.0f + __expf(-x)); }
DI float softplusf_(float x) { return fmaxf(x, 0.f) + log1pf(__expf(-fabsf(x))); }
DI u32x2 pack4(const f32x4 a) { u32x2 w; w.x = pk_bf16(a[0], a[1]); w.y = pk_bf16(a[2], a[3]); return w; }
DI float wave_sum(float v) {
#pragma unroll
    for (int o = 32; o >= 1; o >>= 1) v += __shfl_xor(v, o);
    return v;
}

DI int tid_() { int t = threadIdx.x; asm volatile("" : "+v"(t)); return t; }
DI void glds16(const void* gsrc, unsigned lds_dst) {
    unsigned keep;
    asm volatile("s_mov_b32 %0, m0\n\ts_mov_b32 m0, %2\n\ts_nop 0\n\tglobal_load_lds_dwordx4 %1, off\n\ts_mov_b32 m0, %0" : "=&s"(keep) : "v"(gsrc), "s"(lds_dst) : "memory");
}
DI void glds16x6(const void* sa, const void* sb, unsigned va0, unsigned va1, unsigned vb0, unsigned vb1, unsigned vb2, unsigned vb3, unsigned lds_dst) {
    unsigned keep;
    asm volatile("s_mov_b32 %0, m0\n\ts_mov_b32 m0, %9\n\ts_nop 0\n\t"
                 "global_load_lds_dwordx4 %3, %1\n\ts_add_u32 m0, m0, 0x2000\n\ts_nop 0\n\t"
                 "global_load_lds_dwordx4 %4, %1\n\ts_add_u32 m0, m0, 0x2000\n\ts_nop 0\n\t"
                 "global_load_lds_dwordx4 %5, %2\n\ts_add_u32 m0, m0, 0x2000\n\ts_nop 0\n\t"
                 "global_load_lds_dwordx4 %6, %2\n\ts_add_u32 m0, m0, 0x2000\n\ts_nop 0\n\t"
                 "global_load_lds_dwordx4 %7, %2\n\ts_add_u32 m0, m0, 0x2000\n\ts_nop 0\n\t"
                 "global_load_lds_dwordx4 %8, %2\n\ts_mov_b32 m0, %0"
                 : "=&s"(keep) : "s"(sa), "s"(sb), "v"(va0), "v"(va1), "v"(vb0), "v"(vb1), "v"(vb2), "v"(vb3), "s"(lds_dst) : "memory", "scc");
}
DI void glds16x5(const void* sa, const void* sb, unsigned va, unsigned vb0, unsigned vb1, unsigned vb2, unsigned vb3, unsigned lds_dst) {
    unsigned keep;
    asm volatile("s_mov_b32 %0, m0\n\ts_mov_b32 m0, %8\n\ts_nop 0\n\t"
                 "global_load_lds_dwordx4 %3, %1\n\ts_add_u32 m0, m0, 0x2000\n\ts_nop 0\n\t"
                 "global_load_lds_dwordx4 %4, %2\n\ts_add_u32 m0, m0, 0x2000\n\ts_nop 0\n\t"
                 "global_load_lds_dwordx4 %5, %2\n\ts_add_u32 m0, m0, 0x2000\n\ts_nop 0\n\t"
                 "global_load_lds_dwordx4 %6, %2\n\ts_add_u32 m0, m0, 0x2000\n\ts_nop 0\n\t"
                 "global_load_lds_dwordx4 %7, %2\n\ts_mov_b32 m0, %0"
                 : "=&s"(keep) : "s"(sa), "s"(sb), "v"(va), "v"(vb0), "v"(vb1), "v"(vb2), "v"(vb3), "s"(lds_dst) : "memory", "scc");
}
DI void lds_barrier() { asm volatile("s_waitcnt lgkmcnt(0)\n\ts_barrier" ::: "memory"); }
constexpr int LDS_ROW = 144;
constexpr int A_STAGE = 128 * LDS_ROW;
constexpr int B_STAGE = 256 * LDS_ROW;
constexpr int STAGE = A_STAGE + B_STAGE;
constexpr int G3_A = 16384, G3_STAGE = 49152;
constexpr int H5_A = 8192, H5_STAGE = 40960;
constexpr int CHUNK_WAVE_LDS = 18944;
constexpr int SMEM_BYTES = 8 * CHUNK_WAVE_LDS;

DI void gemm_tile(const bf16_t* __restrict__ A, int lda, const bf16_t* __restrict__ Bt, int ldb, int K, unsigned char* smem, f32x4 (&acc)[4][4], bool zero = true) {
    const int tid = tid_(), lane = tid & 63, wid = tid >> 6;
    const int wm = wid >> 2, wn = wid & 3;
#pragma unroll
    for (int i = 0; i < 4; ++i)
#pragma unroll
        for (int j = 0; j < 4; ++j) if (zero) acc[i][j] = (f32x4){0.f, 0.f, 0.f, 0.f};
    const int crow = tid >> 3, ckc = tid & 7;
    const bf16_t* ag = A + (size_t)crow * lda + ckc * 8;
    const bf16_t* bg = Bt + (size_t)crow * ldb + ckc * 8;
    u32x4 ra[2], rb[4];
#pragma unroll
    for (int i = 0; i < 2; ++i) ra[i] = *(const u32x4*)(ag + (size_t)i * 64 * lda);
#pragma unroll
    for (int i = 0; i < 4; ++i) rb[i] = *(const u32x4*)(bg + (size_t)i * 64 * ldb);
    const int soff = crow * LDS_ROW + ckc * 16;
#pragma unroll
    for (int i = 0; i < 2; ++i) *(u32x4*)(smem + soff + i * 64 * LDS_ROW) = ra[i];
#pragma unroll
    for (int i = 0; i < 4; ++i) *(u32x4*)(smem + A_STAGE + soff + i * 64 * LDS_ROW) = rb[i];
    __syncthreads();
    const int nk = K >> 6;
    const int fa = (wm * 64 + (lane & 15)) * LDS_ROW + (lane >> 4) * 16;
    const int fb = A_STAGE + (wn * 64 + (lane & 15)) * LDS_ROW + (lane >> 4) * 16;
    for (int kt = 0; kt < nk; ++kt) {
        const int cur = kt & 1;
        const bool more = (kt + 1 < nk);
        if (more) {
            const int ko = (kt + 1) * 64;
#pragma unroll
            for (int i = 0; i < 2; ++i) ra[i] = *(const u32x4*)(ag + (size_t)i * 64 * lda + ko);
#pragma unroll
            for (int i = 0; i < 4; ++i) rb[i] = *(const u32x4*)(bg + (size_t)i * 64 * ldb + ko);
        }
        const unsigned char* sc = smem + cur * STAGE;
#pragma unroll
        for (int ks = 0; ks < 2; ++ks) {
            bf16x8 af[4], bfr[4];
#pragma unroll
            for (int mt = 0; mt < 4; ++mt) af[mt] = *(const bf16x8*)(sc + fa + mt * 16 * LDS_ROW + ks * 64);
#pragma unroll
            for (int nt = 0; nt < 4; ++nt) bfr[nt] = *(const bf16x8*)(sc + fb + nt * 16 * LDS_ROW + ks * 64);
#pragma unroll
            for (int mt = 0; mt < 4; ++mt)
#pragma unroll
                for (int nt = 0; nt < 4; ++nt) acc[mt][nt] = __builtin_amdgcn_mfma_f32_16x16x32_bf16(bfr[nt], af[mt], acc[mt][nt], 0, 0, 0);
        }
        if (more) {
            unsigned char* sn = smem + (cur ^ 1) * STAGE;
#pragma unroll
            for (int i = 0; i < 2; ++i) *(u32x4*)(sn + soff + i * 64 * LDS_ROW) = ra[i];
#pragma unroll
            for (int i = 0; i < 4; ++i) *(u32x4*)(sn + A_STAGE + soff + i * 64 * LDS_ROW) = rb[i];
        }
        __syncthreads();
    }
}

DI int colmap(int mode, int n) {
    if (mode == 0) return n;
    if (mode == 1) { const int a = (n >> 4) & 7; return (a & 1) * DFF + (n >> 9) * 256 + ((n >> 7) & 3) * 64 + ((n >> 2) & 3) * 16 + (a >> 1) * 4 + (n & 3); }
    if (n < 2816) return n;
    if (n < 3584) return n + 8;
    if (n < 3592) return n - 3584 + 2816;
    return -1;
}
DI void transpose_tile(const float* __restrict__ src, int Nsrc, int K, bf16_t* __restrict__ dst, int mode, int k0, int n0, float* tile  ) {
    const int tid = tid_();
    const int n4 = (tid & 15) * 4;
    const int c = colmap(mode, n0 + n4);
#pragma unroll
    for (int i = 0; i < 2; ++i) {
        const int kk = (tid >> 4) + 32 * i;
        f32x4 v = {0.f, 0.f, 0.f, 0.f};
        if (c >= 0) v = *(const f32x4*)(src + (size_t)(k0 + kk) * Nsrc + c);
        tile[kk * 65 + n4] = v[0]; tile[kk * 65 + n4 + 1] = v[1]; tile[kk * 65 + n4 + 2] = v[2]; tile[kk * 65 + n4 + 3] = v[3];
    }
    __syncthreads();
    const int n = tid >> 3, ks = (tid & 7) * 8;
    u32x4 w;
    w.x = pk_bf16(tile[(ks + 0) * 65 + n], tile[(ks + 1) * 65 + n]);
    w.y = pk_bf16(tile[(ks + 2) * 65 + n], tile[(ks + 3) * 65 + n]);
    w.z = pk_bf16(tile[(ks + 4) * 65 + n], tile[(ks + 5) * 65 + n]);
    w.w = pk_bf16(tile[(ks + 6) * 65 + n], tile[(ks + 7) * 65 + n]);
    *(u32x4*)(dst + ((size_t)((n0 >> 8) * (K >> 6) + (k0 >> 6)) * 256 + (n0 & 255) + n) * 64 + ks) = w;
    __syncthreads();
}
DI void prep_weights(const Params& P, unsigned char* smem, int L, int vb, int nvb, int part  ) {
    float* tile = (float*)smem;
    unsigned char* ws = P.ws;
    constexpr int T_W1 = 16 * 88, T_W2 = 44 * 16, T_WIN = 16 * 60, T_SQ = 16 * 16, T_WP = 4 * 16;
    constexpr int E1 = 2 * T_W1, E2 = E1 + 2 * T_W2, E3 = E2 + T_WIN, E4 = E3 + T_SQ, E5 = E4 + T_SQ, E6 = E5 + T_WP;
    for (int idx = vb; idx < E6; idx += nvb) {
        const bool early = (idx < T_W1) || (idx >= E1 && idx < E1 + T_W2) || (idx >= E2 && idx < E3);
        if (part != 2 && early != (part == 0)) continue;
        if (idx < E1) { const int j = L * 2 + idx / T_W1, t = idx % T_W1; const int kt = t / 88, nt = t % 88;
            transpose_tile(P.ffn_w_in + (size_t)j * D * 2 * DFF, 2 * DFF, D, (bf16_t*)(ws + OFF_W1 + j * SZ_W1), 1, kt * 64, nt * 64, tile); }
        else if (idx < E2) { const int q = idx - E1; const int j = L * 2 + q / T_W2, t = q % T_W2; const int kt = t / 16, nt = t % 16;
            transpose_tile(P.ffn_w_out + (size_t)j * DFF * D, D, DFF, (bf16_t*)(ws + OFF_W2 + j * SZ_W2), 0, kt * 64, nt * 64, tile); }
        else if (idx < E3) { const int t = idx - E2; const int kt = t / 60, nt = t % 60;
            transpose_tile(P.mix_w_in + (size_t)L * D * 3592, 3592, D, (bf16_t*)(ws + OFF_WIN + L * SZ_WIN), 2, kt * 64, nt * 64, tile); }
        else if (idx < E4) { const int t = idx - E3; const int kt = t / 16, nt = t % 16;
            transpose_tile(P.mix_w_out + (size_t)L * D * D, D, D, (bf16_t*)(ws + OFF_WOUT + L * SZ_WSQ), 0, kt * 64, nt * 64, tile); }
        else if (idx < E5) { const int t = idx - E4; const int kt = t / 16, nt = t % 16;
            transpose_tile(P.ple_w_gate + (size_t)L * D * D, D, D, (bf16_t*)(ws + OFF_WG + L * SZ_WSQ), 0, kt * 64, nt * 64, tile); }
        else { const int t = idx - E5; const int kt = t / 16, nt = t % 16;
            transpose_tile(P.ple_w_proj + (size_t)L * PLE * D, D, PLE, (bf16_t*)(ws + OFF_WP + L * SZ_WP), 0, kt * 64, nt * 64, tile); }
    }
}
DI void phase_prep(const Params& P, unsigned char* smem) {
    unsigned char* ws = P.ws;
    prep_weights(P, smem, 0, blockIdx.x, gridDim.x, (gridDim.x <= 64) ? 2 : 0);
    if (gridDim.x <= 64) prep_weights(P, smem, 1, blockIdx.x, gridDim.x, 2);
    if (blockIdx.x == 0 && threadIdx.x == 0) *(unsigned*)(ws + OFF_BAR) = 0u;
    bf16_t* xb = (bf16_t*)(ws + OFF_XB);
    const size_t n4 = (size_t)NTOK * D / 4;
    const int tidp = tid_();
    for (size_t i = (size_t)blockIdx.x * NTHREADS + tidp; i < n4; i += (size_t)gridDim.x * NTHREADS) {
        const f32x4 v = *(const f32x4*)(P.x + i * 4);
        u32x2 w; w.x = pk_bf16(v[0], v[1]); w.y = pk_bf16(v[2], v[3]);
        *(u32x2*)(xb + i * 4) = w;
    }
}

DI void ln_rows(float* xr, bf16_t* xbr, const float* __restrict__ g, const float* __restrict__ b, float* stp, bool write_f32) {
    const int tidl = tid_();
    const int lane = tidl & 63, wid = tidl >> 6;
    f32x4 gv[4], bv[4];
#pragma unroll
    for (int i = 0; i < 4; ++i) { gv[i] = *(const f32x4*)(g + i * 256 + lane * 4); bv[i] = *(const f32x4*)(b + i * 256 + lane * 4); }
    for (int r0 = wid * 16; r0 < wid * 16 + 16; r0 += 4) {
        f32x4 v[4][4];
#pragma unroll
        for (int q = 0; q < 4; ++q)
#pragma unroll
            for (int i = 0; i < 4; ++i) v[q][i] = *(const f32x4*)(xr + (size_t)(r0 + q) * D + i * 256 + lane * 4);
        float s[4], qq[4];
#pragma unroll
        for (int q = 0; q < 4; ++q) {
            s[q] = 0.f;
#pragma unroll
            for (int i = 0; i < 4; ++i) s[q] += (v[q][i][0] + v[q][i][1]) + (v[q][i][2] + v[q][i][3]);
        }
#pragma unroll
        for (int o = 32; o >= 1; o >>= 1)
#pragma unroll
            for (int q = 0; q < 4; ++q) s[q] += __shfl_xor(s[q], o);
#pragma unroll
        for (int q = 0; q < 4; ++q) {
            const float mu = s[q] * (1.0f / D);
            qq[q] = 0.f;
#pragma unroll
            for (int i = 0; i < 4; ++i) { v[q][i] = v[q][i] - mu; qq[q] += (v[q][i][0] * v[q][i][0] + v[q][i][1] * v[q][i][1]) + (v[q][i][2] * v[q][i][2] + v[q][i][3] * v[q][i][3]); }
        }
#pragma unroll
        for (int o = 32; o >= 1; o >>= 1)
#pragma unroll
            for (int q = 0; q < 4; ++q) qq[q] += __shfl_xor(qq[q], o);
#pragma unroll
        for (int q = 0; q < 4; ++q) {
            const float rs = rsqrtf(qq[q] * (1.0f / D) + 1e-5f);
            if (lane == 0) { stp[(r0 + q) * 2] = s[q] * (1.0f / D); stp[(r0 + q) * 2 + 1] = rs; }
#pragma unroll
            for (int i = 0; i < 4; ++i) {
                const f32x4 o = v[q][i] * rs * gv[i] + bv[i];
                if (write_f32) *(f32x4*)(xr + (size_t)(r0 + q) * D + i * 256 + lane * 4) = o;
                if (!write_f32) {
                    u32x2 w; w.x = pk_bf16(o[0], o[1]); w.y = pk_bf16(o[2], o[3]);
                    *(u32x2*)(xbr + (size_t)(r0 + q) * D + i * 256 + lane * 4) = w;
                }
            }
        }
    }
}

DI void run_jobs(const Params& P, int rb, int jj_lo, int jj_hi, unsigned char* smem) {
    float* xr = P.out + (size_t)rb * RB * D;
    bf16_t* xbr = (bf16_t*)(P.ws + OFF_XB) + (size_t)rb * RB * D;
    bf16_t* ureg = (bf16_t*)(P.ws + OFF_U) + (size_t)rb * RB * PJ;
    float* pps = (float*)ureg;
    bf16_t* pbf = (bf16_t*)((unsigned char*)ureg + (size_t)RB * D * 4);
    float* ab = (float*)(P.ws + OFF_AB) + (size_t)rb * RB * 8;
    for (int jj = jj_lo; jj < jj_hi; ++jj) {
        const int tid = tid_(), lane = tid & 63, wid = tid >> 6, wm = wid >> 2, wn = wid & 3;
        const int l = jj >> 3, j = jj & 7;
        if (j == 3) {
            const int hh = lane >> 4, cl = (lane & 15) * 8;
            const float* nw = P.gdn_norm_w + (size_t)l * 128 + cl;
            const f32x4 nw0 = *(const f32x4*)nw, nw1 = *(const f32x4*)(nw + 4);
            for (int r0 = wid * 16; r0 < wid * 16 + 16; r0 += 4) {
                u32x4 ov[4], zv[4];
#pragma unroll
                for (int q = 0; q < 4; ++q) {
                    ov[q] = *(const u32x4*)(xbr + (size_t)(r0 + q) * D + 256 + hh * 128 + cl);
                    zv[q] = *(const u32x4*)(ureg + (size_t)(r0 + q) * PJ + 2304 + hh * 128 + cl);
                }
#pragma unroll
                for (int q = 0; q < 4; ++q) {
                    float o[8], z[8];
#pragma unroll
                    for (int e = 0; e < 4; ++e) { o[2 * e] = bf_lo(ov[q][e]); o[2 * e + 1] = bf_hi(ov[q][e]); z[2 * e] = bf_lo(zv[q][e]); z[2 * e + 1] = bf_hi(zv[q][e]); }
                    float ss = 0.f;
#pragma unroll
                    for (int e = 0; e < 8; ++e) ss += o[e] * o[e];
                    ss += __shfl_xor(ss, 1); ss += __shfl_xor(ss, 2); ss += __shfl_xor(ss, 4); ss += __shfl_xor(ss, 8);
                    const float rs = rsqrtf(ss * (1.0f / 128.f) + 1e-6f);
                    float y[8];
#pragma unroll
                    for (int e = 0; e < 8; ++e) y[e] = o[e] * rs * ((e < 4) ? nw0[e & 3] : nw1[e & 3]) * (z[e] * sigmoidf_(z[e]));
                    u32x4 w; w.x = pk_bf16(y[0], y[1]); w.y = pk_bf16(y[2], y[3]); w.z = pk_bf16(y[4], y[5]); w.w = pk_bf16(y[6], y[7]);
                    *(u32x4*)(xbr + (size_t)(r0 + q) * D + 256 + hh * 128 + cl) = w;
                }
            }
            __syncthreads();
        }
        if (j == 6) {
            const float* pin = P.p + ((size_t)l * NTOK + (size_t)rb * RB) * PLE;
            for (int i = tid; i < RB * PLE / 4; i += NTHREADS) {
                const f32x4 v = *(const f32x4*)(pin + (size_t)i * 4);
                u32x2 w; w.x = pk_bf16(v[0], v[1]); w.y = pk_bf16(v[2], v[3]);
                *(u32x2*)(pbf + (size_t)i * 4) = w;
            }
            __syncthreads();
        }
        const bf16_t* A; const bf16_t* Bt; int lda, K, nt;
        if (j == 0 || j == 4) { A = xbr; lda = D; K = D; nt = 22; Bt = (const bf16_t*)(P.ws + OFF_W1 + (size_t)(l * 2 + (j >> 2)) * SZ_W1); }
        else if (j == 1 || j == 5) { A = ureg; lda = DFF; K = DFF; nt = 4; Bt = (const bf16_t*)(P.ws + OFF_W2 + (size_t)(l * 2 + (j >> 2)) * SZ_W2); }
        else if (j == 2) { A = xbr; lda = D; K = D; nt = 14; Bt = (const bf16_t*)(P.ws + OFF_WIN + (size_t)l * SZ_WIN); }
        else if (j == 3) { A = xbr; lda = D; K = D; nt = 4; Bt = (const bf16_t*)(P.ws + OFF_WOUT + (size_t)l * SZ_WSQ); }
        else if (j == 6) { A = pbf; lda = PLE; K = PLE; nt = 4; Bt = (const bf16_t*)(P.ws + OFF_WP + (size_t)l * SZ_WP); }
        else { A = xbr; lda = D; K = D; nt = 4; Bt = (const bf16_t*)(P.ws + OFF_WG + (size_t)l * SZ_WSQ); }
        const float* resid = (jj == 1) ? (P.x + (size_t)rb * RB * D) : xr;
        const float rsc = (j == 3) ? 1.0f : 0.5f;
        const float* bgate = P.ple_b_gate + (size_t)l * D;
        float* stp = (float*)(P.ws + OFF_ST) + (size_t)rb * RB * 2;
        const bool rec = (j == 1 || j == 3 || j == 5 || j == 7) && (jj != 1);
        const int lsrc = (j == 1) ? (l * 4 - 1) : (l * 4 + ((j - 3) >> 1));
        const float* lng = P.ln_g + (size_t)(rec ? lsrc : 0) * D;
        const float* lnb = P.ln_b + (size_t)(rec ? lsrc : 0) * D;
        {
            const int nk = K >> 5, nk64 = K >> 6, ntw = nt >> 1, S = ntw * nk;
            const int drow = tid >> 2, kcs = (tid & 3) ^ ((4 - ((tid >> 4) & 3)) & 3);
            const unsigned va = (unsigned)((drow * lda + kcs * 8) * 2);
            const unsigned vb0 = (unsigned)((drow * 64 + kcs * 8) * 2), vb1 = vb0 + 16384u;
            const unsigned vb2 = vb0 + (unsigned)nk64 * 32768u, vb3 = vb2 + 16384u;
            const unsigned lbase = (unsigned)(size_t)smem + (unsigned)__builtin_amdgcn_readfirstlane(wid) * 1024u;
            const int r16 = lane & 15, q4 = lane >> 4;
            const int ko = ((q4 ^ ((4 - (r16 >> 2)) & 3)) << 4);
            const int fa = (wm * 64 + r16) * 64 + ko, fb = H5_A + (wn * 128 + r16) * 64 + ko;
            f32x4 acc[4][8];
#pragma unroll
            for (int i = 0; i < 4; ++i)
#pragma unroll
                for (int jq = 0; jq < 8; ++jq) acc[i][jq] = (f32x4){0.f, 0.f, 0.f, 0.f};
            const int toff = (int)((blockIdx.x & 7u) * (unsigned)ntw) >> 3;
            const int koff = (int)((blockIdx.x >> 3) * (unsigned)nk) >> 5;
            int kp = 0, sp = 0, tp = toff;
            const bf16_t* pbt = Bt + (size_t)toff * 512 * K;
#define ISSUE() do { const int ka_ = (kp + koff >= nk) ? kp + koff - nk : kp + koff; \
                glds16x5(A + ka_ * 32, pbt + (size_t)(ka_ >> 1) * 16384 + (ka_ & 1) * 32, va, vb0, vb1, vb2, vb3, lbase + (unsigned)sp * H5_STAGE); \
                ++kp; if (kp == nk) { kp = 0; ++tp; pbt += (size_t)512 * K; if (tp == ntw) { tp = 0; pbt = Bt; } } sp = (sp == 2) ? 0 : sp + 1; } while (0)
            ISSUE();
            ISSUE();
            ISSUE();
            asm volatile("s_waitcnt vmcnt(10)" ::: "memory");
            lds_barrier();
            int kt = 0, t = toff, st = 0;
            for (int s = 0; s < S; ++s) {
                const unsigned char* sc_ = smem + st * H5_STAGE;
                bf16x8 af[4], bfr[8];
#pragma unroll
                for (int mt = 0; mt < 4; ++mt) af[mt] = *(const bf16x8*)(sc_ + fa + mt * 1024);
#pragma unroll
                for (int n_ = 0; n_ < 8; ++n_) bfr[n_] = *(const bf16x8*)(sc_ + fb + n_ * 1024);
                if (kt == 0) {
#pragma unroll
                    for (int i = 0; i < 4; ++i)
#pragma unroll
                        for (int jq = 0; jq < 8; ++jq) acc[i][jq] = (f32x4){0.f, 0.f, 0.f, 0.f};
                }
#pragma unroll
                for (int mt = 0; mt < 4; ++mt)
#pragma unroll
                    for (int n_ = 0; n_ < 8; ++n_) acc[mt][n_] = __builtin_amdgcn_mfma_f32_16x16x32_bf16(bfr[n_], af[mt], acc[mt][n_], 0, 0, 0);
                if (s + 2 < S) asm volatile("s_waitcnt vmcnt(5)" ::: "memory");
                else asm volatile("s_waitcnt vmcnt(0)" ::: "memory");
                lds_barrier();
                if (s + 3 < S) ISSUE();
                st = (st == 2) ? 0 : st + 1;
                ++kt;
                if (kt == nk) {
                    kt = 0;
                    const int row0 = wm * 64 + r16;
                    const int col0 = t * 512 + wn * 128 + q4 * 4;
                    if (j == 0 || j == 4) {
                        bf16_t* hp = ureg + (size_t)row0 * DFF + t * 256 + wn * 64 + q4 * 16;
#pragma unroll
                        for (int mt = 0; mt < 4; ++mt) {
                            float hv[16];
#pragma unroll
                            for (int pr = 0; pr < 4; ++pr)
#pragma unroll
                                for (int r = 0; r < 4; ++r) { const float g = acc[mt][2 * pr][r]; hv[pr * 4 + r] = g * sigmoidf_(g) * acc[mt][2 * pr + 1][r]; }
                            u32x4 w0, w1;
                            w0.x = pk_bf16(hv[0], hv[1]); w0.y = pk_bf16(hv[2], hv[3]); w0.z = pk_bf16(hv[4], hv[5]); w0.w = pk_bf16(hv[6], hv[7]);
                            w1.x = pk_bf16(hv[8], hv[9]); w1.y = pk_bf16(hv[10], hv[11]); w1.z = pk_bf16(hv[12], hv[13]); w1.w = pk_bf16(hv[14], hv[15]);
                            *(u32x4*)(hp + (size_t)mt * 16 * DFF) = w0;
                            *(u32x4*)(hp + (size_t)mt * 16 * DFF + 8) = w1;
                        }
                    } else if (j == 1 || j == 5 || j == 3) {
#pragma unroll
                        for (int mt = 0; mt < 4; ++mt)
#pragma unroll
                            for (int nn = 0; nn < 8; ++nn) {
                                if ((nn & 3) == 0) asm volatile("" ::: "memory");
                                const size_t o = (size_t)(row0 + mt * 16) * D + col0 + nn * 16;
                                f32x4 rv = *(const f32x4*)(resid + o);
                                if (rec) {
                                    const float mu = stp[(row0 + mt * 16) * 2], rs = stp[(row0 + mt * 16) * 2 + 1];
                                    rv = (rv - mu) * rs * *(const f32x4*)(lng + col0 + nn * 16) + *(const f32x4*)(lnb + col0 + nn * 16);
                                }
                                *(f32x4*)(xr + o) = rv * ALPHA + acc[mt][nn] * rsc;
                            }
                    } else if (j == 2) {
#pragma unroll
                        for (int mt = 0; mt < 4; ++mt)
#pragma unroll
                            for (int nn = 0; nn < 8; ++nn) {
                                u32x2 w; w.x = pk_bf16(acc[mt][nn][0], acc[mt][nn][1]); w.y = pk_bf16(acc[mt][nn][2], acc[mt][nn][3]);
                                *(u32x2*)(ureg + (size_t)(row0 + mt * 16) * PJ + col0 + nn * 16) = w;
                            }
                    } else if (j == 6) {
#pragma unroll
                        for (int mt = 0; mt < 4; ++mt)
#pragma unroll
                            for (int nn = 0; nn < 8; ++nn) *(u32x2*)((bf16_t*)pps + (size_t)(row0 + mt * 16) * D + col0 + nn * 16) = pack4(acc[mt][nn]);
                    } else {
#pragma unroll
                        for (int mt = 0; mt < 4; ++mt)
#pragma unroll
                            for (int nn = 0; nn < 8; ++nn) {
                                if ((nn & 1) == 0) asm volatile("" ::: "memory");
                                const size_t o = (size_t)(row0 + mt * 16) * D + col0 + nn * 16;
                                const f32x4 bv = *(const f32x4*)(bgate + col0 + nn * 16);
                                const u32x2 pu = *(const u32x2*)((const bf16_t*)pps + o);
                                const f32x4 pv = {bf_lo(pu.x), bf_hi(pu.x), bf_lo(pu.y), bf_hi(pu.y)};
                                f32x4 xv = *(const f32x4*)(xr + o);
                                {
                                    const float mu = stp[(row0 + mt * 16) * 2], rs = stp[(row0 + mt * 16) * 2 + 1];
                                    xv = (xv - mu) * rs * *(const f32x4*)(lng + col0 + nn * 16) + *(const f32x4*)(lnb + col0 + nn * 16);
                                }
                                f32x4 ov;
#pragma unroll
                                for (int r = 0; r < 4; ++r) ov[r] = xv[r] * ALPHA + sigmoidf_(acc[mt][nn][r] + bv[r]) * pv[r];
                                *(f32x4*)(xr + o) = ov;
                            }
                    }
                    ++t; if (t == ntw) t = 0;
                }
            }
#undef ISSUE
        }
        if (j == 2) {
            const int r16 = lane & 15, q4 = lane >> 4;
            const bf16_t* arow = xbr + (size_t)(wid * 16 + r16) * D + 8 * q4;
            const bf16_t* wrow = Bt + ((size_t)(14 * 16) * 256 + r16) * 64 + 8 * q4;
            f32x4 c = {0.f, 0.f, 0.f, 0.f};
#pragma unroll 8
            for (int kk = 0; kk < 32; ++kk) {
                const bf16x8 af = *(const bf16x8*)(arow + 32 * kk);
                const bf16x8 wf = *(const bf16x8*)(wrow + (size_t)(kk >> 1) * 16384 + (kk & 1) * 32);
                c = __builtin_amdgcn_mfma_f32_16x16x32_bf16(wf, af, c, 0, 0, 0);
            }
            if (q4 < 2) *(f32x4*)(ab + (size_t)(wid * 16 + r16) * 8 + q4 * 4) = c;
            __syncthreads();
            bf16_t* halo = (bf16_t*)(P.ws + OFF_HALO) + (size_t)rb * 3 * 1536;
            for (int i = tid; i < 3 * 192; i += NTHREADS) {
                const int rr = i / 192, cc = (i % 192) * 8;
                *(u32x4*)(halo + rr * 1536 + cc) = *(const u32x4*)(ureg + (size_t)(125 + rr) * PJ + 768 + cc);
            }
        }
        __syncthreads();
        if (j == 1 || j == 3 || j == 5 || j == 7) {
            const int li = l * 4 + ((j - 1) >> 1);
            ln_rows(xr, xbr, P.ln_g + (size_t)li * D, P.ln_b + (size_t)li * D, stp, jj == 15);
            __syncthreads();
        }
    }
}

DI void phase_gdn_prep(const Params& P, int l) {
    const int tid = tid_(), lane = tid & 63, wid = tid >> 6;
    const int h = lane >> 4, cl = (lane & 15) * 8;
    const bf16_t* proj = (const bf16_t*)(P.ws + OFF_U);
    const bf16_t* halo = (const bf16_t*)(P.ws + OFF_HALO);
    bf16_t* gq = (bf16_t*)(P.ws + OFF_GQ);
    const float* cw = P.gdn_conv_w + (size_t)l * 4 * 1536;
    const float* ab = (const float*)(P.ws + OFF_AB);
    float* gb = (float*)(P.ws + OFF_GB);
    for (int rb = blockIdx.x; rb < NRB; rb += gridDim.x) {
        for (int itl = wid; itl < 96; itl += 8) {
            const int which = itl % 3, tgl = itl / 3;
            const int t0 = rb * RB + tgl * 4, s0 = t0 & (SEQ - 1);
            const int c = which * 512 + h * 128 + cl;
            f32x4 w[4][2];
#pragma unroll
            for (int i = 0; i < 4; ++i) { w[i][0] = *(const f32x4*)(cw + i * 1536 + c); w[i][1] = *(const f32x4*)(cw + i * 1536 + c + 4); }
            u32x4 x[7];
#pragma unroll
            for (int rr = 0; rr < 7; ++rr) {
                if (tgl == 0 && rr < 3) {
                    if (s0 > 0) x[rr] = *(const u32x4*)(halo + ((size_t)(rb - 1) * 3 + rr) * 1536 + c);
                    else x[rr] = (u32x4){0u, 0u, 0u, 0u};
                } else x[rr] = *(const u32x4*)(proj + (size_t)(t0 - 3 + rr) * PJ + 768 + c);
            }
#pragma unroll
            for (int tk = 0; tk < 4; ++tk) {
                float y[8];
#pragma unroll
                for (int e = 0; e < 8; ++e) y[e] = 0.f;
#pragma unroll
                for (int i = 0; i < 4; ++i)
#pragma unroll
                    for (int jj = 0; jj < 4; ++jj) {
                        y[2 * jj] += w[i][jj >> 1][(2 * jj) & 3] * bf_lo(x[tk + i][jj]);
                        y[2 * jj + 1] += w[i][jj >> 1][(2 * jj + 1) & 3] * bf_hi(x[tk + i][jj]);
                    }
                float ss = 0.f;
#pragma unroll
                for (int e = 0; e < 8; ++e) { y[e] = y[e] * sigmoidf_(y[e]); ss += y[e] * y[e]; }
                if (which < 2) {
                    ss += __shfl_xor(ss, 1); ss += __shfl_xor(ss, 2); ss += __shfl_xor(ss, 4); ss += __shfl_xor(ss, 8);
                    float sc = rsqrtf(ss + 1e-6f);
                    if (which == 0) sc *= 0.08838834764831845f;
#pragma unroll
                    for (int e = 0; e < 8; ++e) y[e] *= sc;
                }
                u32x4 o; o.x = pk_bf16(y[0], y[1]); o.y = pk_bf16(y[2], y[3]); o.z = pk_bf16(y[4], y[5]); o.w = pk_bf16(y[6], y[7]);
                *(u32x4*)(gq + (size_t)(t0 + tk) * 1536 + c) = o;
            }
        }
        {
            const int t = rb * RB + (tid >> 2), hh = tid & 3;
            const float a = ab[(size_t)t * 8 + hh], bl = ab[(size_t)t * 8 + 4 + hh];
            gb[(size_t)t * 8 + hh] = -__expf(P.gdn_a_log[l * 4 + hh]) * softplusf_(a + P.gdn_dt_bias[l * 4 + hh]);
            gb[(size_t)t * 8 + 4 + hh] = sigmoidf_(bl);
        }
    }
}

DI void sc_conv(const Params& P, int l, int vb, int nvb) {
    const bf16_t* proj = (const bf16_t*)(P.ws + OFF_U);
    bf16_t* mixed = (bf16_t*)(P.ws + OFF_XB);
    const float* w = P.sc_conv_w + (size_t)l * 3 * 256;
    const int tids = tid_();
    for (size_t it = (size_t)vb * NTHREADS + tids; it < (size_t)NTOK * 128; it += (size_t)nvb * NTHREADS) {
        const int t = (int)(it >> 7), c = (int)(it & 127) * 2;
        const int s = t & (SEQ - 1);
        float y0 = 0.f, y1 = 0.f;
#pragma unroll
        for (int i = 0; i < 3; ++i) {
            if (s - 2 + i >= 0) {
                const bf16_t* pr = proj + (size_t)(t - 2 + i) * PJ;
                const unsigned cu = *(const unsigned*)(pr + 3072 + c), hu = *(const unsigned*)(pr + 3328 + c);
                y0 += w[i * 256 + c] * (bf_lo(cu) * bf_lo(hu));
                y1 += w[i * 256 + c + 1] * (bf_hi(cu) * bf_hi(hu));
            }
        }
        const unsigned bu = *(const unsigned*)(proj + (size_t)t * PJ + 2816 + c);
        *(unsigned*)(mixed + (size_t)t * D + 768 + c) = pk_bf16(bf_lo(bu) * y0, bf_hi(bu) * y1);
    }
}

DI bf16x8 scale_frag(bf16x8 f, float s) {
    const u32x4 u = __builtin_bit_cast(u32x4, f);
    u32x4 o;
#pragma unroll
    for (int e = 0; e < 4; ++e) o[e] = pk_bf16(bf_lo(u[e]) * s, bf_hi(u[e]) * s);
    return __builtin_bit_cast(bf16x8, o);
}
typedef float f32x16 __attribute__((ext_vector_type(16)));
DI void sb_mfma(const Params& P, int vw, int nvw) {
    const bf16_t* proj = (const bf16_t*)(P.ws + OFF_U);
    bf16_t* mixed = (bf16_t*)(P.ws + OFF_XB);
    for (int it = vw; it < 4096; it += nvw) {
        const int lane = tid_() & 63, c32 = lane & 31, h2 = lane >> 5;
        const int qt = it & 255, h = (it >> 8) & 3, b = it >> 10;
        const size_t Tb = (size_t)b * SEQ, T0 = Tb + 32 * qt;
        bf16x8 qf[4];
#pragma unroll
        for (int ks = 0; ks < 4; ++ks) qf[ks] = scale_frag(*(const bf16x8*)(proj + (T0 + c32) * PJ + h * 64 + 16 * ks + 8 * h2), 0.125f);
        f32x16 O0, O1;
#pragma unroll
        for (int i = 0; i < 16; ++i) { O0[i] = 0.f; O1[i] = 0.f; }
        float carry = 0.f;
        for (int kt = qt; kt >= 0; --kt) {
            const bf16_t* kb = proj + (Tb + 32 * kt + c32) * PJ + 256 + h * 64 + 8 * h2;
            f32x16 S;
#pragma unroll
            for (int i = 0; i < 16; ++i) S[i] = 0.f;
#pragma unroll
            for (int ks = 0; ks < 4; ++ks) S = __builtin_amdgcn_mfma_f32_32x32x16_bf16(*(const bf16x8*)(kb + 16 * ks), qf[ks], S, 0, 0, 0);
            const bf16_t* vb = proj + (Tb + 32 * kt + 4 * h2) * PJ + 512 + h * 64 + c32;
            bf16x8 vf[2][2];
#pragma unroll
            for (int s2 = 0; s2 < 2; ++s2)
#pragma unroll
                for (int nt = 0; nt < 2; ++nt)
#pragma unroll
                    for (int j = 0; j < 8; ++j) vf[s2][nt][j] = (short)vb[(size_t)(16 * s2 + 8 * (j >> 2) + (j & 3)) * PJ + 32 * nt];
            const bool diag = (kt == qt);
            float ls[16], lb[16];
#pragma unroll
            for (int i = 0; i < 16; ++i) {
                const float z = S[i];
                const float sp = fmaxf(z, 0.f) + __logf(1.0f + __expf(-fabsf(z)));
                const int sl = 8 * (i >> 2) + 4 * h2 + (i & 3);
                const bool valid = !diag || (sl < c32);
                lb[i] = valid ? (z - sp) : -1e30f;
                ls[i] = valid ? -sp : 0.f;
            }
            float qs[4], pq[4], ps[4];
#pragma unroll
            for (int g = 0; g < 4; ++g) { qs[g] = (ls[4 * g] + ls[4 * g + 1]) + (ls[4 * g + 2] + ls[4 * g + 3]); pq[g] = __shfl_xor(qs[g], 32); ps[g] = qs[g] + pq[g]; }
            float R[4];
            R[3] = 0.f; R[2] = ps[3]; R[1] = R[2] + ps[2]; R[0] = R[1] + ps[1];
            float att[16];
#pragma unroll
            for (int g = 0; g < 4; ++g) {
                const float suf = carry + R[g] + ((h2 == 0) ? pq[g] : 0.f);
                const float l3 = suf, l2 = l3 + ls[4 * g + 3], l1 = l2 + ls[4 * g + 2], l0 = l1 + ls[4 * g + 1];
                att[4 * g + 3] = __expf(lb[4 * g + 3] + l3);
                att[4 * g + 2] = __expf(lb[4 * g + 2] + l2);
                att[4 * g + 1] = __expf(lb[4 * g + 1] + l1);
                att[4 * g + 0] = __expf(lb[4 * g + 0] + l0);
            }
            carry += R[0] + ps[0];
            bf16x8 af[2];
#pragma unroll
            for (int s2 = 0; s2 < 2; ++s2) {
                u32x4 u;
                u.x = pk_bf16(att[8 * s2 + 0], att[8 * s2 + 1]); u.y = pk_bf16(att[8 * s2 + 2], att[8 * s2 + 3]);
                u.z = pk_bf16(att[8 * s2 + 4], att[8 * s2 + 5]); u.w = pk_bf16(att[8 * s2 + 6], att[8 * s2 + 7]);
                af[s2] = __builtin_bit_cast(bf16x8, u);
            }
#pragma unroll
            for (int s2 = 0; s2 < 2; ++s2) {
                O0 = __builtin_amdgcn_mfma_f32_32x32x16_bf16(af[s2], vf[s2][0], O0, 0, 0, 0);
                O1 = __builtin_amdgcn_mfma_f32_32x32x16_bf16(af[s2], vf[s2][1], O1, 0, 0, 0);
            }
            if (__all(carry < -104.f)) break;
        }
        bf16_t* op = mixed + (T0 + 4 * h2) * D + h * 64 + c32;
#pragma unroll
        for (int i = 0; i < 16; ++i) {
            const int tl = (i & 3) + 8 * (i >> 2);
            op[(size_t)tl * D] = (bf16_t)(pk_bf16(O0[i], 0.f) & 0xffffu);
            op[(size_t)tl * D + 32] = (bf16_t)(pk_bf16(O1[i], 0.f) & 0xffffu);
        }
    }
}

DI void wsync() { asm volatile("s_waitcnt lgkmcnt(0)" ::: "memory"); }
DI void store_T_row(bf16_t* XT, const bf16x8 (&f)[4], float sc, int m, int r16, int q4) {
#pragma unroll
    for (int kk = 0; kk < 4; ++kk) {
        const u32x4 u = __builtin_bit_cast(u32x4, f[kk]);
#pragma unroll
        for (int e = 0; e < 4; ++e) {
            const unsigned w = pk_bf16(bf_lo(u[e]) * sc, bf_hi(u[e]) * sc);
            const int c = 32 * kk + 8 * q4 + 2 * e;
            XT[c * 72 + 16 * m + r16] = (bf16_t)(w & 0xffffu);
            XT[(c + 1) * 72 + 16 * m + r16] = (bf16_t)(w >> 16);
        }
    }
}

DI void phase_gdn_chunk(const Params& P, unsigned char* smem) {
    const int tid0 = tid_(), wid = tid0 >> 6;
    unsigned char* wl = smem + wid * CHUNK_WAVE_LDS;
    float* X = (float*)wl;
    bf16_t* XT = (bf16_t*)wl;
    float* gcs = (float*)(wl + 18432);
    float* bts = gcs + 64;
    bf16_t* gq = (bf16_t*)(P.ws + OFF_GQ);
    bf16_t* proj = (bf16_t*)(P.ws + OFF_U);
    const float* gb = (const float*)(P.ws + OFF_GB);
    float* glw = (float*)(P.ws + OFF_GL);
    for (int it = blockIdx.x * 8 + wid; it < 2048; it += gridDim.x * 8) {
        const int lane = tid_() & 63, r16 = lane & 15, q4 = lane >> 4;
        const int h = it & 3, c = (it >> 2) & 127, b = it >> 9;
        const size_t t0 = (size_t)b * SEQ + (size_t)c * 64;
        float gc = gb[(t0 + lane) * 8 + h];
        const float bt = gb[(t0 + lane) * 8 + 4 + h];
#pragma unroll
        for (int o = 1; o < 64; o <<= 1) { const float v = __shfl_up(gc, o); if (lane >= o) gc += v; }
        gcs[lane] = gc; bts[lane] = bt;
        const float gtot = __shfl(gc, 63);
        if (lane == 0) glw[it] = __expf(gtot);
        wsync();
        bf16x8 kf[4][4];
        {
            const bf16_t* kb = gq + t0 * 1536 + 512 + h * 128 + (size_t)r16 * 1536 + 8 * q4;
#pragma unroll
            for (int m = 0; m < 4; ++m)
#pragma unroll
                for (int kk = 0; kk < 4; ++kk) kf[m][kk] = *(const bf16x8*)(kb + (size_t)m * 16 * 1536 + 32 * kk);
        }
#pragma unroll
        for (int mi = 0; mi < 4; ++mi)
#pragma unroll
            for (int mj = 0; mj <= mi; ++mj) {
                f32x4 a = {0.f, 0.f, 0.f, 0.f};
#pragma unroll
                for (int kk = 0; kk < 4; ++kk) a = __builtin_amdgcn_mfma_f32_16x16x32_bf16(kf[mi][kk], kf[mj][kk], a, 0, 0, 0);
                const int j = 16 * mj + r16;
                const float gj = gcs[j];
                const f32x4 gi = *(const f32x4*)(gcs + 16 * mi + 4 * q4);
                const f32x4 bi = *(const f32x4*)(bts + 16 * mi + 4 * q4);
#pragma unroll
                for (int r = 0; r < 4; ++r) {
                    const int i = 16 * mi + 4 * q4 + r;
                    X[i * 68 + j] = (i > j) ? bi[r] * a[r] * __expf(fminf(gi[r] - gj, 0.f)) : 0.f;
                }
            }
        {
            bf16_t* qb = gq + t0 * 1536 + h * 128 + (size_t)r16 * 1536 + 8 * q4;
#pragma unroll
            for (int mi = 0; mi < 4; ++mi) {
                bf16x8 qf[4];
#pragma unroll
                for (int kk = 0; kk < 4; ++kk) qf[kk] = *(const bf16x8*)(qb + (size_t)mi * 16 * 1536 + 32 * kk);
                const int i = 16 * mi + r16;
                const float gi = gcs[i];
                bf16_t* qkrow = proj + (t0 + i) * PJ + 1792 + h * 128 + 4 * q4;
#pragma unroll
                for (int mj = 0; mj < 4; ++mj) {
                    u32x2 w = {0u, 0u};
                    if (mj <= mi) {
                        f32x4 a = {0.f, 0.f, 0.f, 0.f};
#pragma unroll
                        for (int kk = 0; kk < 4; ++kk) a = __builtin_amdgcn_mfma_f32_16x16x32_bf16(kf[mj][kk], qf[kk], a, 0, 0, 0);
                        const f32x4 gj = *(const f32x4*)(gcs + 16 * mj + 4 * q4);
                        f32x4 v;
#pragma unroll
                        for (int r = 0; r < 4; ++r) { const int j = 16 * mj + 4 * q4 + r; v[r] = (j <= i) ? a[r] * __expf(fminf(gi - gj[r], 0.f)) : 0.f; }
                        w = pack4(v);
                    }
                    *(u32x2*)(qkrow + 16 * mj) = w;
                }
                const float s = __expf(gi);
#pragma unroll
                for (int kk = 0; kk < 4; ++kk) *(bf16x8*)(qb + (size_t)mi * 16 * 1536 + 32 * kk) = scale_frag(qf[kk], s);
            }
        }
        wsync();
        {
            float Tc[64];
#pragma unroll
            for (int i = 0; i < 64; ++i) Tc[i] = 0.f;
            Tc[0] = (lane == 0) ? 1.f : 0.f;
#pragma unroll
            for (int i = 1; i < 64; ++i) {
                float a0 = 0.f, a1 = 0.f, a2 = 0.f, a3 = 0.f;
#pragma unroll
                for (int jj = 0; jj < (i + 3) / 4; ++jj) {
                    const f32x4 m4 = *(const f32x4*)(X + i * 68 + 4 * jj);
                    a0 += m4[0] * Tc[4 * jj]; a1 += m4[1] * Tc[4 * jj + 1]; a2 += m4[2] * Tc[4 * jj + 2]; a3 += m4[3] * Tc[4 * jj + 3];
                }
                Tc[i] = ((lane == i) ? 1.f : 0.f) - ((a0 + a1) + (a2 + a3));
            }
            wsync();
#pragma unroll
            for (int i = 0; i < 64; ++i) X[i * 68 + lane] = Tc[i];
            wsync();
        }
        {
            const bf16_t* kb = gq + t0 * 1536 + 512 + h * 128 + (size_t)r16 * 1536 + 8 * q4;
#pragma unroll
            for (int m = 0; m < 4; ++m)
#pragma unroll
                for (int kk = 0; kk < 4; ++kk) kf[m][kk] = *(const bf16x8*)(kb + (size_t)m * 16 * 1536 + 32 * kk);
        }
        bf16x8 Tf[4][2];
#pragma unroll
        for (int mi = 0; mi < 4; ++mi)
#pragma unroll
            for (int ks = 0; ks < 2; ++ks) {
                const float* xp = X + (16 * mi + r16) * 68 + 32 * ks + 8 * q4;
                const f32x4 a = *(const f32x4*)xp, bb = *(const f32x4*)(xp + 4);
                u32x4 u; u.x = pk_bf16(a[0], a[1]); u.y = pk_bf16(a[2], a[3]); u.z = pk_bf16(bb[0], bb[1]); u.w = pk_bf16(bb[2], bb[3]);
                Tf[mi][ks] = __builtin_bit_cast(bf16x8, u);
            }
        float sk[4];
#pragma unroll
        for (int m = 0; m < 4; ++m) sk[m] = bts[16 * m + r16] * __expf(gcs[16 * m + r16]);
        wsync();
#pragma unroll
        for (int m = 0; m < 4; ++m) store_T_row(XT, kf[m], sk[m], m, r16, q4);
        wsync();
#pragma unroll
        for (int md = 0; md < 8; ++md) {
            bf16x8 af[2];
#pragma unroll
            for (int ks = 0; ks < 2; ++ks) af[ks] = *(const bf16x8*)(XT + (16 * md + r16) * 72 + 32 * ks + 8 * q4);
#pragma unroll
            for (int mi = 0; mi < 4; ++mi) {
                f32x4 a = {0.f, 0.f, 0.f, 0.f};
#pragma unroll
                for (int ks = 0; ks < 2; ++ks) a = __builtin_amdgcn_mfma_f32_16x16x32_bf16(af[ks], Tf[mi][ks], a, 0, 0, 0);
                *(u32x2*)(proj + (t0 + 16 * mi + r16) * PJ + 768 + h * 128 + 16 * md + 4 * q4) = pack4(a);
            }
        }
        wsync();
#pragma unroll
        for (int m = 0; m < 4; ++m) sk[m] = __expf(gtot - gcs[16 * m + r16]);
#pragma unroll
        for (int m = 0; m < 4; ++m) store_T_row(XT, kf[m], sk[m], m, r16, q4);
        wsync();
#pragma unroll
        for (int e = 0; e < 16; ++e) {
            const int q = lane + 64 * e, d = q >> 3, jc = (q & 7) * 8;
            const u32x4 v = *(const u32x4*)(XT + d * 72 + jc);
            *(u32x4*)(proj + (t0 + (d >> 1)) * PJ + 1280 + h * 128 + (d & 1) * 64 + jc) = v;
        }
        wsync();
        {
            const bf16_t* vb = gq + t0 * 1536 + 1024 + h * 128 + (size_t)r16 * 1536 + 8 * q4;
#pragma unroll
            for (int m = 0; m < 4; ++m) {
                bf16x8 vf[4];
#pragma unroll
                for (int kk = 0; kk < 4; ++kk) vf[kk] = *(const bf16x8*)(vb + (size_t)m * 16 * 1536 + 32 * kk);
                store_T_row(XT, vf, bts[16 * m + r16], m, r16, q4);
            }
        }
        wsync();
#pragma unroll
        for (int nt = 0; nt < 8; ++nt) {
            bf16x8 bfv[2];
#pragma unroll
            for (int ks = 0; ks < 2; ++ks) bfv[ks] = *(const bf16x8*)(XT + (16 * nt + r16) * 72 + 32 * ks + 8 * q4);
            const int n = 16 * nt + r16;
#pragma unroll
            for (int mi = 0; mi < 4; ++mi) {
                f32x4 a = {0.f, 0.f, 0.f, 0.f};
#pragma unroll
                for (int ks = 0; ks < 2; ++ks) a = __builtin_amdgcn_mfma_f32_16x16x32_bf16(Tf[mi][ks], bfv[ks], a, 0, 0, 0);
                *(u32x2*)(gq + (t0 + (n >> 1)) * 1536 + 1024 + h * 128 + (n & 1) * 64 + 16 * mi + 4 * q4) = pack4(a);
            }
        }
        wsync();
    }
}

constexpr int SC_W = 0, SC_QD = 16384, SC_QK = 32768, SC_KD = 40960, SC_UT = 57344, SC_STAGE = 61440;
constexpr int SC_ST = 2 * SC_STAGE, SC_VT = SC_ST + 32 * 136 * 2, SC_GL = SC_VT + 32 * 72 * 2;
DI void gdn_scan(const Params& P, int item, unsigned char* smem) {
    const int tid = tid_(), lane = tid & 63, wid = tid >> 6, r16 = lane & 15, q4 = lane >> 4;
    const int ns = (item >> 3) & 3, bh = ((item & 7) << 1) | (item >> 5), h = bh & 3, b = bh >> 2;
    const int mi = wid & 3, nt = wid >> 2, md = wid;
    bf16_t* ST = (bf16_t*)(smem + SC_ST);
    bf16_t* VT = (bf16_t*)(smem + SC_VT);
    float* gls = (float*)(smem + SC_GL);
    const bf16_t* proj = (const bf16_t*)(P.ws + OFF_U);
    const bf16_t* gq = (const bf16_t*)(P.ws + OFF_GQ);
    const float* glw = (const float*)(P.ws + OFF_GL);
    bf16_t* mixed = (bf16_t*)(P.ws + OFF_XB);
    for (int i = tid; i < 32 * 136 / 2; i += NTHREADS) ((unsigned*)ST)[i] = 0u;
    if (tid < 128) gls[tid] = glw[((b * 128 + tid) << 2) + h];
    const size_t tb = (size_t)b * SEQ;
    const int r4 = tid >> 4, k16 = (tid & 15) ^ (r4 & 15), k8 = (tid & 7) ^ (r4 & 7);
    const bf16_t* pw = proj + (tb + r4) * PJ + 768 + h * 128 + k16 * 8;
    const bf16_t* pq = gq + (tb + r4) * 1536 + h * 128 + k16 * 8;
    const bf16_t* pk = proj + (tb + (tid >> 3)) * PJ + 1792 + h * 128 + k8 * 8;
    const bf16_t* pd = proj + (tb + r4) * PJ + 1280 + h * 128 + ((tid >> 3) & 1) * 64 + k8 * 8;
    const int nu = ns * 32 + ((tid >> 3) & 31);
    const bf16_t* pu = gq + (tb + (nu >> 1)) * 1536 + 1024 + h * 128 + (nu & 1) * 64 + (tid & 7) * 8;
    const unsigned lbase = (unsigned)(size_t)smem + (unsigned)__builtin_amdgcn_readfirstlane(wid) * 1024u;
    const bool uwave = (__builtin_amdgcn_readfirstlane(wid) < 4);
#define SC_ISSUE(c_) do { const unsigned dst_ = lbase + (unsigned)((c_) & 1) * SC_STAGE; const size_t o1_ = (size_t)(c_) * 64 * PJ, o2_ = (size_t)(c_) * 64 * 1536; \
        glds16(pw + o1_, dst_ + SC_W); glds16(pw + o1_ + (size_t)32 * PJ, dst_ + SC_W + 8192u); \
        glds16(pq + o2_, dst_ + SC_QD); glds16(pq + o2_ + (size_t)32 * 1536, dst_ + SC_QD + 8192u); \
        glds16(pk + o1_, dst_ + SC_QK); \
        glds16(pd + o1_, dst_ + SC_KD); glds16(pd + o1_ + (size_t)32 * PJ, dst_ + SC_KD + 8192u); \
        if (uwave) glds16(pu + o2_, dst_ + SC_UT); } while (0)
    const int ow = (16 * mi + r16) * 256, oqk = SC_QK + (16 * mi + r16) * 128, okd = SC_KD + (16 * md + r16) * 128;
    const int out = SC_UT + (16 * nt + r16) * 128 + (16 * mi + 4 * q4) * 2;
    const int x8 = r16 >> 1;
    f32x4 accS[2] = {{0.f, 0.f, 0.f, 0.f}, {0.f, 0.f, 0.f, 0.f}};
    SC_ISSUE(0);
    asm volatile("s_waitcnt vmcnt(0)" ::: "memory");
    __syncthreads();
    for (int c = 0; c < 128; ++c) {
        if (c + 1 < 128) SC_ISSUE(c + 1);
        const unsigned char* sg = smem + (c & 1) * SC_STAGE;
        f32x4 aP = {0.f, 0.f, 0.f, 0.f}, aO = {0.f, 0.f, 0.f, 0.f};
#pragma unroll
        for (int kk = 0; kk < 4; ++kk) {
            const bf16x8 sf = *(const bf16x8*)(ST + (16 * nt + r16) * 136 + 32 * kk + 8 * q4);
            const int co = (((4 * kk + q4) ^ r16) << 4);
            const bf16x8 wf = *(const bf16x8*)(sg + SC_W + ow + co);
            const bf16x8 qd = *(const bf16x8*)(sg + SC_QD + ow + co);
            aP = __builtin_amdgcn_mfma_f32_16x16x32_bf16(wf, sf, aP, 0, 0, 0);
            aO = __builtin_amdgcn_mfma_f32_16x16x32_bf16(qd, sf, aO, 0, 0, 0);
        }
        {
            const u32x2 uu = *(const u32x2*)(sg + out);
            f32x4 vn;
            vn[0] = bf_lo(uu.x) - aP[0]; vn[1] = bf_hi(uu.x) - aP[1]; vn[2] = bf_lo(uu.y) - aP[2]; vn[3] = bf_hi(uu.y) - aP[3];
            *(u32x2*)(VT + (16 * nt + r16) * 72 + 16 * mi + 4 * q4) = pack4(vn);
        }
        lds_barrier();
#pragma unroll
        for (int ks = 0; ks < 2; ++ks) {
            const bf16x8 vf = *(const bf16x8*)(VT + (16 * nt + r16) * 72 + 32 * ks + 8 * q4);
            const bf16x8 qk = *(const bf16x8*)(sg + oqk + (((4 * ks + q4) ^ x8) << 4));
            aO = __builtin_amdgcn_mfma_f32_16x16x32_bf16(qk, vf, aO, 0, 0, 0);
        }
        {
            bf16_t* op = mixed + (tb + (size_t)c * 64 + 16 * mi + 4 * q4) * D + 256 + h * 128 + ns * 32 + 16 * nt + r16;
#pragma unroll
            for (int r = 0; r < 4; ++r) op[(size_t)r * D] = (bf16_t)(pk_bf16(aO[r], 0.f) & 0xffffu);
        }
        const float gl = gls[c];
        bf16x8 kd[2];
#pragma unroll
        for (int ks = 0; ks < 2; ++ks) kd[ks] = *(const bf16x8*)(sg + okd + (((4 * ks + q4) ^ x8) << 4));
#pragma unroll
        for (int n2 = 0; n2 < 2; ++n2) {
            accS[n2] = accS[n2] * gl;
#pragma unroll
            for (int ks = 0; ks < 2; ++ks) {
                const bf16x8 vf = *(const bf16x8*)(VT + (16 * n2 + r16) * 72 + 32 * ks + 8 * q4);
                accS[n2] = __builtin_amdgcn_mfma_f32_16x16x32_bf16(kd[ks], vf, accS[n2], 0, 0, 0);
            }
            *(u32x2*)(ST + (16 * n2 + r16) * 136 + 16 * md + 4 * q4) = pack4(accS[n2]);
        }
        asm volatile("s_waitcnt vmcnt(0)" ::: "memory");
        lds_barrier();
    }
#undef SC_ISSUE
    __syncthreads();
}

DI void phase_mix(const Params& P, int l, unsigned char* smem) {
    const int G = gridDim.x;
    for (int it = blockIdx.x; it < 64; it += G) {
        gdn_scan(P, it, smem);
#if PROBE_SCAN2
        __syncthreads();
        gdn_scan(P, it, smem);
#endif
    }
    const int nvb = (G > 64) ? (G - 64) : G;
    const int vb = (G > 64) ? ((int)blockIdx.x - 64) : (int)blockIdx.x;
    if (vb >= 0) {
        sb_mfma(P, vb * 8 + (tid_() >> 6), nvb * 8); sc_conv(P, l, vb, nvb);
#if PROBE_SBSC2
        sb_mfma(P, vb * 8 + (tid_() >> 6), nvb * 8); sc_conv(P, l, vb, nvb);
#endif
        if (l == 0 && G > 64) { __syncthreads(); prep_weights(P, smem, 0, vb, nvb, 1); prep_weights(P, smem, 1, vb, nvb, 2); }
    }
}

DI void grid_bar(unsigned* cnt, unsigned& gen) {
    __syncthreads();
    gen += gridDim.x;
    if (threadIdx.x == 0) {
        __builtin_amdgcn_fence(__ATOMIC_RELEASE, "agent");
        __hip_atomic_fetch_add(cnt, 1u, __ATOMIC_RELAXED, __HIP_MEMORY_SCOPE_AGENT);
        while (__hip_atomic_load(cnt, __ATOMIC_RELAXED, __HIP_MEMORY_SCOPE_AGENT) < gen) __builtin_amdgcn_s_sleep(2);
        __builtin_amdgcn_fence(__ATOMIC_ACQUIRE, "agent");
    }
    __syncthreads();
}

constexpr int NPH = 8;
__global__ void __launch_bounds__(NTHREADS) mega(Params PK) {
    extern __shared__ __attribute__((aligned(16))) unsigned char smem[];
    cg::grid_group grid = cg::this_grid();
    unsigned bar_gen = 0u;
    for (int ph = PK.ph_lo; ph < PK.ph_hi; ++ph) {
        const Params& P = PK;
        if (ph == 0) phase_prep(P, smem);
        else if (ph == 1 || ph == 4 || ph == 7) {
            const int lo = (ph == 1) ? 0 : (ph == 4 ? 3 : 11), hi = (ph == 1) ? 3 : (ph == 4 ? 11 : 16);
            for (int rb = blockIdx.x; rb < NRB; rb += gridDim.x) run_jobs(P, rb, lo, hi, smem);
        }
        else if (ph == 2 || ph == 5) {
            phase_gdn_prep(P, ph == 2 ? 0 : 1);
            __syncthreads();
            phase_gdn_chunk(P, smem);
        }
        else phase_mix(P, ph == 3 ? 0 : 1, smem);
        if (ph + 1 < PK.ph_hi) { if (ph == 0) grid.sync(); else grid_bar((unsigned*)(PK.ws + OFF_BAR), bar_gen); }
    }
}

extern "C" void kernel_launch(void* const* d_in, const int* in_sizes, int n_in, void* d_out, int out_size, void* d_ws, size_t ws_size, hipStream_t stream) {
    static int grid_blocks = 0;
    if (grid_blocks == 0) {
        if (n_in != 16 || out_size != NTOK * D || ws_size < WS_END) {
            fprintf(stderr, "kernel_launch: unexpected shapes / workspace (n_in %d out %d ws %zu need %zu)\n", n_in, out_size, ws_size, (size_t)WS_END);
            grid_blocks = -1; return;
        }
        int dev = 0, cus = 0, per_cu = 0;
        hipGetDevice(&dev);
        hipDeviceGetAttribute(&cus, hipDeviceAttributeMultiprocessorCount, dev);
        if (hipFuncSetAttribute((const void*)mega, hipFuncAttributeMaxDynamicSharedMemorySize, SMEM_BYTES) != hipSuccess) { fprintf(stderr, "hipFuncSetAttribute failed\n"); grid_blocks = -1; return; }
        hipOccupancyMaxActiveBlocksPerMultiprocessor(&per_cu, (const void*)mega, NTHREADS, SMEM_BYTES);
        if (per_cu < 1) per_cu = 1;
        grid_blocks = cus * per_cu;
        if (grid_blocks > NRB) grid_blocks = NRB;
    }
    if (grid_blocks < 0) return;
    Params P{};
    P.x = (const float*)d_in[0]; P.p = (const float*)d_in[1]; P.ln_g = (const float*)d_in[2]; P.ln_b = (const float*)d_in[3];
    P.ffn_w_in = (const float*)d_in[4]; P.ffn_w_out = (const float*)d_in[5]; P.mix_w_in = (const float*)d_in[6]; P.gdn_conv_w = (const float*)d_in[7];
    P.gdn_a_log = (const float*)d_in[8]; P.gdn_dt_bias = (const float*)d_in[9]; P.gdn_norm_w = (const float*)d_in[10]; P.sc_conv_w = (const float*)d_in[11];
    P.mix_w_out = (const float*)d_in[12]; P.ple_w_proj = (const float*)d_in[13]; P.ple_w_gate = (const float*)d_in[14]; P.ple_b_gate = (const float*)d_in[15];
    P.out = (float*)d_out; P.ws = (unsigned char*)d_ws;
#if N_LAUNCH_MODE == 1
    P.ph_lo = 0; P.ph_hi = NPH;
    void* args[] = {&P};
    hipError_t e = hipLaunchCooperativeKernel((const void*)mega, dim3(grid_blocks), dim3(NTHREADS), args, SMEM_BYTES, stream);
    if (e != hipSuccess) fprintf(stderr, "cooperative launch failed: %s (grid %d)\n", hipGetErrorString(e), grid_blocks);
#else
    for (int ph = 0; ph < NPH; ++ph) {
        P.ph_lo = ph; P.ph_hi = ph + 1;
        void* args[] = {&P};
        hipError_t e = hipLaunchCooperativeKernel((const void*)mega, dim3(grid_blocks), dim3(NTHREADS), args, SMEM_BYTES, stream);
        if (e != hipSuccess) fprintf(stderr, "launch failed: %s (grid %d)\n", hipGetErrorString(e), grid_blocks);
    }
#endif
}
```

```cpp
#include <hip/hip_runtime.h>
#include <hip/hip_cooperative_groups.h>
#include <cstdio>
#include <cstdint>
namespace cg = cooperative_groups;

#define DI __device__ __forceinline__
typedef unsigned short bf16_t;
typedef short bf16x8 __attribute__((ext_vector_type(8)));
typedef float f32x4 __attribute__((ext_vector_type(4)));
typedef unsigned u32x4 __attribute__((ext_vector_type(4)));
typedef unsigned u32x2 __attribute__((ext_vector_type(2)));
typedef __bf16 bf2_t __attribute__((ext_vector_type(2)));
typedef float f2_t __attribute__((ext_vector_type(2)));

#ifndef PROBE_GEMM2
#define PROBE_GEMM2 0
#endif
#ifndef PROBE_MIX2
#define PROBE_MIX2 0
#endif
#ifndef PROBE_PREP2
#define PROBE_PREP2 0
#endif
#ifndef PROBE_GPREP2
#define PROBE_GPREP2 0
#endif
#ifndef PROBE_SCAN2
#define PROBE_SCAN2 0
#endif
#ifndef PROBE_SBSC2
#define PROBE_SBSC2 0
#endif
#ifndef PROBE_TILES2
#define PROBE_TILES2 0
#endif
#ifndef N_LAUNCH_MODE
#define N_LAUNCH_MODE 1
#endif

constexpr int D = 1024, BATCH = 4, SEQ = 8192, NTOK = BATCH * SEQ, DEPTH = 2;
constexpr int DFF = 2816, PLE = 256;
constexpr int PJ = 3584;
constexpr int PJN = 3840;
constexpr int RB = 128;
constexpr int NRB = NTOK / RB;
constexpr float ALPHA = 1.41421356237f;
constexpr int NTHREADS = 512;

constexpr size_t SZ_W1 = (size_t)2 * DFF * D * 2;
constexpr size_t SZ_W2 = (size_t)D * DFF * 2;
constexpr size_t SZ_WIN = (size_t)PJN * D * 2;
constexpr size_t SZ_WSQ = (size_t)D * D * 2;
constexpr size_t SZ_WP = (size_t)D * PLE * 2;
constexpr size_t OFF_W1 = 0;
constexpr size_t OFF_W2 = OFF_W1 + 4 * SZ_W1;
constexpr size_t OFF_WIN = OFF_W2 + 4 * SZ_W2;
constexpr size_t OFF_WOUT = OFF_WIN + 2 * SZ_WIN;
constexpr size_t OFF_WG = OFF_WOUT + 2 * SZ_WSQ;
constexpr size_t OFF_WP = OFF_WG + 2 * SZ_WSQ;
constexpr size_t OFF_XB = OFF_WP + 2 * SZ_WP;
constexpr size_t OFF_U = OFF_XB + (size_t)NTOK * D * 2;
constexpr size_t OFF_GQ = OFF_U + (size_t)NTOK * PJ * 2;
constexpr size_t OFF_AB = OFF_GQ + (size_t)NTOK * 1536 * 2;
constexpr size_t OFF_GB = OFF_AB + (size_t)NTOK * 8 * 4;
constexpr size_t OFF_GL = OFF_GB + (size_t)NTOK * 8 * 4;
constexpr size_t OFF_BAR = OFF_GL + 2048 * 4;
constexpr size_t OFF_HALO = OFF_BAR + 128;
constexpr size_t OFF_ST = OFF_HALO + (size_t)NRB * 3 * 1536 * 2;
constexpr size_t WS_END = OFF_ST + (size_t)NTOK * 2 * 4;

struct Params {
    const float *x, *p, *ln_g, *ln_b, *ffn_w_in, *ffn_w_out, *mix_w_in, *gdn_conv_w, *gdn_a_log, *gdn_dt_bias, *gdn_norm_w, *sc_conv_w,
        *mix_w_out, *ple_w_proj, *ple_w_gate, *ple_b_gate;
    float* out;
    unsigned char* ws;
    int ph_lo, ph_hi;
};

DI unsigned pk_bf16(float a, float b) { bf2_t v = __builtin_convertvector((f2_t){a, b}, bf2_t); return __builtin_bit_cast(unsigned, v); }
DI float bf_lo(unsigned u) { return __uint_as_float(u << 16); }
DI float bf_hi(unsigned u) { return __uint_as_float(u & 0xffff0000u); }
DI float bf2f(bf16_t h) { return __uint_as_float(((unsigned)h) << 16); }
DI float sigmoidf_(float x) { return __builtin_amdgcn_rcpf(1.0f + __expf(-x)); }
DI float softplusf_(float x) { return fmaxf(x, 0.f) + log1pf(__expf(-fabsf(x))); }
DI u32x2 pack4(const f32x4 a) { u32x2 w; w.x = pk_bf16(a[0], a[1]); w.y = pk_bf16(a[2], a[3]); return w; }
DI float wave_sum(float v) {
#pragma unroll
    for (int o = 32; o >= 1; o >>= 1) v += __shfl_xor(v, o);
    return v;
}

DI int tid_() { int t = threadIdx.x; asm volatile("" : "+v"(t)); return t; }
DI void glds16(const void* gsrc, unsigned lds_dst) {
    unsigned keep;
    asm volatile("s_mov_b32 %0, m0\n\ts_mov_b32 m0, %2\n\ts_nop 0\n\tglobal_load_lds_dwordx4 %1, off\n\ts_mov_b32 m0, %0" : "=&s"(keep) : "v"(gsrc), "s"(lds_dst) : "memory");
}
DI void glds16x6(const void* sa, const void* sb, unsigned va0, unsigned va1, unsigned vb0, unsigned vb1, unsigned vb2, unsigned vb3, unsigned lds_dst) {
    unsigned keep;
    asm volatile("s_mov_b32 %0, m0\n\ts_mov_b32 m0, %9\n\ts_nop 0\n\t"
                 "global_load_lds_dwordx4 %3, %1\n\ts_add_u32 m0, m0, 0x2000\n\ts_nop 0\n\t"
                 "global_load_lds_dwordx4 %4, %1\n\ts_add_u32 m0, m0, 0x2000\n\ts_nop 0\n\t"
                 "global_load_lds_dwordx4 %5, %2\n\ts_add_u32 m0, m0, 0x2000\n\ts_nop 0\n\t"
                 "global_load_lds_dwordx4 %6, %2\n\ts_add_u32 m0, m0, 0x2000\n\ts_nop 0\n\t"
                 "global_load_lds_dwordx4 %7, %2\n\ts_add_u32 m0, m0, 0x2000\n\ts_nop 0\n\t"
                 "global_load_lds_dwordx4 %8, %2\n\ts_mov_b32 m0, %0"
                 : "=&s"(keep) : "s"(sa), "s"(sb), "v"(va0), "v"(va1), "v"(vb0), "v"(vb1), "v"(vb2), "v"(vb3), "s"(lds_dst) : "memory", "scc");
}
DI void glds16x5(const void* sa, const void* sb, unsigned va, unsigned vb0, unsigned vb1, unsigned vb2, unsigned vb3, unsigned lds_dst) {
    unsigned keep;
    asm volatile("s_mov_b32 %0, m0\n\ts_mov_b32 m0, %8\n\ts_nop 0\n\t"
                 "global_load_lds_dwordx4 %3, %1\n\ts_add_u32 m0, m0, 0x2000\n\ts_nop 0\n\t"
                 "global_load_lds_dwordx4 %4, %2\n\ts_add_u32 m0, m0, 0x2000\n\ts_nop 0\n\t"
                 "global_load_lds_dwordx4 %5, %2\n\ts_add_u32 m0, m0, 0x2000\n\ts_nop 0\n\t"
                 "global_load_lds_dwordx4 %6, %2\n\ts_add_u32 m0, m0, 0x2000\n\ts_nop 0\n\t"
                 "global_load_lds_dwordx4 %7, %2\n\ts_mov_b32 m0, %0"
                 : "=&s"(keep) : "s"(sa), "s"(sb), "v"(va), "v"(vb0), "v"(vb1), "v"(vb2), "v"(vb3), "s"(lds_dst) : "memory", "scc");
}
DI void lds_barrier() { asm volatile("s_waitcnt lgkmcnt(0)\n\ts_barrier" ::: "memory"); }
constexpr int LDS_ROW = 144;
constexpr int A_STAGE = 128 * LDS_ROW;
constexpr int B_STAGE = 256 * LDS_ROW;
constexpr int STAGE = A_STAGE + B_STAGE;
constexpr int G3_A = 16384, G3_STAGE = 49152;
constexpr int H5_A = 8192, H5_STAGE = 40960;
constexpr int CHUNK_WAVE_LDS = 18944;
constexpr int SMEM_BYTES = 8 * CHUNK_WAVE_LDS;

DI void gemm_tile(const bf16_t* __restrict__ A, int lda, const bf16_t* __restrict__ Bt, int ldb, int K, unsigned char* smem, f32x4 (&acc)[4][4], bool zero = true) {
    const int tid = tid_(), lane = tid & 63, wid = tid >> 6;
    const int wm = wid >> 2, wn = wid & 3;
#pragma unroll
    for (int i = 0; i < 4; ++i)
#pragma unroll
        for (int j = 0; j < 4; ++j) if (zero) acc[i][j] = (f32x4){0.f, 0.f, 0.f, 0.f};
    const int crow = tid >> 3, ckc = tid & 7;
    const bf16_t* ag = A + (size_t)crow * lda + ckc * 8;
    const bf16_t* bg = Bt + (size_t)crow * ldb + ckc * 8;
    u32x4 ra[2], rb[4];
#pragma unroll
    for (int i = 0; i < 2; ++i) ra[i] = *(const u32x4*)(ag + (size_t)i * 64 * lda);
#pragma unroll
    for (int i = 0; i < 4; ++i) rb[i] = *(const u32x4*)(bg + (size_t)i * 64 * ldb);
    const int soff = crow * LDS_ROW + ckc * 16;
#pragma unroll
    for (int i = 0; i < 2; ++i) *(u32x4*)(smem + soff + i * 64 * LDS_ROW) = ra[i];
#pragma unroll
    for (int i = 0; i < 4; ++i) *(u32x4*)(smem + A_STAGE + soff + i * 64 * LDS_ROW) = rb[i];
    __syncthreads();
    const int nk = K >> 6;
    const int fa = (wm * 64 + (lane & 15)) * LDS_ROW + (lane >> 4) * 16;
    const int fb = A_STAGE + (wn * 64 + (lane & 15)) * LDS_ROW + (lane >> 4) * 16;
    for (int kt = 0; kt < nk; ++kt) {
        const int cur = kt & 1;
        const bool more = (kt + 1 < nk);
        if (more) {
            const int ko = (kt + 1) * 64;
#pragma unroll
            for (int i = 0; i < 2; ++i) ra[i] = *(const u32x4*)(ag + (size_t)i * 64 * lda + ko);
#pragma unroll
            for (int i = 0; i < 4; ++i) rb[i] = *(const u32x4*)(bg + (size_t)i * 64 * ldb + ko);
        }
        const unsigned char* sc = smem + cur * STAGE;
#pragma unroll
        for (int ks = 0; ks < 2; ++ks) {
            bf16x8 af[4], bfr[4];
#pragma unroll
            for (int mt = 0; mt < 4; ++mt) af[mt] = *(const bf16x8*)(sc + fa + mt * 16 * LDS_ROW + ks * 64);
#pragma unroll
            for (int nt = 0; nt < 4; ++nt) bfr[nt] = *(const bf16x8*)(sc + fb + nt * 16 * LDS_ROW + ks * 64);
#pragma unroll
            for (int mt = 0; mt < 4; ++mt)
#pragma unroll
                for (int nt = 0; nt < 4; ++nt) acc[mt][nt] = __builtin_amdgcn_mfma_f32_16x16x32_bf16(bfr[nt], af[mt], acc[mt][nt], 0, 0, 0);
        }
        if (more) {
            unsigned char* sn = smem + (cur ^ 1) * STAGE;
#pragma unroll
            for (int i = 0; i < 2; ++i) *(u32x4*)(sn + soff + i * 64 * LDS_ROW) = ra[i];
#pragma unroll
            for (int i = 0; i < 4; ++i) *(u32x4*)(sn + A_STAGE + soff + i * 64 * LDS_ROW) = rb[i];
        }
        __syncthreads();
    }
}

DI int colmap(int mode, int n) {
    if (mode == 0) return n;
    if (mode == 1) { const int a = (n >> 4) & 7; return (a & 1) * DFF + (n >> 9) * 256 + ((n >> 7) & 3) * 64 + ((n >> 2) & 3) * 16 + (a >> 1) * 4 + (n & 3); }
    if (n < 2816) return n;
    if (n < 3584) return n + 8;
    if (n < 3592) return n - 3584 + 2816;
    return -1;
}
DI void transpose_tile(const float* __restrict__ src, int Nsrc, int K, bf16_t* __restrict__ dst, int mode, int k0, int n0, float* tile  ) {
    const int tid = tid_();
    const int n4 = (tid & 15) * 4;
    const int c = colmap(mode, n0 + n4);
#pragma unroll
    for (int i = 0; i < 2; ++i) {
        const int kk = (tid >> 4) + 32 * i;
        f32x4 v = {0.f, 0.f, 0.f, 0.f};
        if (c >= 0) v = __builtin_nontemporal_load((const f32x4*)(src + (size_t)(k0 + kk) * Nsrc + c));
        tile[kk * 65 + n4] = v[0]; tile[kk * 65 + n4 + 1] = v[1]; tile[kk * 65 + n4 + 2] = v[2]; tile[kk * 65 + n4 + 3] = v[3];
    }
    __syncthreads();
    const int n = tid >> 3, ks = (tid & 7) * 8;
    u32x4 w;
    w.x = pk_bf16(tile[(ks + 0) * 65 + n], tile[(ks + 1) * 65 + n]);
    w.y = pk_bf16(tile[(ks + 2) * 65 + n], tile[(ks + 3) * 65 + n]);
    w.z = pk_bf16(tile[(ks + 4) * 65 + n], tile[(ks + 5) * 65 + n]);
    w.w = pk_bf16(tile[(ks + 6) * 65 + n], tile[(ks + 7) * 65 + n]);
    *(u32x4*)(dst + ((size_t)((n0 >> 8) * (K >> 6) + (k0 >> 6)) * 256 + (n0 & 255) + n) * 64 + ks) = w;
    __syncthreads();
}
DI void prep_weights(const Params& P, unsigned char* smem, int L, int vb, int nvb, int part  ) {
    float* tile = (float*)smem;
    unsigned char* ws = P.ws;
    constexpr int T_W1 = 16 * 88, T_W2 = 44 * 16, T_WIN = 16 * 60, T_SQ = 16 * 16, T_WP = 4 * 16;
    constexpr int E1 = 2 * T_W1, E2 = E1 + 2 * T_W2, E3 = E2 + T_WIN, E4 = E3 + T_SQ, E5 = E4 + T_SQ, E6 = E5 + T_WP;
    for (int idx = vb; idx < E6; idx += nvb) {
        const bool early = (idx < T_W1) || (idx >= E1 && idx < E1 + T_W2) || (idx >= E2 && idx < E3);
        if (part != 2 && early != (part == 0)) continue;
        if (idx < E1) { const int j = L * 2 + idx / T_W1, t = idx % T_W1; const int kt = t / 88, nt = t % 88;
            transpose_tile(P.ffn_w_in + (size_t)j * D * 2 * DFF, 2 * DFF, D, (bf16_t*)(ws + OFF_W1 + j * SZ_W1), 1, kt * 64, nt * 64, tile); }
        else if (idx < E2) { const int q = idx - E1; const int j = L * 2 + q / T_W2, t = q % T_W2; const int kt = t / 16, nt = t % 16;
            transpose_tile(P.ffn_w_out + (size_t)j * DFF * D, D, DFF, (bf16_t*)(ws + OFF_W2 + j * SZ_W2), 0, kt * 64, nt * 64, tile); }
        else if (idx < E3) { const int t = idx - E2; const int kt = t / 60, nt = t % 60;
            transpose_tile(P.mix_w_in + (size_t)L * D * 3592, 3592, D, (bf16_t*)(ws + OFF_WIN + L * SZ_WIN), 2, kt * 64, nt * 64, tile); }
        else if (idx < E4) { const int t = idx - E3; const int kt = t / 16, nt = t % 16;
            transpose_tile(P.mix_w_out + (size_t)L * D * D, D, D, (bf16_t*)(ws + OFF_WOUT + L * SZ_WSQ), 0, kt * 64, nt * 64, tile); }
        else if (idx < E5) { const int t = idx - E4; const int kt = t / 16, nt = t % 16;
            transpose_tile(P.ple_w_gate + (size_t)L * D * D, D, D, (bf16_t*)(ws + OFF_WG + L * SZ_WSQ), 0, kt * 64, nt * 64, tile); }
        else { const int t = idx - E5; const int kt = t / 16, nt = t % 16;
            transpose_tile(P.ple_w_proj + (size_t)L * PLE * D, D, PLE, (bf16_t*)(ws + OFF_WP + L * SZ_WP), 0, kt * 64, nt * 64, tile); }
    }
}
DI void phase_prep(const Params& P, unsigned char* smem) {
    unsigned char* ws = P.ws;
    prep_weights(P, smem, 0, blockIdx.x, gridDim.x, (gridDim.x <= 64) ? 2 : 0);
    if (gridDim.x <= 64) prep_weights(P, smem, 1, blockIdx.x, gridDim.x, 2);
    if (blockIdx.x == 0 && threadIdx.x == 0) *(unsigned*)(ws + OFF_BAR) = 0u;
    bf16_t* xb = (bf16_t*)(ws + OFF_XB);
    const size_t n4 = (size_t)NTOK * D / 4;
    const int tidp = tid_();
    for (size_t i = (size_t)blockIdx.x * NTHREADS + tidp; i < n4; i += (size_t)gridDim.x * NTHREADS) {
        const f32x4 v = *(const f32x4*)(P.x + i * 4);
        u32x2 w; w.x = pk_bf16(v[0], v[1]); w.y = pk_bf16(v[2], v[3]);
        *(u32x2*)(xb + i * 4) = w;
    }
}

DI void ln_rows(float* xr, bf16_t* xbr, const float* __restrict__ g, const float* __restrict__ b, float* stp, bool write_f32) {
    const int tidl = tid_();
    const int lane = tidl & 63, wid = tidl >> 6;
    f32x4 gv[4], bv[4];
#pragma unroll
    for (int i = 0; i < 4; ++i) { gv[i] = *(const f32x4*)(g + i * 256 + lane * 4); bv[i] = *(const f32x4*)(b + i * 256 + lane * 4); }
    for (int r0 = wid * 16; r0 < wid * 16 + 16; r0 += 4) {
        f32x4 v[4][4];
#pragma unroll
        for (int q = 0; q < 4; ++q)
#pragma unroll
            for (int i = 0; i < 4; ++i) v[q][i] = *(const f32x4*)(xr + (size_t)(r0 + q) * D + i * 256 + lane * 4);
        float s[4], qq[4];
#pragma unroll
        for (int q = 0; q < 4; ++q) {
            s[q] = 0.f;
#pragma unroll
            for (int i = 0; i < 4; ++i) s[q] += (v[q][i][0] + v[q][i][1]) + (v[q][i][2] + v[q][i][3]);
        }
#pragma unroll
        for (int o = 32; o >= 1; o >>= 1)
#pragma unroll
            for (int q = 0; q < 4; ++q) s[q] += __shfl_xor(s[q], o);
#pragma unroll
        for (int q = 0; q < 4; ++q) {
            const float mu = s[q] * (1.0f / D);
            qq[q] = 0.f;
#pragma unroll
            for (int i = 0; i < 4; ++i) { v[q][i] = v[q][i] - mu; qq[q] += (v[q][i][0] * v[q][i][0] + v[q][i][1] * v[q][i][1]) + (v[q][i][2] * v[q][i][2] + v[q][i][3] * v[q][i][3]); }
        }
#pragma unroll
        for (int o = 32; o >= 1; o >>= 1)
#pragma unroll
            for (int q = 0; q < 4; ++q) qq[q] += __shfl_xor(qq[q], o);
#pragma unroll
        for (int q = 0; q < 4; ++q) {
            const float rs = rsqrtf(qq[q] * (1.0f / D) + 1e-5f);
            if (lane == 0) { stp[(r0 + q) * 2] = s[q] * (1.0f / D); stp[(r0 + q) * 2 + 1] = rs; }
#pragma unroll
            for (int i = 0; i < 4; ++i) {
                const f32x4 o = v[q][i] * rs * gv[i] + bv[i];
                if (write_f32) *(f32x4*)(xr + (size_t)(r0 + q) * D + i * 256 + lane * 4) = o;
                if (!write_f32) {
                    u32x2 w; w.x = pk_bf16(o[0], o[1]); w.y = pk_bf16(o[2], o[3]);
                    *(u32x2*)(xbr + (size_t)(r0 + q) * D + i * 256 + lane * 4) = w;
                }
            }
        }
    }
}

DI void run_jobs(const Params& P, int rb, int jj_lo, int jj_hi, unsigned char* smem) {
    float* xr = P.out + (size_t)rb * RB * D;
    bf16_t* xbr = (bf16_t*)(P.ws + OFF_XB) + (size_t)rb * RB * D;
    bf16_t* ureg = (bf16_t*)(P.ws + OFF_U) + (size_t)rb * RB * PJ;
    float* pps = (float*)ureg;
    bf16_t* pbf = (bf16_t*)((unsigned char*)ureg + (size_t)RB * D * 4);
    float* ab = (float*)(P.ws + OFF_AB) + (size_t)rb * RB * 8;
    for (int jj = jj_lo; jj < jj_hi; ++jj) {
        const int tid = tid_(), lane = tid & 63, wid = tid >> 6, wm = wid >> 2, wn = wid & 3;
        const int l = jj >> 3, j = jj & 7;
        if (j == 3) {
            const int hh = lane >> 4, cl = (lane & 15) * 8;
            const float* nw = P.gdn_norm_w + (size_t)l * 128 + cl;
            const f32x4 nw0 = *(const f32x4*)nw, nw1 = *(const f32x4*)(nw + 4);
            for (int r0 = wid * 16; r0 < wid * 16 + 16; r0 += 4) {
                u32x4 ov[4], zv[4];
#pragma unroll
                for (int q = 0; q < 4; ++q) {
                    ov[q] = *(const u32x4*)(xbr + (size_t)(r0 + q) * D + 256 + hh * 128 + cl);
                    zv[q] = *(const u32x4*)(ureg + (size_t)(r0 + q) * PJ + 2304 + hh * 128 + cl);
                }
#pragma unroll
                for (int q = 0; q < 4; ++q) {
                    float o[8], z[8];
#pragma unroll
                    for (int e = 0; e < 4; ++e) { o[2 * e] = bf_lo(ov[q][e]); o[2 * e + 1] = bf_hi(ov[q][e]); z[2 * e] = bf_lo(zv[q][e]); z[2 * e + 1] = bf_hi(zv[q][e]); }
                    float ss = 0.f;
#pragma unroll
                    for (int e = 0; e < 8; ++e) ss += o[e] * o[e];
                    ss += __shfl_xor(ss, 1); ss += __shfl_xor(ss, 2); ss += __shfl_xor(ss, 4); ss += __shfl_xor(ss, 8);
                    const float rs = rsqrtf(ss * (1.0f / 128.f) + 1e-6f);
                    float y[8];
#pragma unroll
                    for (int e = 0; e < 8; ++e) y[e] = o[e] * rs * ((e < 4) ? nw0[e & 3] : nw1[e & 3]) * (z[e] * sigmoidf_(z[e]));
                    u32x4 w; w.x = pk_bf16(y[0], y[1]); w.y = pk_bf16(y[2], y[3]); w.z = pk_bf16(y[4], y[5]); w.w = pk_bf16(y[6], y[7]);
                    *(u32x4*)(xbr + (size_t)(r0 + q) * D + 256 + hh * 128 + cl) = w;
                }
            }
            __syncthreads();
        }
        if (j == 6) {
            const float* pin = P.p + ((size_t)l * NTOK + (size_t)rb * RB) * PLE;
            for (int i = tid; i < RB * PLE / 4; i += NTHREADS) {
                const f32x4 v = *(const f32x4*)(pin + (size_t)i * 4);
                u32x2 w; w.x = pk_bf16(v[0], v[1]); w.y = pk_bf16(v[2], v[3]);
                *(u32x2*)(pbf + (size_t)i * 4) = w;
            }
            __syncthreads();
        }
        const bf16_t* A; const bf16_t* Bt; int lda, K, nt;
        if (j == 0 || j == 4) { A = xbr; lda = D; K = D; nt = 22; Bt = (const bf16_t*)(P.ws + OFF_W1 + (size_t)(l * 2 + (j >> 2)) * SZ_W1); }
        else if (j == 1 || j == 5) { A = ureg; lda = DFF; K = DFF; nt = 4; Bt = (const bf16_t*)(P.ws + OFF_W2 + (size_t)(l * 2 + (j >> 2)) * SZ_W2); }
        else if (j == 2) { A = xbr; lda = D; K = D; nt = 14; Bt = (const bf16_t*)(P.ws + OFF_WIN + (size_t)l * SZ_WIN); }
        else if (j == 3) { A = xbr; lda = D; K = D; nt = 4; Bt = (const bf16_t*)(P.ws + OFF_WOUT + (size_t)l * SZ_WSQ); }
        else if (j == 6) { A = pbf; lda = PLE; K = PLE; nt = 4; Bt = (const bf16_t*)(P.ws + OFF_WP + (size_t)l * SZ_WP); }
        else { A = xbr; lda = D; K = D; nt = 4; Bt = (const bf16_t*)(P.ws + OFF_WG + (size_t)l * SZ_WSQ); }
        const float* resid = (jj == 1) ? (P.x + (size_t)rb * RB * D) : xr;
        const float rsc = (j == 3) ? 1.0f : 0.5f;
        const float* bgate = P.ple_b_gate + (size_t)l * D;
        float* stp = (float*)(P.ws + OFF_ST) + (size_t)rb * RB * 2;
        const bool rec = (j == 1 || j == 3 || j == 5 || j == 7) && (jj != 1);
        const int lsrc = (j == 1) ? (l * 4 - 1) : (l * 4 + ((j - 3) >> 1));
        const float* lng = P.ln_g + (size_t)(rec ? lsrc : 0) * D;
        const float* lnb = P.ln_b + (size_t)(rec ? lsrc : 0) * D;
        {
            const int nk = K >> 5, nk64 = K >> 6, ntw = nt >> 1, S = ntw * nk;
            const int drow = tid >> 2, kcs = (tid & 3) ^ ((4 - ((tid >> 4) & 3)) & 3);
            const unsigned va = (unsigned)((drow * lda + kcs * 8) * 2);
            const unsigned vb0 = (unsigned)((drow * 64 + kcs * 8) * 2), vb1 = vb0 + 16384u;
            const unsigned vb2 = vb0 + (unsigned)nk64 * 32768u, vb3 = vb2 + 16384u;
            const unsigned lbase = (unsigned)(size_t)smem + (unsigned)__builtin_amdgcn_readfirstlane(wid) * 1024u;
            const int r16 = lane & 15, q4 = lane >> 4;
            const int ko = ((q4 ^ ((4 - (r16 >> 2)) & 3)) << 4);
            const int fa = (wm * 64 + r16) * 64 + ko, fb = H5_A + (wn * 128 + r16) * 64 + ko;
            f32x4 acc[4][8];
#pragma unroll
            for (int i = 0; i < 4; ++i)
#pragma unroll
                for (int jq = 0; jq < 8; ++jq) acc[i][jq] = (f32x4){0.f, 0.f, 0.f, 0.f};
            const int toff = (int)((blockIdx.x & 7u) * (unsigned)ntw) >> 3;
            const int koff = (int)((blockIdx.x >> 3) * (unsigned)nk) >> 5;
            int kp = 0, sp = 0, tp = toff;
            const bf16_t* pbt = Bt + (size_t)toff * 512 * K;
#define ISSUE() do { const int ka_ = (kp + koff >= nk) ? kp + koff - nk : kp + koff; \
                glds16x5(A + ka_ * 32, pbt + (size_t)(ka_ >> 1) * 16384 + (ka_ & 1) * 32, va, vb0, vb1, vb2, vb3, lbase + (unsigned)sp * H5_STAGE); \
                ++kp; if (kp == nk) { kp = 0; ++tp; pbt += (size_t)512 * K; if (tp == ntw) { tp = 0; pbt = Bt; } } sp = (sp == 2) ? 0 : sp + 1; } while (0)
            ISSUE();
            ISSUE();
            ISSUE();
            asm volatile("s_waitcnt vmcnt(10)" ::: "memory");
            lds_barrier();
            int kt = 0, t = toff, st = 0;
            for (int s = 0; s < S; ++s) {
                const unsigned char* sc_ = smem + st * H5_STAGE;
                bf16x8 af[4], bfr[8];
#pragma unroll
                for (int mt = 0; mt < 4; ++mt) af[mt] = *(const bf16x8*)(sc_ + fa + mt * 1024);
#pragma unroll
                for (int n_ = 0; n_ < 8; ++n_) bfr[n_] = *(const bf16x8*)(sc_ + fb + n_ * 1024);
                if (kt == 0) {
#pragma unroll
                    for (int i = 0; i < 4; ++i)
#pragma unroll
                        for (int jq = 0; jq < 8; ++jq) acc[i][jq] = (f32x4){0.f, 0.f, 0.f, 0.f};
                }
#pragma unroll
                for (int mt = 0; mt < 4; ++mt)
#pragma unroll
                    for (int n_ = 0; n_ < 8; ++n_) acc[mt][n_] = __builtin_amdgcn_mfma_f32_16x16x32_bf16(bfr[n_], af[mt], acc[mt][n_], 0, 0, 0);
                if (s + 2 < S) asm volatile("s_waitcnt vmcnt(5)" ::: "memory");
                else asm volatile("s_waitcnt vmcnt(0)" ::: "memory");
                lds_barrier();
                if (s + 3 < S) ISSUE();
                st = (st == 2) ? 0 : st + 1;
                ++kt;
                if (kt == nk) {
                    kt = 0;
                    const int row0 = wm * 64 + r16;
                    const int col0 = t * 512 + wn * 128 + q4 * 4;
                    if (j == 0 || j == 4) {
                        bf16_t* hp = ureg + (size_t)row0 * DFF + t * 256 + wn * 64 + q4 * 16;
#pragma unroll
                        for (int mt = 0; mt < 4; ++mt) {
                            float hv[16];
#pragma unroll
                            for (int pr = 0; pr < 4; ++pr)
#pragma unroll
                                for (int r = 0; r < 4; ++r) { const float g = acc[mt][2 * pr][r]; hv[pr * 4 + r] = g * sigmoidf_(g) * acc[mt][2 * pr + 1][r]; }
                            u32x4 w0, w1;
                            w0.x = pk_bf16(hv[0], hv[1]); w0.y = pk_bf16(hv[2], hv[3]); w0.z = pk_bf16(hv[4], hv[5]); w0.w = pk_bf16(hv[6], hv[7]);
                            w1.x = pk_bf16(hv[8], hv[9]); w1.y = pk_bf16(hv[10], hv[11]); w1.z = pk_bf16(hv[12], hv[13]); w1.w = pk_bf16(hv[14], hv[15]);
                            *(u32x4*)(hp + (size_t)mt * 16 * DFF) = w0;
                            *(u32x4*)(hp + (size_t)mt * 16 * DFF + 8) = w1;
                        }
                    } else if (j == 1 || j == 5 || j == 3) {
#pragma unroll
                        for (int mt = 0; mt < 4; ++mt)
#pragma unroll
                            for (int nn = 0; nn < 8; ++nn) {
                                if ((nn & 3) == 0) asm volatile("" ::: "memory");
                                const size_t o = (size_t)(row0 + mt * 16) * D + col0 + nn * 16;
                                f32x4 rv = *(const f32x4*)(resid + o);
                                if (rec) {
                                    const float mu = stp[(row0 + mt * 16) * 2], rs = stp[(row0 + mt * 16) * 2 + 1];
                                    rv = (rv - mu) * rs * *(const f32x4*)(lng + col0 + nn * 16) + *(const f32x4*)(lnb + col0 + nn * 16);
                                }
                                *(f32x4*)(xr + o) = rv * ALPHA + acc[mt][nn] * rsc;
                            }
                    } else if (j == 2) {
#pragma unroll
                        for (int mt = 0; mt < 4; ++mt)
#pragma unroll
                            for (int nn = 0; nn < 8; ++nn) {
                                u32x2 w; w.x = pk_bf16(acc[mt][nn][0], acc[mt][nn][1]); w.y = pk_bf16(acc[mt][nn][2], acc[mt][nn][3]);
                                *(u32x2*)(ureg + (size_t)(row0 + mt * 16) * PJ + col0 + nn * 16) = w;
                            }
                    } else if (j == 6) {
#pragma unroll
                        for (int mt = 0; mt < 4; ++mt)
#pragma unroll
                            for (int nn = 0; nn < 8; ++nn) *(u32x2*)((bf16_t*)pps + (size_t)(row0 + mt * 16) * D + col0 + nn * 16) = pack4(acc[mt][nn]);
                    } else {
#pragma unroll
                        for (int mt = 0; mt < 4; ++mt)
#pragma unroll
                            for (int nn = 0; nn < 8; ++nn) {
                                if ((nn & 1) == 0) asm volatile("" ::: "memory");
                                const size_t o = (size_t)(row0 + mt * 16) * D + col0 + nn * 16;
                                const f32x4 bv = *(const f32x4*)(bgate + col0 + nn * 16);
                                const u32x2 pu = *(const u32x2*)((const bf16_t*)pps + o);
                                const f32x4 pv = {bf_lo(pu.x), bf_hi(pu.x), bf_lo(pu.y), bf_hi(pu.y)};
                                f32x4 xv = *(const f32x4*)(xr + o);
                                {
                                    const float mu = stp[(row0 + mt * 16) * 2], rs = stp[(row0 + mt * 16) * 2 + 1];
                                    xv = (xv - mu) * rs * *(const f32x4*)(lng + col0 + nn * 16) + *(const f32x4*)(lnb + col0 + nn * 16);
                                }
                                f32x4 ov;
#pragma unroll
                                for (int r = 0; r < 4; ++r) ov[r] = xv[r] * ALPHA + sigmoidf_(acc[mt][nn][r] + bv[r]) * pv[r];
                                *(f32x4*)(xr + o) = ov;
                            }
                    }
                    ++t; if (t == ntw) t = 0;
                }
            }
#undef ISSUE
        }
        if (j == 2) {
            const int r16 = lane & 15, q4 = lane >> 4;
            const bf16_t* arow = xbr + (size_t)(wid * 16 + r16) * D + 8 * q4;
            const bf16_t* wrow = Bt + ((size_t)(14 * 16) * 256 + r16) * 64 + 8 * q4;
            f32x4 c = {0.f, 0.f, 0.f, 0.f};
#pragma unroll 8
            for (int kk = 0; kk < 32; ++kk) {
                const bf16x8 af = *(const bf16x8*)(arow + 32 * kk);
                const bf16x8 wf = *(const bf16x8*)(wrow + (size_t)(kk >> 1) * 16384 + (kk & 1) * 32);
                c = __builtin_amdgcn_mfma_f32_16x16x32_bf16(wf, af, c, 0, 0, 0);
            }
            if (q4 < 2) *(f32x4*)(ab + (size_t)(wid * 16 + r16) * 8 + q4 * 4) = c;
            __syncthreads();
            bf16_t* halo = (bf16_t*)(P.ws + OFF_HALO) + (size_t)rb * 3 * 1536;
            for (int i = tid; i < 3 * 192; i += NTHREADS) {
                const int rr = i / 192, cc = (i % 192) * 8;
                *(u32x4*)(halo + rr * 1536 + cc) = *(const u32x4*)(ureg + (size_t)(125 + rr) * PJ + 768 + cc);
            }
        }
        __syncthreads();
        if (j == 1 || j == 3 || j == 5 || j == 7) {
            const int li = l * 4 + ((j - 1) >> 1);
            ln_rows(xr, xbr, P.ln_g + (size_t)li * D, P.ln_b + (size_t)li * D, stp, jj == 15);
            __syncthreads();
        }
    }
}

DI void phase_gdn_prep(const Params& P, int l) {
    const int tid = tid_(), lane = tid & 63, wid = tid >> 6;
    const int h = lane >> 4, cl = (lane & 15) * 8;
    const bf16_t* proj = (const bf16_t*)(P.ws + OFF_U);
    const bf16_t* halo = (const bf16_t*)(P.ws + OFF_HALO);
    bf16_t* gq = (bf16_t*)(P.ws + OFF_GQ);
    const float* cw = P.gdn_conv_w + (size_t)l * 4 * 1536;
    const float* ab = (const float*)(P.ws + OFF_AB);
    float* gb = (float*)(P.ws + OFF_GB);
    for (int rb = blockIdx.x; rb < NRB; rb += gridDim.x) {
        for (int itl = wid; itl < 96; itl += 8) {
            const int which = itl % 3, tgl = itl / 3;
            const int t0 = rb * RB + tgl * 4, s0 = t0 & (SEQ - 1);
            const int c = which * 512 + h * 128 + cl;
            f32x4 w[4][2];
#pragma unroll
            for (int i = 0; i < 4; ++i) { w[i][0] = *(const f32x4*)(cw + i * 1536 + c); w[i][1] = *(const f32x4*)(cw + i * 1536 + c + 4); }
            u32x4 x[7];
#pragma unroll
            for (int rr = 0; rr < 7; ++rr) {
                if (tgl == 0 && rr < 3) {
                    if (s0 > 0) x[rr] = *(const u32x4*)(halo + ((size_t)(rb - 1) * 3 + rr) * 1536 + c);
                    else x[rr] = (u32x4){0u, 0u, 0u, 0u};
                } else x[rr] = *(const u32x4*)(proj + (size_t)(t0 - 3 + rr) * PJ + 768 + c);
            }
#pragma unroll
            for (int tk = 0; tk < 4; ++tk) {
                float y[8];
#pragma unroll
                for (int e = 0; e < 8; ++e) y[e] = 0.f;
#pragma unroll
                for (int i = 0; i < 4; ++i)
#pragma unroll
                    for (int jj = 0; jj < 4; ++jj) {
                        y[2 * jj] += w[i][jj >> 1][(2 * jj) & 3] * bf_lo(x[tk + i][jj]);
                        y[2 * jj + 1] += w[i][jj >> 1][(2 * jj + 1) & 3] * bf_hi(x[tk + i][jj]);
                    }
                float ss = 0.f;
#pragma unroll
                for (int e = 0; e < 8; ++e) { y[e] = y[e] * sigmoidf_(y[e]); ss += y[e] * y[e]; }
                if (which < 2) {
                    ss += __shfl_xor(ss, 1); ss += __shfl_xor(ss, 2); ss += __shfl_xor(ss, 4); ss += __shfl_xor(ss, 8);
                    float sc = rsqrtf(ss + 1e-6f);
                    if (which == 0) sc *= 0.08838834764831845f;
#pragma unroll
                    for (int e = 0; e < 8; ++e) y[e] *= sc;
                }
                u32x4 o; o.x = pk_bf16(y[0], y[1]); o.y = pk_bf16(y[2], y[3]); o.z = pk_bf16(y[4], y[5]); o.w = pk_bf16(y[6], y[7]);
                *(u32x4*)(gq + (size_t)(t0 + tk) * 1536 + c) = o;
            }
        }
        {
            const int t = rb * RB + (tid >> 2), hh = tid & 3;
            const float a = ab[(size_t)t * 8 + hh], bl = ab[(size_t)t * 8 + 4 + hh];
            gb[(size_t)t * 8 + hh] = -__expf(P.gdn_a_log[l * 4 + hh]) * softplusf_(a + P.gdn_dt_bias[l * 4 + hh]);
            gb[(size_t)t * 8 + 4 + hh] = sigmoidf_(bl);
        }
    }
}

DI void sc_conv(const Params& P, int l, int vb, int nvb) {
    const bf16_t* proj = (const bf16_t*)(P.ws + OFF_U);
    bf16_t* mixed = (bf16_t*)(P.ws + OFF_XB);
    const float* w = P.sc_conv_w + (size_t)l * 3 * 256;
    const int tids = tid_();
    for (size_t it = (size_t)vb * NTHREADS + tids; it < (size_t)NTOK * 128; it += (size_t)nvb * NTHREADS) {
        const int t = (int)(it >> 7), c = (int)(it & 127) * 2;
        const int s = t & (SEQ - 1);
        float y0 = 0.f, y1 = 0.f;
#pragma unroll
        for (int i = 0; i < 3; ++i) {
            if (s - 2 + i >= 0) {
                const bf16_t* pr = proj + (size_t)(t - 2 + i) * PJ;
                const unsigned cu = *(const unsigned*)(pr + 3072 + c), hu = *(const unsigned*)(pr + 3328 + c);
                y0 += w[i * 256 + c] * (bf_lo(cu) * bf_lo(hu));
                y1 += w[i * 256 + c + 1] * (bf_hi(cu) * bf_hi(hu));
            }
        }
        const unsigned bu = *(const unsigned*)(proj + (size_t)t * PJ + 2816 + c);
        *(unsigned*)(mixed + (size_t)t * D + 768 + c) = pk_bf16(bf_lo(bu) * y0, bf_hi(bu) * y1);
    }
}

DI bf16x8 scale_frag(bf16x8 f, float s) {
    const u32x4 u = __builtin_bit_cast(u32x4, f);
    u32x4 o;
#pragma unroll
    for (int e = 0; e < 4; ++e) o[e] = pk_bf16(bf_lo(u[e]) * s, bf_hi(u[e]) * s);
    return __builtin_bit_cast(bf16x8, o);
}
typedef float f32x16 __attribute__((ext_vector_type(16)));
DI void sb_mfma(const Params& P, int vw, int nvw) {
    const bf16_t* proj = (const bf16_t*)(P.ws + OFF_U);
    bf16_t* mixed = (bf16_t*)(P.ws + OFF_XB);
    for (int it = vw; it < 4096; it += nvw) {
        const int lane = tid_() & 63, c32 = lane & 31, h2 = lane >> 5;
        const int qt = it & 255, h = (it >> 8) & 3, b = it >> 10;
        const size_t Tb = (size_t)b * SEQ, T0 = Tb + 32 * qt;
        bf16x8 qf[4];
#pragma unroll
        for (int ks = 0; ks < 4; ++ks) qf[ks] = scale_frag(*(const bf16x8*)(proj + (T0 + c32) * PJ + h * 64 + 16 * ks + 8 * h2), 0.125f);
        f32x16 O0, O1;
#pragma unroll
        for (int i = 0; i < 16; ++i) { O0[i] = 0.f; O1[i] = 0.f; }
        float carry = 0.f;
        for (int kt = qt; kt >= 0; --kt) {
            const bf16_t* kb = proj + (Tb + 32 * kt + c32) * PJ + 256 + h * 64 + 8 * h2;
            f32x16 S;
#pragma unroll
            for (int i = 0; i < 16; ++i) S[i] = 0.f;
#pragma unroll
            for (int ks = 0; ks < 4; ++ks) S = __builtin_amdgcn_mfma_f32_32x32x16_bf16(*(const bf16x8*)(kb + 16 * ks), qf[ks], S, 0, 0, 0);
            const bf16_t* vb = proj + (Tb + 32 * kt + 4 * h2) * PJ + 512 + h * 64 + c32;
            bf16x8 vf[2][2];
#pragma unroll
            for (int s2 = 0; s2 < 2; ++s2)
#pragma unroll
                for (int nt = 0; nt < 2; ++nt)
#pragma unroll
                    for (int j = 0; j < 8; ++j) vf[s2][nt][j] = (short)vb[(size_t)(16 * s2 + 8 * (j >> 2) + (j & 3)) * PJ + 32 * nt];
            const bool diag = (kt == qt);
            float ls[16], lb[16];
#pragma unroll
            for (int i = 0; i < 16; ++i) {
                const float z = S[i];
                const float sp = fmaxf(z, 0.f) + __logf(1.0f + __expf(-fabsf(z)));
                const int sl = 8 * (i >> 2) + 4 * h2 + (i & 3);
                const bool valid = !diag || (sl < c32);
                lb[i] = valid ? (z - sp) : -1e30f;
                ls[i] = valid ? -sp : 0.f;
            }
            float qs[4], pq[4], ps[4];
#pragma unroll
            for (int g = 0; g < 4; ++g) { qs[g] = (ls[4 * g] + ls[4 * g + 1]) + (ls[4 * g + 2] + ls[4 * g + 3]); pq[g] = __shfl_xor(qs[g], 32); ps[g] = qs[g] + pq[g]; }
            float R[4];
            R[3] = 0.f; R[2] = ps[3]; R[1] = R[2] + ps[2]; R[0] = R[1] + ps[1];
            float att[16];
#pragma unroll
            for (int g = 0; g < 4; ++g) {
                const float suf = carry + R[g] + ((h2 == 0) ? pq[g] : 0.f);
                const float l3 = suf, l2 = l3 + ls[4 * g + 3], l1 = l2 + ls[4 * g + 2], l0 = l1 + ls[4 * g + 1];
                att[4 * g + 3] = __expf(lb[4 * g + 3] + l3);
                att[4 * g + 2] = __expf(lb[4 * g + 2] + l2);
                att[4 * g + 1] = __expf(lb[4 * g + 1] + l1);
                att[4 * g + 0] = __expf(lb[4 * g + 0] + l0);
            }
            carry += R[0] + ps[0];
            bf16x8 af[2];
#pragma unroll
            for (int s2 = 0; s2 < 2; ++s2) {
                u32x4 u;
                u.x = pk_bf16(att[8 * s2 + 0], att[8 * s2 + 1]); u.y = pk_bf16(att[8 * s2 + 2], att[8 * s2 + 3]);
                u.z = pk_bf16(att[8 * s2 + 4], att[8 * s2 + 5]); u.w = pk_bf16(att[8 * s2 + 6], att[8 * s2 + 7]);
                af[s2] = __builtin_bit_cast(bf16x8, u);
            }
#pragma unroll
            for (int s2 = 0; s2 < 2; ++s2) {
                O0 = __builtin_amdgcn_mfma_f32_32x32x16_bf16(af[s2], vf[s2][0], O0, 0, 0, 0);
                O1 = __builtin_amdgcn_mfma_f32_32x32x16_bf16(af[s2], vf[s2][1], O1, 0, 0, 0);
            }
            if (__all(carry < -104.f)) break;
        }
        bf16_t* op = mixed + (T0 + 4 * h2) * D + h * 64 + c32;
#pragma unroll
        for (int i = 0; i < 16; ++i) {
            const int tl = (i & 3) + 8 * (i >> 2);
            op[(size_t)tl * D] = (bf16_t)(pk_bf16(O0[i], 0.f) & 0xffffu);
            op[(size_t)tl * D + 32] = (bf16_t)(pk_bf16(O1[i], 0.f) & 0xffffu);
        }
    }
}

DI void wsync() { asm volatile("s_waitcnt lgkmcnt(0)" ::: "memory"); }
DI void store_T_row(bf16_t* XT, const bf16x8 (&f)[4], float sc, int m, int r16, int q4) {
#pragma unroll
    for (int kk = 0; kk < 4; ++kk) {
        const u32x4 u = __builtin_bit_cast(u32x4, f[kk]);
#pragma unroll
        for (int e = 0; e < 4; ++e) {
            const unsigned w = pk_bf16(bf_lo(u[e]) * sc, bf_hi(u[e]) * sc);
            const int c = 32 * kk + 8 * q4 + 2 * e;
            XT[c * 72 + 16 * m + r16] = (bf16_t)(w & 0xffffu);
            XT[(c + 1) * 72 + 16 * m + r16] = (bf16_t)(w >> 16);
        }
    }
}

DI void phase_gdn_chunk(const Params& P, unsigned char* smem) {
    const int tid0 = tid_(), wid = tid0 >> 6;
    unsigned char* wl = smem + wid * CHUNK_WAVE_LDS;
    float* X = (float*)wl;
    bf16_t* XT = (bf16_t*)wl;
    float* gcs = (float*)(wl + 18432);
    float* bts = gcs + 64;
    bf16_t* gq = (bf16_t*)(P.ws + OFF_GQ);
    bf16_t* proj = (bf16_t*)(P.ws + OFF_U);
    const float* gb = (const float*)(P.ws + OFF_GB);
    float* glw = (float*)(P.ws + OFF_GL);
    for (int it = blockIdx.x * 8 + wid; it < 2048; it += gridDim.x * 8) {
        const int lane = tid_() & 63, r16 = lane & 15, q4 = lane >> 4;
        const int h = it & 3, c = (it >> 2) & 127, b = it >> 9;
        const size_t t0 = (size_t)b * SEQ + (size_t)c * 64;
        float gc = gb[(t0 + lane) * 8 + h];
        const float bt = gb[(t0 + lane) * 8 + 4 + h];
#pragma unroll
        for (int o = 1; o < 64; o <<= 1) { const float v = __shfl_up(gc, o); if (lane >= o) gc += v; }
        gcs[lane] = gc; bts[lane] = bt;
        const float gtot = __shfl(gc, 63);
        if (lane == 0) glw[it] = __expf(gtot);
        wsync();
        bf16x8 kf[4][4];
        {
            const bf16_t* kb = gq + t0 * 1536 + 512 + h * 128 + (size_t)r16 * 1536 + 8 * q4;
#pragma unroll
            for (int m = 0; m < 4; ++m)
#pragma unroll
                for (int kk = 0; kk < 4; ++kk) kf[m][kk] = *(const bf16x8*)(kb + (size_t)m * 16 * 1536 + 32 * kk);
        }
#pragma unroll
        for (int mi = 0; mi < 4; ++mi)
#pragma unroll
            for (int mj = 0; mj <= mi; ++mj) {
                f32x4 a = {0.f, 0.f, 0.f, 0.f};
#pragma unroll
                for (int kk = 0; kk < 4; ++kk) a = __builtin_amdgcn_mfma_f32_16x16x32_bf16(kf[mi][kk], kf[mj][kk], a, 0, 0, 0);
                const int j = 16 * mj + r16;
                const float gj = gcs[j];
                const f32x4 gi = *(const f32x4*)(gcs + 16 * mi + 4 * q4);
                const f32x4 bi = *(const f32x4*)(bts + 16 * mi + 4 * q4);
#pragma unroll
                for (int r = 0; r < 4; ++r) {
                    const int i = 16 * mi + 4 * q4 + r;
                    X[i * 68 + j] = (i > j) ? bi[r] * a[r] * __expf(fminf(gi[r] - gj, 0.f)) : 0.f;
                }
            }
        {
            bf16_t* qb = gq + t0 * 1536 + h * 128 + (size_t)r16 * 1536 + 8 * q4;
#pragma unroll
            for (int mi = 0; mi < 4; ++mi) {
                bf16x8 qf[4];
#pragma unroll
                for (int kk = 0; kk < 4; ++kk) qf[kk] = *(const bf16x8*)(qb + (size_t)mi * 16 * 1536 + 32 * kk);
                const int i = 16 * mi + r16;
                const float gi = gcs[i];
                bf16_t* qkrow = proj + (t0 + i) * PJ + 1792 + h * 128 + 4 * q4;
#pragma unroll
                for (int mj = 0; mj < 4; ++mj) {
                    u32x2 w = {0u, 0u};
                    if (mj <= mi) {
                        f32x4 a = {0.f, 0.f, 0.f, 0.f};
#pragma unroll
                        for (int kk = 0; kk < 4; ++kk) a = __builtin_amdgcn_mfma_f32_16x16x32_bf16(kf[mj][kk], qf[kk], a, 0, 0, 0);
                        const f32x4 gj = *(const f32x4*)(gcs + 16 * mj + 4 * q4);
                        f32x4 v;
#pragma unroll
                        for (int r = 0; r < 4; ++r) { const int j = 16 * mj + 4 * q4 + r; v[r] = (j <= i) ? a[r] * __expf(fminf(gi - gj[r], 0.f)) : 0.f; }
                        w = pack4(v);
                    }
                    *(u32x2*)(qkrow + 16 * mj) = w;
                }
                const float s = __expf(gi);
#pragma unroll
                for (int kk = 0; kk < 4; ++kk) *(bf16x8*)(qb + (size_t)mi * 16 * 1536 + 32 * kk) = scale_frag(qf[kk], s);
            }
        }
        wsync();
        {
            float Tc[64];
#pragma unroll
            for (int i = 0; i < 64; ++i) Tc[i] = 0.f;
            Tc[0] = (lane == 0) ? 1.f : 0.f;
#pragma unroll
            for (int i = 1; i < 64; ++i) {
                float a0 = 0.f, a1 = 0.f, a2 = 0.f, a3 = 0.f;
#pragma unroll
                for (int jj = 0; jj < (i + 3) / 4; ++jj) {
                    const f32x4 m4 = *(const f32x4*)(X + i * 68 + 4 * jj);
                    a0 += m4[0] * Tc[4 * jj]; a1 += m4[1] * Tc[4 * jj + 1]; a2 += m4[2] * Tc[4 * jj + 2]; a3 += m4[3] * Tc[4 * jj + 3];
                }
                Tc[i] = ((lane == i) ? 1.f : 0.f) - ((a0 + a1) + (a2 + a3));
            }
            wsync();
#pragma unroll
            for (int i = 0; i < 64; ++i) X[i * 68 + lane] = Tc[i];
            wsync();
        }
        {
            const bf16_t* kb = gq + t0 * 1536 + 512 + h * 128 + (size_t)r16 * 1536 + 8 * q4;
#pragma unroll
            for (int m = 0; m < 4; ++m)
#pragma unroll
                for (int kk = 0; kk < 4; ++kk) kf[m][kk] = *(const bf16x8*)(kb + (size_t)m * 16 * 1536 + 32 * kk);
        }
        bf16x8 Tf[4][2];
#pragma unroll
        for (int mi = 0; mi < 4; ++mi)
#pragma unroll
            for (int ks = 0; ks < 2; ++ks) {
                const float* xp = X + (16 * mi + r16) * 68 + 32 * ks + 8 * q4;
                const f32x4 a = *(const f32x4*)xp, bb = *(const f32x4*)(xp + 4);
                u32x4 u; u.x = pk_bf16(a[0], a[1]); u.y = pk_bf16(a[2], a[3]); u.z = pk_bf16(bb[0], bb[1]); u.w = pk_bf16(bb[2], bb[3]);
                Tf[mi][ks] = __builtin_bit_cast(bf16x8, u);
            }
        float sk[4];
#pragma unroll
        for (int m = 0; m < 4; ++m) sk[m] = bts[16 * m + r16] * __expf(gcs[16 * m + r16]);
        wsync();
#pragma unroll
        for (int m = 0; m < 4; ++m) store_T_row(XT, kf[m], sk[m], m, r16, q4);
        wsync();
#pragma unroll
        for (int md = 0; md < 8; ++md) {
            bf16x8 af[2];
#pragma unroll
            for (int ks = 0; ks < 2; ++ks) af[ks] = *(const bf16x8*)(XT + (16 * md + r16) * 72 + 32 * ks + 8 * q4);
#pragma unroll
            for (int mi = 0; mi < 4; ++mi) {
                f32x4 a = {0.f, 0.f, 0.f, 0.f};
#pragma unroll
                for (int ks = 0; ks < 2; ++ks) a = __builtin_amdgcn_mfma_f32_16x16x32_bf16(af[ks], Tf[mi][ks], a, 0, 0, 0);
                *(u32x2*)(proj + (t0 + 16 * mi + r16) * PJ + 768 + h * 128 + 16 * md + 4 * q4) = pack4(a);
            }
        }
        wsync();
#pragma unroll
        for (int m = 0; m < 4; ++m) sk[m] = __expf(gtot - gcs[16 * m + r16]);
#pragma unroll
        for (int m = 0; m < 4; ++m) store_T_row(XT, kf[m], sk[m], m, r16, q4);
        wsync();
#pragma unroll
        for (int e = 0; e < 16; ++e) {
            const int q = lane + 64 * e, d = q >> 3, jc = (q & 7) * 8;
            const u32x4 v = *(const u32x4*)(XT + d * 72 + jc);
            *(u32x4*)(proj + (t0 + (d >> 1)) * PJ + 1280 + h * 128 + (d & 1) * 64 + jc) = v;
        }
        wsync();
        {
            const bf16_t* vb = gq + t0 * 1536 + 1024 + h * 128 + (size_t)r16 * 1536 + 8 * q4;
#pragma unroll
            for (int m = 0; m < 4; ++m) {
                bf16x8 vf[4];
#pragma unroll
                for (int kk = 0; kk < 4; ++kk) vf[kk] = *(const bf16x8*)(vb + (size_t)m * 16 * 1536 + 32 * kk);
                store_T_row(XT, vf, bts[16 * m + r16], m, r16, q4);
            }
        }
        wsync();
#pragma unroll
        for (int nt = 0; nt < 8; ++nt) {
            bf16x8 bfv[2];
#pragma unroll
            for (int ks = 0; ks < 2; ++ks) bfv[ks] = *(const bf16x8*)(XT + (16 * nt + r16) * 72 + 32 * ks + 8 * q4);
            const int n = 16 * nt + r16;
#pragma unroll
            for (int mi = 0; mi < 4; ++mi) {
                f32x4 a = {0.f, 0.f, 0.f, 0.f};
#pragma unroll
                for (int ks = 0; ks < 2; ++ks) a = __builtin_amdgcn_mfma_f32_16x16x32_bf16(Tf[mi][ks], bfv[ks], a, 0, 0, 0);
                *(u32x2*)(gq + (t0 + (n >> 1)) * 1536 + 1024 + h * 128 + (n & 1) * 64 + 16 * mi + 4 * q4) = pack4(a);
            }
        }
        wsync();
    }
}

constexpr int SC_W = 0, SC_QD = 16384, SC_QK = 32768, SC_KD = 40960, SC_UT = 57344, SC_STAGE = 61440;
constexpr int SC_ST = 2 * SC_STAGE, SC_VT = SC_ST + 32 * 136 * 2, SC_GL = SC_VT + 32 * 72 * 2;
DI void gdn_scan(const Params& P, int item, unsigned char* smem) {
    const int tid = tid_(), lane = tid & 63, wid = tid >> 6, r16 = lane & 15, q4 = lane >> 4;
    const int ns = (item >> 3) & 3, bh = ((item & 7) << 1) | (item >> 5), h = bh & 3, b = bh >> 2;
    const int mi = wid & 3, nt = wid >> 2, md = wid;
    bf16_t* ST = (bf16_t*)(smem + SC_ST);
    bf16_t* VT = (bf16_t*)(smem + SC_VT);
    float* gls = (float*)(smem + SC_GL);
    const bf16_t* proj = (const bf16_t*)(P.ws + OFF_U);
    const bf16_t* gq = (const bf16_t*)(P.ws + OFF_GQ);
    const float* glw = (const float*)(P.ws + OFF_GL);
    bf16_t* mixed = (bf16_t*)(P.ws + OFF_XB);
    for (int i = tid; i < 32 * 136 / 2; i += NTHREADS) ((unsigned*)ST)[i] = 0u;
    if (tid < 128) gls[tid] = glw[((b * 128 + tid) << 2) + h];
    const size_t tb = (size_t)b * SEQ;
    const int r4 = tid >> 4, k16 = (tid & 15) ^ (r4 & 15), k8 = (tid & 7) ^ (r4 & 7);
    const bf16_t* pw = proj + (tb + r4) * PJ + 768 + h * 128 + k16 * 8;
    const bf16_t* pq = gq + (tb + r4) * 1536 + h * 128 + k16 * 8;
    const bf16_t* pk = proj + (tb + (tid >> 3)) * PJ + 1792 + h * 128 + k8 * 8;
    const bf16_t* pd = proj + (tb + r4) * PJ + 1280 + h * 128 + ((tid >> 3) & 1) * 64 + k8 * 8;
    const int nu = ns * 32 + ((tid >> 3) & 31);
    const bf16_t* pu = gq + (tb + (nu >> 1)) * 1536 + 1024 + h * 128 + (nu & 1) * 64 + (tid & 7) * 8;
    const unsigned lbase = (unsigned)(size_t)smem + (unsigned)__builtin_amdgcn_readfirstlane(wid) * 1024u;
    const bool uwave = (__builtin_amdgcn_readfirstlane(wid) < 4);
#define SC_ISSUE(c_) do { const unsigned dst_ = lbase + (unsigned)((c_) & 1) * SC_STAGE; const size_t o1_ = (size_t)(c_) * 64 * PJ, o2_ = (size_t)(c_) * 64 * 1536; \
        glds16(pw + o1_, dst_ + SC_W); glds16(pw + o1_ + (size_t)32 * PJ, dst_ + SC_W + 8192u); \
        glds16(pq + o2_, dst_ + SC_QD); glds16(pq + o2_ + (size_t)32 * 1536, dst_ + SC_QD + 8192u); \
        glds16(pk + o1_, dst_ + SC_QK); \
        glds16(pd + o1_, dst_ + SC_KD); glds16(pd + o1_ + (size_t)32 * PJ, dst_ + SC_KD + 8192u); \
        if (uwave) glds16(pu + o2_, dst_ + SC_UT); } while (0)
    const int ow = (16 * mi + r16) * 256, oqk = SC_QK + (16 * mi + r16) * 128, okd = SC_KD + (16 * md + r16) * 128;
    const int out = SC_UT + (16 * nt + r16) * 128 + (16 * mi + 4 * q4) * 2;
    const int x8 = r16 >> 1;
    f32x4 accS[2] = {{0.f, 0.f, 0.f, 0.f}, {0.f, 0.f, 0.f, 0.f}};
    SC_ISSUE(0);
    asm volatile("s_waitcnt vmcnt(0)" ::: "memory");
    __syncthreads();
    for (int c = 0; c < 128; ++c) {
        if (c + 1 < 128) SC_ISSUE(c + 1);
        const unsigned char* sg = smem + (c & 1) * SC_STAGE;
        f32x4 aP = {0.f, 0.f, 0.f, 0.f}, aO = {0.f, 0.f, 0.f, 0.f};
#pragma unroll
        for (int kk = 0; kk < 4; ++kk) {
            const bf16x8 sf = *(const bf16x8*)(ST + (16 * nt + r16) * 136 + 32 * kk + 8 * q4);
            const int co = (((4 * kk + q4) ^ r16) << 4);
            const bf16x8 wf = *(const bf16x8*)(sg + SC_W + ow + co);
            const bf16x8 qd = *(const bf16x8*)(sg + SC_QD + ow + co);
            aP = __builtin_amdgcn_mfma_f32_16x16x32_bf16(wf, sf, aP, 0, 0, 0);
            aO = __builtin_amdgcn_mfma_f32_16x16x32_bf16(qd, sf, aO, 0, 0, 0);
        }
        {
            const u32x2 uu = *(const u32x2*)(sg + out);
            f32x4 vn;
            vn[0] = bf_lo(uu.x) - aP[0]; vn[1] = bf_hi(uu.x) - aP[1]; vn[2] = bf_lo(uu.y) - aP[2]; vn[3] = bf_hi(uu.y) - aP[3];
            *(u32x2*)(VT + (16 * nt + r16) * 72 + 16 * mi + 4 * q4) = pack4(vn);
        }
        lds_barrier();
#pragma unroll
        for (int ks = 0; ks < 2; ++ks) {
            const bf16x8 vf = *(const bf16x8*)(VT + (16 * nt + r16) * 72 + 32 * ks + 8 * q4);
            const bf16x8 qk = *(const bf16x8*)(sg + oqk + (((4 * ks + q4) ^ x8) << 4));
            aO = __builtin_amdgcn_mfma_f32_16x16x32_bf16(qk, vf, aO, 0, 0, 0);
        }
        {
            bf16_t* op = mixed + (tb + (size_t)c * 64 + 16 * mi + 4 * q4) * D + 256 + h * 128 + ns * 32 + 16 * nt + r16;
#pragma unroll
            for (int r = 0; r < 4; ++r) op[(size_t)r * D] = (bf16_t)(pk_bf16(aO[r], 0.f) & 0xffffu);
        }
        const float gl = gls[c];
        bf16x8 kd[2];
#pragma unroll
        for (int ks = 0; ks < 2; ++ks) kd[ks] = *(const bf16x8*)(sg + okd + (((4 * ks + q4) ^ x8) << 4));
#pragma unroll
        for (int n2 = 0; n2 < 2; ++n2) {
            accS[n2] = accS[n2] * gl;
#pragma unroll
            for (int ks = 0; ks < 2; ++ks) {
                const bf16x8 vf = *(const bf16x8*)(VT + (16 * n2 + r16) * 72 + 32 * ks + 8 * q4);
                accS[n2] = __builtin_amdgcn_mfma_f32_16x16x32_bf16(kd[ks], vf, accS[n2], 0, 0, 0);
            }
            *(u32x2*)(ST + (16 * n2 + r16) * 136 + 16 * md + 4 * q4) = pack4(accS[n2]);
        }
        asm volatile("s_waitcnt vmcnt(0)" ::: "memory");
        lds_barrier();
    }
#undef SC_ISSUE
    __syncthreads();
}

DI void phase_mix(const Params& P, int l, unsigned char* smem) {
    const int G = gridDim.x;
    for (int it = blockIdx.x; it < 64; it += G) {
        gdn_scan(P, it, smem);
#if PROBE_SCAN2
        __syncthreads();
        gdn_scan(P, it, smem);
#endif
    }
    const int nvb = (G > 64) ? (G - 64) : G;
    const int vb = (G > 64) ? ((int)blockIdx.x - 64) : (int)blockIdx.x;
    if (vb >= 0) {
        sb_mfma(P, vb * 8 + (tid_() >> 6), nvb * 8); sc_conv(P, l, vb, nvb);
#if PROBE_SBSC2
        sb_mfma(P, vb * 8 + (tid_() >> 6), nvb * 8); sc_conv(P, l, vb, nvb);
#endif
        if (l == 0 && G > 64) { __syncthreads(); prep_weights(P, smem, 0, vb, nvb, 1); prep_weights(P, smem, 1, vb, nvb, 2); }
    }
}

DI void grid_bar(unsigned* cnt, unsigned& gen) {
    __syncthreads();
    gen += gridDim.x;
    if (threadIdx.x == 0) {
        __builtin_amdgcn_fence(__ATOMIC_RELEASE, "agent");
        __hip_atomic_fetch_add(cnt, 1u, __ATOMIC_RELAXED, __HIP_MEMORY_SCOPE_AGENT);
        while (__hip_atomic_load(cnt, __ATOMIC_RELAXED, __HIP_MEMORY_SCOPE_AGENT) < gen) __builtin_amdgcn_s_sleep(2);
        __builtin_amdgcn_fence(__ATOMIC_ACQUIRE, "agent");
    }
    __syncthreads();
}

constexpr int NPH = 8;
__global__ void __launch_bounds__(NTHREADS) mega(Params PK) {
    extern __shared__ __attribute__((aligned(16))) unsigned char smem[];
    cg::grid_group grid = cg::this_grid();
    unsigned bar_gen = 0u;
    for (int ph = PK.ph_lo; ph < PK.ph_hi; ++ph) {
        const Params& P = PK;
        if (ph == 0) phase_prep(P, smem);
        else if (ph == 1 || ph == 4 || ph == 7) {
            const int lo = (ph == 1) ? 0 : (ph == 4 ? 3 : 11), hi = (ph == 1) ? 3 : (ph == 4 ? 11 : 16);
            for (int rb = blockIdx.x; rb < NRB; rb += gridDim.x) run_jobs(P, rb, lo, hi, smem);
        }
        else if (ph == 2 || ph == 5) {
            phase_gdn_prep(P, ph == 2 ? 0 : 1);
            __syncthreads();
            phase_gdn_chunk(P, smem);
        }
        else phase_mix(P, ph == 3 ? 0 : 1, smem);
        if (ph + 1 < PK.ph_hi) { if (ph == 0) grid.sync(); else grid_bar((unsigned*)(PK.ws + OFF_BAR), bar_gen); }
    }
}

extern "C" void kernel_launch(void* const* d_in, const int* in_sizes, int n_in, void* d_out, int out_size, void* d_ws, size_t ws_size, hipStream_t stream) {
    static int grid_blocks = 0;
    if (grid_blocks == 0) {
        if (n_in != 16 || out_size != NTOK * D || ws_size < WS_END) {
            fprintf(stderr, "kernel_launch: unexpected shapes / workspace (n_in %d out %d ws %zu need %zu)\n", n_in, out_size, ws_size, (size_t)WS_END);
            grid_blocks = -1; return;
        }
        int dev = 0, cus = 0, per_cu = 0;
        hipGetDevice(&dev);
        hipDeviceGetAttribute(&cus, hipDeviceAttributeMultiprocessorCount, dev);
        if (hipFuncSetAttribute((const void*)mega, hipFuncAttributeMaxDynamicSharedMemorySize, SMEM_BYTES) != hipSuccess) { fprintf(stderr, "hipFuncSetAttribute failed\n"); grid_blocks = -1; return; }
        hipOccupancyMaxActiveBlocksPerMultiprocessor(&per_cu, (const void*)mega, NTHREADS, SMEM_BYTES);
        if (per_cu < 1) per_cu = 1;
        grid_blocks = cus * per_cu;
        if (grid_blocks > NRB) grid_blocks = NRB;
    }
    if (grid_blocks < 0) return;
    Params P{};
    P.x = (const float*)d_in[0]; P.p = (const float*)d_in[1]; P.ln_g = (const float*)d_in[2]; P.ln_b = (const float*)d_in[3];
    P.ffn_w_in = (const float*)d_in[4]; P.ffn_w_out = (const float*)d_in[5]; P.mix_w_in = (const float*)d_in[6]; P.gdn_conv_w = (const float*)d_in[7];
    P.gdn_a_log = (const float*)d_in[8]; P.gdn_dt_bias = (const float*)d_in[9]; P.gdn_norm_w = (const float*)d_in[10]; P.sc_conv_w = (const float*)d_in[11];
    P.mix_w_out = (const float*)d_in[12]; P.ple_w_proj = (const float*)d_in[13]; P.ple_w_gate = (const float*)d_in[14]; P.ple_b_gate = (const float*)d_in[15];
    P.out = (float*)d_out; P.ws = (unsigned char*)d_ws;
#if N_LAUNCH_MODE == 1
    P.ph_lo = 0; P.ph_hi = NPH;
    void* args[] = {&P};
    hipError_t e = hipLaunchCooperativeKernel((const void*)mega, dim3(grid_blocks), dim3(NTHREADS), args, SMEM_BYTES, stream);
    if (e != hipSuccess) fprintf(stderr, "cooperative launch failed: %s (grid %d)\n", hipGetErrorString(e), grid_blocks);
#else
    for (int ph = 0; ph < NPH; ++ph) {
        P.ph_lo = ph; P.ph_hi = ph + 1;
        void* args[] = {&P};
        hipError_t e = hipLaunchCooperativeKernel((const void*)mega, dim3(grid_blocks), dim3(NTHREADS), args, SMEM_BYTES, stream);
        if (e != hipSuccess) fprintf(stderr, "launch failed: %s (grid %d)\n", hipGetErrorString(e), grid_blocks);
    }
#endif
}
```

```cpp
#include <hip/hip_runtime.h>
#include <hip/hip_cooperative_groups.h>
#include <cstdio>
#include <cstdint>
namespace cg = cooperative_groups;

#define DI __device__ __forceinline__
typedef unsigned short bf16_t;
typedef short bf16x8 __attribute__((ext_vector_type(8)));
typedef float f32x4 __attribute__((ext_vector_type(4)));
typedef unsigned u32x4 __attribute__((ext_vector_type(4)));
typedef unsigned u32x2 __attribute__((ext_vector_type(2)));
typedef __bf16 bf2_t __attribute__((ext_vector_type(2)));
typedef float f2_t __attribute__((ext_vector_type(2)));

#ifndef PROBE_GEMM2
#define PROBE_GEMM2 0
#endif
#ifndef PROBE_MIX2
#define PROBE_MIX2 0
#endif
#ifndef PROBE_PREP2
#define PROBE_PREP2 0
#endif
#ifndef PROBE_GPREP2
#define PROBE_GPREP2 0
#endif
#ifndef PROBE_SCAN2
#define PROBE_SCAN2 0
#endif
#ifndef PROBE_SBSC2
#define PROBE_SBSC2 0
#endif
#ifndef PROBE_TILES2
#define PROBE_TILES2 0
#endif
#ifndef N_LAUNCH_MODE
#define N_LAUNCH_MODE 1
#endif

constexpr int D = 1024, BATCH = 4, SEQ = 8192, NTOK = BATCH * SEQ, DEPTH = 2;
constexpr int DFF = 2816, PLE = 256;
constexpr int PJ = 3584;
constexpr int PJN = 3840;
constexpr int RB = 128;
constexpr int NRB = NTOK / RB;
constexpr float ALPHA = 1.41421356237f;
constexpr int NTHREADS = 512;

constexpr size_t SZ_W1 = (size_t)2 * DFF * D * 2;
constexpr size_t SZ_W2 = (size_t)D * DFF * 2;
constexpr size_t SZ_WIN = (size_t)PJN * D * 2;
constexpr size_t SZ_WSQ = (size_t)D * D * 2;
constexpr size_t SZ_WP = (size_t)D * PLE * 2;
constexpr size_t OFF_W1 = 0;
constexpr size_t OFF_W2 = OFF_W1 + 4 * SZ_W1;
constexpr size_t OFF_WIN = OFF_W2 + 4 * SZ_W2;
constexpr size_t OFF_WOUT = OFF_WIN + 2 * SZ_WIN;
constexpr size_t OFF_WG = OFF_WOUT + 2 * SZ_WSQ;
constexpr size_t OFF_WP = OFF_WG + 2 * SZ_WSQ;
constexpr size_t OFF_XB = OFF_WP + 2 * SZ_WP;
constexpr size_t OFF_U = OFF_XB + (size_t)NTOK * D * 2;
constexpr size_t OFF_GQ = OFF_U + (size_t)NTOK * PJ * 2;
constexpr size_t OFF_AB = OFF_GQ + (size_t)NTOK * 1536 * 2;
constexpr size_t OFF_GB = OFF_AB + (size_t)NTOK * 8 * 4;
constexpr size_t OFF_GL = OFF_GB + (size_t)NTOK * 8 * 4;
constexpr size_t OFF_BAR = OFF_GL + 2048 * 4;
constexpr size_t OFF_HALO = OFF_BAR + 128;
constexpr size_t OFF_ST = OFF_HALO + (size_t)NRB * 3 * 1536 * 2;
constexpr size_t WS_END = OFF_ST + (size_t)NTOK * 2 * 4;

struct Params {
    const float *x, *p, *ln_g, *ln_b, *ffn_w_in, *ffn_w_out, *mix_w_in, *gdn_conv_w, *gdn_a_log, *gdn_dt_bias, *gdn_norm_w, *sc_conv_w,
        *mix_w_out, *ple_w_proj, *ple_w_gate, *ple_b_gate;
    float* out;
    unsigned char* ws;
    int ph_lo, ph_hi;
};

DI unsigned pk_bf16(float a, float b) { bf2_t v = __builtin_convertvector((f2_t){a, b}, bf2_t); return __builtin_bit_cast(unsigned, v); }
DI float bf_lo(unsigned u) { return __uint_as_float(u << 16); }
DI float bf_hi(unsigned u) { return __uint_as_float(u & 0xffff0000u); }
DI float bf2f(bf16_t h) { return __uint_as_float(((unsigned)h) << 16); }
DI float sigmoidf_(float x) { return __builtin_amdgcn_rcpf(1.0f + __expf(-x)); }
DI float softplusf_(float x) { return fmaxf(x, 0.f) + log1pf(__expf(-fabsf(x))); }
DI u32x2 pack4(const f32x4 a) { u32x2 w; w.x = pk_bf16(a[0], a[1]); w.y = pk_bf16(a[2], a[3]); return w; }
DI float wave_sum(float v) {
#pragma unroll
    for (int o = 32; o >= 1; o >>= 1) v += __shfl_xor(v, o);
    return v;
}

DI int tid_() { int t = threadIdx.x; asm volatile("" : "+v"(t)); return t; }
DI void glds16(const void* gsrc, unsigned lds_dst) {
    unsigned keep;
    asm volatile("s_mov_b32 %0, m0\n\ts_mov_b32 m0, %2\n\ts_nop 0\n\tglobal_load_lds_dwordx4 %1, off\n\ts_mov_b32 m0, %0" : "=&s"(keep) : "v"(gsrc), "s"(lds_dst) : "memory");
}
DI void glds16x6(const void* sa, const void* sb, unsigned va0, unsigned va1, unsigned vb0, unsigned vb1, unsigned vb2, unsigned vb3, unsigned lds_dst) {
    unsigned keep;
    asm volatile("s_mov_b32 %0, m0\n\ts_mov_b32 m0, %9\n\ts_nop 0\n\t"
                 "global_load_lds_dwordx4 %3, %1\n\ts_add_u32 m0, m0, 0x2000\n\ts_nop 0\n\t"
                 "global_load_lds_dwordx4 %4, %1\n\ts_add_u32 m0, m0, 0x2000\n\ts_nop 0\n\t"
                 "global_load_lds_dwordx4 %5, %2\n\ts_add_u32 m0, m0, 0x2000\n\ts_nop 0\n\t"
                 "global_load_lds_dwordx4 %6, %2\n\ts_add_u32 m0, m0, 0x2000\n\ts_nop 0\n\t"
                 "global_load_lds_dwordx4 %7, %2\n\ts_add_u32 m0, m0, 0x2000\n\ts_nop 0\n\t"
                 "global_load_lds_dwordx4 %8, %2\n\ts_mov_b32 m0, %0"
                 : "=&s"(keep) : "s"(sa), "s"(sb), "v"(va0), "v"(va1), "v"(vb0), "v"(vb1), "v"(vb2), "v"(vb3), "s"(lds_dst) : "memory", "scc");
}
DI void glds16x5(const void* sa, const void* sb, unsigned va, unsigned vb0, unsigned vb1, unsigned vb2, unsigned vb3, unsigned lds_dst) {
    unsigned keep;
    asm volatile("s_mov_b32 %0, m0\n\ts_mov_b32 m0, %8\n\ts_nop 0\n\t"
                 "global_load_lds_dwordx4 %3, %1\n\ts_add_u32 m0, m0, 0x2000\n\ts_nop 0\n\t"
                 "global_load_lds_dwordx4 %4, %2\n\ts_add_u32 m0, m0, 0x2000\n\ts_nop 0\n\t"
                 "global_load_lds_dwordx4 %5, %2\n\ts_add_u32 m0, m0, 0x2000\n\ts_nop 0\n\t"
                 "global_load_lds_dwordx4 %6, %2\n\ts_add_u32 m0, m0, 0x2000\n\ts_nop 0\n\t"
                 "global_load_lds_dwordx4 %7, %2\n\ts_mov_b32 m0, %0"
                 : "=&s"(keep) : "s"(sa), "s"(sb), "v"(va), "v"(vb0), "v"(vb1), "v"(vb2), "v"(vb3), "s"(lds_dst) : "memory", "scc");
}
DI void lds_barrier() { asm volatile("s_waitcnt lgkmcnt(0)\n\ts_barrier" ::: "memory"); }
constexpr int LDS_ROW = 144;
constexpr int A_STAGE = 128 * LDS_ROW;
constexpr int B_STAGE = 256 * LDS_ROW;
constexpr int STAGE = A_STAGE + B_STAGE;
constexpr int G3_A = 16384, G3_STAGE = 49152;
constexpr int H5_A = 8192, H5_STAGE = 40960;
constexpr int CHUNK_WAVE_LDS = 18944;
constexpr int SMEM_BYTES = 8 * CHUNK_WAVE_LDS;

DI void gemm_tile(const bf16_t* __restrict__ A, int lda, const bf16_t* __restrict__ Bt, int ldb, int K, unsigned char* smem, f32x4 (&acc)[4][4], bool zero = true) {
    const int tid = tid_(), lane = tid & 63, wid = tid >> 6;
    const int wm = wid >> 2, wn = wid & 3;
#pragma unroll
    for (int i = 0; i < 4; ++i)
#pragma unroll
        for (int j = 0; j < 4; ++j) if (zero) acc[i][j] = (f32x4){0.f, 0.f, 0.f, 0.f};
    const int crow = tid >> 3, ckc = tid & 7;
    const bf16_t* ag = A + (size_t)crow * lda + ckc * 8;
    const bf16_t* bg = Bt + (size_t)crow * ldb + ckc * 8;
    u32x4 ra[2], rb[4];
#pragma unroll
    for (int i = 0; i < 2; ++i) ra[i] = *(const u32x4*)(ag + (size_t)i * 64 * lda);
#pragma unroll
    for (int i = 0; i < 4; ++i) rb[i] = *(const u32x4*)(bg + (size_t)i * 64 * ldb);
    const int soff = crow * LDS_ROW + ckc * 16;
#pragma unroll
    for (int i = 0; i < 2; ++i) *(u32x4*)(smem + soff + i * 64 * LDS_ROW) = ra[i];
#pragma unroll
    for (int i = 0; i < 4; ++i) *(u32x4*)(smem + A_STAGE + soff + i * 64 * LDS_ROW) = rb[i];
    __syncthreads();
    const int nk = K >> 6;
    const int fa = (wm * 64 + (lane & 15)) * LDS_ROW + (lane >> 4) * 16;
    const int fb = A_STAGE + (wn * 64 + (lane & 15)) * LDS_ROW + (lane >> 4) * 16;
    for (int kt = 0; kt < nk; ++kt) {
        const int cur = kt & 1;
        const bool more = (kt + 1 < nk);
        if (more) {
            const int ko = (kt + 1) * 64;
#pragma unroll
            for (int i = 0; i < 2; ++i) ra[i] = *(const u32x4*)(ag + (size_t)i * 64 * lda + ko);
#pragma unroll
            for (int i = 0; i < 4; ++i) rb[i] = *(const u32x4*)(bg + (size_t)i * 64 * ldb + ko);
        }
        const unsigned char* sc = smem + cur * STAGE;
#pragma unroll
        for (int ks = 0; ks < 2; ++ks) {
            bf16x8 af[4], bfr[4];
#pragma unroll
            for (int mt = 0; mt < 4; ++mt) af[mt] = *(const bf16x8*)(sc + fa + mt * 16 * LDS_ROW + ks * 64);
#pragma unroll
            for (int nt = 0; nt < 4; ++nt) bfr[nt] = *(const bf16x8*)(sc + fb + nt * 16 * LDS_ROW + ks * 64);
#pragma unroll
            for (int mt = 0; mt < 4; ++mt)
#pragma unroll
                for (int nt = 0; nt < 4; ++nt) acc[mt][nt] = __builtin_amdgcn_mfma_f32_16x16x32_bf16(bfr[nt], af[mt], acc[mt][nt], 0, 0, 0);
        }
        if (more) {
            unsigned char* sn = smem + (cur ^ 1) * STAGE;
#pragma unroll
            for (int i = 0; i < 2; ++i) *(u32x4*)(sn + soff + i * 64 * LDS_ROW) = ra[i];
#pragma unroll
            for (int i = 0; i < 4; ++i) *(u32x4*)(sn + A_STAGE + soff + i * 64 * LDS_ROW) = rb[i];
        }
        __syncthreads();
    }
}

DI int colmap(int mode, int n) {
    if (mode == 0) return n;
    if (mode == 1) { const int a = (n >> 4) & 7; return (a & 1) * DFF + (n >> 9) * 256 + ((n >> 7) & 3) * 64 + ((n >> 2) & 3) * 16 + (a >> 1) * 4 + (n & 3); }
    if (n < 2816) return n;
    if (n < 3584) return n + 8;
    if (n < 3592) return n - 3584 + 2816;
    return -1;
}
DI void transpose_tile(const float* __restrict__ src, int Nsrc, int K, bf16_t* __restrict__ dst, int mode, int k0, int n0, float* tile  ) {
    const int tid = tid_();
    const int n4 = (tid & 15) * 4;
    const int c = colmap(mode, n0 + n4);
#pragma unroll
    for (int i = 0; i < 2; ++i) {
        const int kk = (tid >> 4) + 32 * i;
        f32x4 v = {0.f, 0.f, 0.f, 0.f};
        if (c >= 0) v = __builtin_nontemporal_load((const f32x4*)(src + (size_t)(k0 + kk) * Nsrc + c));
        tile[kk * 65 + n4] = v[0]; tile[kk * 65 + n4 + 1] = v[1]; tile[kk * 65 + n4 + 2] = v[2]; tile[kk * 65 + n4 + 3] = v[3];
    }
    __syncthreads();
    const int n = tid >> 3, ks = (tid & 7) * 8;
    u32x4 w;
    w.x = pk_bf16(tile[(ks + 0) * 65 + n], tile[(ks + 1) * 65 + n]);
    w.y = pk_bf16(tile[(ks + 2) * 65 + n], tile[(ks + 3) * 65 + n]);
    w.z = pk_bf16(tile[(ks + 4) * 65 + n], tile[(ks + 5) * 65 + n]);
    w.w = pk_bf16(tile[(ks + 6) * 65 + n], tile[(ks + 7) * 65 + n]);
    *(u32x4*)(dst + ((size_t)((n0 >> 8) * (K >> 6) + (k0 >> 6)) * 256 + (n0 & 255) + n) * 64 + ks) = w;
    __syncthreads();
}
DI void prep_weights(const Params& P, unsigned char* smem, int L, int vb, int nvb, int part  ) {
    float* tile = (float*)smem;
    unsigned char* ws = P.ws;
    constexpr int T_W1 = 16 * 88, T_W2 = 44 * 16, T_WIN = 16 * 60, T_SQ = 16 * 16, T_WP = 4 * 16;
    constexpr int E1 = 2 * T_W1, E2 = E1 + 2 * T_W2, E3 = E2 + T_WIN, E4 = E3 + T_SQ, E5 = E4 + T_SQ, E6 = E5 + T_WP;
    for (int idx = vb; idx < E6; idx += nvb) {
        const bool early = (idx < T_W1) || (idx >= E1 && idx < E1 + T_W2) || (idx >= E2 && idx < E3);
        if (part != 2 && early != (part == 0)) continue;
        if (idx < E1) { const int j = L * 2 + idx / T_W1, t = idx % T_W1; const int kt = t / 88, nt = t % 88;
            transpose_tile(P.ffn_w_in + (size_t)j * D * 2 * DFF, 2 * DFF, D, (bf16_t*)(ws + OFF_W1 + j * SZ_W1), 1, kt * 64, nt * 64, tile); }
        else if (idx < E2) { const int q = idx - E1; const int j = L * 2 + q / T_W2, t = q % T_W2; const int kt = t / 16, nt = t % 16;
            transpose_tile(P.ffn_w_out + (size_t)j * DFF * D, D, DFF, (bf16_t*)(ws + OFF_W2 + j * SZ_W2), 0, kt * 64, nt * 64, tile); }
        else if (idx < E3) { const int t = idx - E2; const int kt = t / 60, nt = t % 60;
            transpose_tile(P.mix_w_in + (size_t)L * D * 3592, 3592, D, (bf16_t*)(ws + OFF_WIN + L * SZ_WIN), 2, kt * 64, nt * 64, tile); }
        else if (idx < E4) { const int t = idx - E3; const int kt = t / 16, nt = t % 16;
            transpose_tile(P.mix_w_out + (size_t)L * D * D, D, D, (bf16_t*)(ws + OFF_WOUT + L * SZ_WSQ), 0, kt * 64, nt * 64, tile); }
        else if (idx < E5) { const int t = idx - E4; const int kt = t / 16, nt = t % 16;
            transpose_tile(P.ple_w_gate + (size_t)L * D * D, D, D, (bf16_t*)(ws + OFF_WG + L * SZ_WSQ), 0, kt * 64, nt * 64, tile); }
        else { const int t = idx - E5; const int kt = t / 16, nt = t % 16;
            transpose_tile(P.ple_w_proj + (size_t)L * PLE * D, D, PLE, (bf16_t*)(ws + OFF_WP + L * SZ_WP), 0, kt * 64, nt * 64, tile); }
    }
}
DI void phase_prep(const Params& P, unsigned char* smem) {
    unsigned char* ws = P.ws;
    prep_weights(P, smem, 0, blockIdx.x, gridDim.x, (gridDim.x <= 64) ? 2 : 0);
    if (gridDim.x <= 64) prep_weights(P, smem, 1, blockIdx.x, gridDim.x, 2);
    if (blockIdx.x == 0 && threadIdx.x == 0) *(unsigned*)(ws + OFF_BAR) = 0u;
    bf16_t* xb = (bf16_t*)(ws + OFF_XB);
    const size_t n4 = (size_t)NTOK * D / 4;
    const int tidp = tid_();
    for (size_t i = (size_t)blockIdx.x * NTHREADS + tidp; i < n4; i += (size_t)gridDim.x * NTHREADS) {
        const f32x4 v = *(const f32x4*)(P.x + i * 4);
        u32x2 w; w.x = pk_bf16(v[0], v[1]); w.y = pk_bf16(v[2], v[3]);
        *(u32x2*)(xb + i * 4) = w;
    }
}

DI void ln_rows(float* xr, bf16_t* xbr, const float* __restrict__ g, const float* __restrict__ b, float* stp, bool write_f32) {
    const int tidl = tid_();
    const int lane = tidl & 63, wid = tidl >> 6;
    f32x4 gv[4], bv[4];
#pragma unroll
    for (int i = 0; i < 4; ++i) { gv[i] = *(const f32x4*)(g + i * 256 + lane * 4); bv[i] = *(const f32x4*)(b + i * 256 + lane * 4); }
    for (int r0 = wid * 16; r0 < wid * 16 + 16; r0 += 4) {
        f32x4 v[4][4];
#pragma unroll
        for (int q = 0; q < 4; ++q)
#pragma unroll
            for (int i = 0; i < 4; ++i) v[q][i] = *(const f32x4*)(xr + (size_t)(r0 + q) * D + i * 256 + lane * 4);
        float s[4], qq[4];
#pragma unroll
        for (int q = 0; q < 4; ++q) {
            s[q] = 0.f;
#pragma unroll
            for (int i = 0; i < 4; ++i) s[q] += (v[q][i][0] + v[q][i][1]) + (v[q][i][2] + v[q][i][3]);
        }
#pragma unroll
        for (int o = 32; o >= 1; o >>= 1)
#pragma unroll
            for (int q = 0; q < 4; ++q) s[q] += __shfl_xor(s[q], o);
#pragma unroll
        for (int q = 0; q < 4; ++q) {
            const float mu = s[q] * (1.0f / D);
            qq[q] = 0.f;
#pragma unroll
            for (int i = 0; i < 4; ++i) { v[q][i] = v[q][i] - mu; qq[q] += (v[q][i][0] * v[q][i][0] + v[q][i][1] * v[q][i][1]) + (v[q][i][2] * v[q][i][2] + v[q][i][3] * v[q][i][3]); }
        }
#pragma unroll
        for (int o = 32; o >= 1; o >>= 1)
#pragma unroll
            for (int q = 0; q < 4; ++q) qq[q] += __shfl_xor(qq[q], o);
#pragma unroll
        for (int q = 0; q < 4; ++q) {
            const float rs = rsqrtf(qq[q] * (1.0f / D) + 1e-5f);
            if (lane == 0) { stp[(r0 + q) * 2] = s[q] * (1.0f / D); stp[(r0 + q) * 2 + 1] = rs; }
#pragma unroll
            for (int i = 0; i < 4; ++i) {
                const f32x4 o = v[q][i] * rs * gv[i] + bv[i];
                if (write_f32) __builtin_nontemporal_store(o, (f32x4*)(xr + (size_t)(r0 + q) * D + i * 256 + lane * 4));
                if (!write_f32) {
                    u32x2 w; w.x = pk_bf16(o[0], o[1]); w.y = pk_bf16(o[2], o[3]);
                    *(u32x2*)(xbr + (size_t)(r0 + q) * D + i * 256 + lane * 4) = w;
                }
            }
        }
    }
}

DI void run_jobs(const Params& P, int rb, int jj_lo, int jj_hi, unsigned char* smem) {
    float* xr = P.out + (size_t)rb * RB * D;
    bf16_t* xbr = (bf16_t*)(P.ws + OFF_XB) + (size_t)rb * RB * D;
    bf16_t* ureg = (bf16_t*)(P.ws + OFF_U) + (size_t)rb * RB * PJ;
    float* pps = (float*)ureg;
    bf16_t* pbf = (bf16_t*)((unsigned char*)ureg + (size_t)RB * D * 4);
    float* ab = (float*)(P.ws + OFF_AB) + (size_t)rb * RB * 8;
    for (int jj = jj_lo; jj < jj_hi; ++jj) {
        const int tid = tid_(), lane = tid & 63, wid = tid >> 6, wm = wid >> 2, wn = wid & 3;
        const int l = jj >> 3, j = jj & 7;
        if (j == 3) {
            const int hh = lane >> 4, cl = (lane & 15) * 8;
            const float* nw = P.gdn_norm_w + (size_t)l * 128 + cl;
            const f32x4 nw0 = *(const f32x4*)nw, nw1 = *(const f32x4*)(nw + 4);
            for (int r0 = wid * 16; r0 < wid * 16 + 16; r0 += 4) {
                u32x4 ov[4], zv[4];
#pragma unroll
                for (int q = 0; q < 4; ++q) {
                    ov[q] = *(const u32x4*)(xbr + (size_t)(r0 + q) * D + 256 + hh * 128 + cl);
                    zv[q] = *(const u32x4*)(ureg + (size_t)(r0 + q) * PJ + 2304 + hh * 128 + cl);
                }
#pragma unroll
                for (int q = 0; q < 4; ++q) {
                    float o[8], z[8];
#pragma unroll
                    for (int e = 0; e < 4; ++e) { o[2 * e] = bf_lo(ov[q][e]); o[2 * e + 1] = bf_hi(ov[q][e]); z[2 * e] = bf_lo(zv[q][e]); z[2 * e + 1] = bf_hi(zv[q][e]); }
                    float ss = 0.f;
#pragma unroll
                    for (int e = 0; e < 8; ++e) ss += o[e] * o[e];
                    ss += __shfl_xor(ss, 1); ss += __shfl_xor(ss, 2); ss += __shfl_xor(ss, 4); ss += __shfl_xor(ss, 8);
                    const float rs = rsqrtf(ss * (1.0f / 128.f) + 1e-6f);
                    float y[8];
#pragma unroll
                    for (int e = 0; e < 8; ++e) y[e] = o[e] * rs * ((e < 4) ? nw0[e & 3] : nw1[e & 3]) * (z[e] * sigmoidf_(z[e]));
                    u32x4 w; w.x = pk_bf16(y[0], y[1]); w.y = pk_bf16(y[2], y[3]); w.z = pk_bf16(y[4], y[5]); w.w = pk_bf16(y[6], y[7]);
                    *(u32x4*)(xbr + (size_t)(r0 + q) * D + 256 + hh * 128 + cl) = w;
                }
            }
            __syncthreads();
        }
        if (j == 6) {
            const float* pin = P.p + ((size_t)l * NTOK + (size_t)rb * RB) * PLE;
            for (int i = tid; i < RB * PLE / 4; i += NTHREADS) {
                const f32x4 v = __builtin_nontemporal_load((const f32x4*)(pin + (size_t)i * 4));
                u32x2 w; w.x = pk_bf16(v[0], v[1]); w.y = pk_bf16(v[2], v[3]);
                *(u32x2*)(pbf + (size_t)i * 4) = w;
            }
            __syncthreads();
        }
        const bf16_t* A; const bf16_t* Bt; int lda, K, nt;
        if (j == 0 || j == 4) { A = xbr; lda = D; K = D; nt = 22; Bt = (const bf16_t*)(P.ws + OFF_W1 + (size_t)(l * 2 + (j >> 2)) * SZ_W1); }
        else if (j == 1 || j == 5) { A = ureg; lda = DFF; K = DFF; nt = 4; Bt = (const bf16_t*)(P.ws + OFF_W2 + (size_t)(l * 2 + (j >> 2)) * SZ_W2); }
        else if (j == 2) { A = xbr; lda = D; K = D; nt = 14; Bt = (const bf16_t*)(P.ws + OFF_WIN + (size_t)l * SZ_WIN); }
        else if (j == 3) { A = xbr; lda = D; K = D; nt = 4; Bt = (const bf16_t*)(P.ws + OFF_WOUT + (size_t)l * SZ_WSQ); }
        else if (j == 6) { A = pbf; lda = PLE; K = PLE; nt = 4; Bt = (const bf16_t*)(P.ws + OFF_WP + (size_t)l * SZ_WP); }
        else { A = xbr; lda = D; K = D; nt = 4; Bt = (const bf16_t*)(P.ws + OFF_WG + (size_t)l * SZ_WSQ); }
        const float* resid = (jj == 1) ? (P.x + (size_t)rb * RB * D) : xr;
        const float rsc = (j == 3) ? 1.0f : 0.5f;
        const float* bgate = P.ple_b_gate + (size_t)l * D;
        float* stp = (float*)(P.ws + OFF_ST) + (size_t)rb * RB * 2;
        const bool rec = (j == 1 || j == 3 || j == 5 || j == 7) && (jj != 1);
        const int lsrc = (j == 1) ? (l * 4 - 1) : (l * 4 + ((j - 3) >> 1));
        const float* lng = P.ln_g + (size_t)(rec ? lsrc : 0) * D;
        const float* lnb = P.ln_b + (size_t)(rec ? lsrc : 0) * D;
        {
            const int nk = K >> 5, nk64 = K >> 6, ntw = nt >> 1, S = ntw * nk;
            const int drow = tid >> 2, kcs = (tid & 3) ^ ((4 - ((tid >> 4) & 3)) & 3);
            const unsigned va = (unsigned)((drow * lda + kcs * 8) * 2);
            const unsigned vb0 = (unsigned)((drow * 64 + kcs * 8) * 2), vb1 = vb0 + 16384u;
            const unsigned vb2 = vb0 + (unsigned)nk64 * 32768u, vb3 = vb2 + 16384u;
            const unsigned lbase = (unsigned)(size_t)smem + (unsigned)__builtin_amdgcn_readfirstlane(wid) * 1024u;
            const int r16 = lane & 15, q4 = lane >> 4;
            const int ko = ((q4 ^ ((4 - (r16 >> 2)) & 3)) << 4);
            const int fa = (wm * 64 + r16) * 64 + ko, fb = H5_A + (wn * 128 + r16) * 64 + ko;
            f32x4 acc[4][8];
#pragma unroll
            for (int i = 0; i < 4; ++i)
#pragma unroll
                for (int jq = 0; jq < 8; ++jq) acc[i][jq] = (f32x4){0.f, 0.f, 0.f, 0.f};
            const int toff = (int)((blockIdx.x & 7u) * (unsigned)ntw) >> 3;
            const int koff = (int)((blockIdx.x >> 3) * (unsigned)nk) >> 5;
            int kp = 0, sp = 0, tp = toff;
            const bf16_t* pbt = Bt + (size_t)toff * 512 * K;
#define ISSUE() do { const int ka_ = (kp + koff >= nk) ? kp + koff - nk : kp + koff; \
                glds16x5(A + ka_ * 32, pbt + (size_t)(ka_ >> 1) * 16384 + (ka_ & 1) * 32, va, vb0, vb1, vb2, vb3, lbase + (unsigned)sp * H5_STAGE); \
                ++kp; if (kp == nk) { kp = 0; ++tp; pbt += (size_t)512 * K; if (tp == ntw) { tp = 0; pbt = Bt; } } sp = (sp == 2) ? 0 : sp + 1; } while (0)
            ISSUE();
            ISSUE();
            ISSUE();
            asm volatile("s_waitcnt vmcnt(10)" ::: "memory");
            lds_barrier();
            int kt = 0, t = toff, st = 0;
            for (int s = 0; s < S; ++s) {
                const unsigned char* sc_ = smem + st * H5_STAGE;
                bf16x8 af[4], bfr[8];
#pragma unroll
                for (int mt = 0; mt < 4; ++mt) af[mt] = *(const bf16x8*)(sc_ + fa + mt * 1024);
#pragma unroll
                for (int n_ = 0; n_ < 8; ++n_) bfr[n_] = *(const bf16x8*)(sc_ + fb + n_ * 1024);
                if (kt == 0) {
#pragma unroll
                    for (int i = 0; i < 4; ++i)
#pragma unroll
                        for (int jq = 0; jq < 8; ++jq) acc[i][jq] = (f32x4){0.f, 0.f, 0.f, 0.f};
                }
#pragma unroll
                for (int mt = 0; mt < 4; ++mt)
#pragma unroll
                    for (int n_ = 0; n_ < 8; ++n_) acc[mt][n_] = __builtin_amdgcn_mfma_f32_16x16x32_bf16(bfr[n_], af[mt], acc[mt][n_], 0, 0, 0);
                if (s + 2 < S) asm volatile("s_waitcnt vmcnt(5)" ::: "memory");
                else asm volatile("s_waitcnt vmcnt(0)" ::: "memory");
                lds_barrier();
                if (s + 3 < S) ISSUE();
                st = (st == 2) ? 0 : st + 1;
                ++kt;
                if (kt == nk) {
                    kt = 0;
                    const int row0 = wm * 64 + r16;
                    const int col0 = t * 512 + wn * 128 + q4 * 4;
                    if (j == 0 || j == 4) {
                        bf16_t* hp = ureg + (size_t)row0 * DFF + t * 256 + wn * 64 + q4 * 16;
#pragma unroll
                        for (int mt = 0; mt < 4; ++mt) {
                            float hv[16];
#pragma unroll
                            for (int pr = 0; pr < 4; ++pr)
#pragma unroll
                                for (int r = 0; r < 4; ++r) { const float g = acc[mt][2 * pr][r]; hv[pr * 4 + r] = g * sigmoidf_(g) * acc[mt][2 * pr + 1][r]; }
                            u32x4 w0, w1;
                            w0.x = pk_bf16(hv[0], hv[1]); w0.y = pk_bf16(hv[2], hv[3]); w0.z = pk_bf16(hv[4], hv[5]); w0.w = pk_bf16(hv[6], hv[7]);
                            w1.x = pk_bf16(hv[8], hv[9]); w1.y = pk_bf16(hv[10], hv[11]); w1.z = pk_bf16(hv[12], hv[13]); w1.w = pk_bf16(hv[14], hv[15]);
                            *(u32x4*)(hp + (size_t)mt * 16 * DFF) = w0;
                            *(u32x4*)(hp + (size_t)mt * 16 * DFF + 8) = w1;
                        }
                    } else if (j == 1 || j == 5 || j == 3) {
#pragma unroll
                        for (int mt = 0; mt < 4; ++mt)
#pragma unroll
                            for (int nn = 0; nn < 8; ++nn) {
                                if ((nn & 3) == 0) asm volatile("" ::: "memory");
                                const size_t o = (size_t)(row0 + mt * 16) * D + col0 + nn * 16;
                                f32x4 rv = *(const f32x4*)(resid + o);
                                if (rec) {
                                    const float mu = stp[(row0 + mt * 16) * 2], rs = stp[(row0 + mt * 16) * 2 + 1];
                                    rv = (rv - mu) * rs * *(const f32x4*)(lng + col0 + nn * 16) + *(const f32x4*)(lnb + col0 + nn * 16);
                                }
                                *(f32x4*)(xr + o) = rv * ALPHA + acc[mt][nn] * rsc;
                            }
                    } else if (j == 2) {
#pragma unroll
                        for (int mt = 0; mt < 4; ++mt)
#pragma unroll
                            for (int nn = 0; nn < 8; ++nn) {
                                u32x2 w; w.x = pk_bf16(acc[mt][nn][0], acc[mt][nn][1]); w.y = pk_bf16(acc[mt][nn][2], acc[mt][nn][3]);
                                *(u32x2*)(ureg + (size_t)(row0 + mt * 16) * PJ + col0 + nn * 16) = w;
                            }
                    } else if (j == 6) {
#pragma unroll
                        for (int mt = 0; mt < 4; ++mt)
#pragma unroll
                            for (int nn = 0; nn < 8; ++nn) *(u32x2*)((bf16_t*)pps + (size_t)(row0 + mt * 16) * D + col0 + nn * 16) = pack4(acc[mt][nn]);
                    } else {
#pragma unroll
                        for (int mt = 0; mt < 4; ++mt)
#pragma unroll
                            for (int nn = 0; nn < 8; ++nn) {
                                if ((nn & 1) == 0) asm volatile("" ::: "memory");
                                const size_t o = (size_t)(row0 + mt * 16) * D + col0 + nn * 16;
                                const f32x4 bv = *(const f32x4*)(bgate + col0 + nn * 16);
                                const u32x2 pu = *(const u32x2*)((const bf16_t*)pps + o);
                                const f32x4 pv = {bf_lo(pu.x), bf_hi(pu.x), bf_lo(pu.y), bf_hi(pu.y)};
                                f32x4 xv = *(const f32x4*)(xr + o);
                                {
                                    const float mu = stp[(row0 + mt * 16) * 2], rs = stp[(row0 + mt * 16) * 2 + 1];
                                    xv = (xv - mu) * rs * *(const f32x4*)(lng + col0 + nn * 16) + *(const f32x4*)(lnb + col0 + nn * 16);
                                }
                                f32x4 ov;
#pragma unroll
                                for (int r = 0; r < 4; ++r) ov[r] = xv[r] * ALPHA + sigmoidf_(acc[mt][nn][r] + bv[r]) * pv[r];
                                *(f32x4*)(xr + o) = ov;
                            }
                    }
                    ++t; if (t == ntw) t = 0;
                }
            }
#undef ISSUE
        }
        if (j == 2) {
            const int r16 = lane & 15, q4 = lane >> 4;
            const bf16_t* arow = xbr + (size_t)(wid * 16 + r16) * D + 8 * q4;
            const bf16_t* wrow = Bt + ((size_t)(14 * 16) * 256 + r16) * 64 + 8 * q4;
            f32x4 c = {0.f, 0.f, 0.f, 0.f};
#pragma unroll 8
            for (int kk = 0; kk < 32; ++kk) {
                const bf16x8 af = *(const bf16x8*)(arow + 32 * kk);
                const bf16x8 wf = *(const bf16x8*)(wrow + (size_t)(kk >> 1) * 16384 + (kk & 1) * 32);
                c = __builtin_amdgcn_mfma_f32_16x16x32_bf16(wf, af, c, 0, 0, 0);
            }
            if (q4 < 2) *(f32x4*)(ab + (size_t)(wid * 16 + r16) * 8 + q4 * 4) = c;
            __syncthreads();
            bf16_t* halo = (bf16_t*)(P.ws + OFF_HALO) + (size_t)rb * 3 * 1536;
            for (int i = tid; i < 3 * 192; i += NTHREADS) {
                const int rr = i / 192, cc = (i % 192) * 8;
                *(u32x4*)(halo + rr * 1536 + cc) = *(const u32x4*)(ureg + (size_t)(125 + rr) * PJ + 768 + cc);
            }
        }
        __syncthreads();
        if (j == 1 || j == 3 || j == 5 || j == 7) {
            const int li = l * 4 + ((j - 1) >> 1);
            ln_rows(xr, xbr, P.ln_g + (size_t)li * D, P.ln_b + (size_t)li * D, stp, jj == 15);
            __syncthreads();
        }
    }
}

DI void phase_gdn_prep(const Params& P, int l) {
    const int tid = tid_(), lane = tid & 63, wid = tid >> 6;
    const int h = lane >> 4, cl = (lane & 15) * 8;
    const bf16_t* proj = (const bf16_t*)(P.ws + OFF_U);
    const bf16_t* halo = (const bf16_t*)(P.ws + OFF_HALO);
    bf16_t* gq = (bf16_t*)(P.ws + OFF_GQ);
    const float* cw = P.gdn_conv_w + (size_t)l * 4 * 1536;
    const float* ab = (const float*)(P.ws + OFF_AB);
    float* gb = (float*)(P.ws + OFF_GB);
    for (int rb = blockIdx.x; rb < NRB; rb += gridDim.x) {
        for (int itl = wid; itl < 96; itl += 8) {
            const int which = itl % 3, tgl = itl / 3;
            const int t0 = rb * RB + tgl * 4, s0 = t0 & (SEQ - 1);
            const int c = which * 512 + h * 128 + cl;
            f32x4 w[4][2];
#pragma unroll
            for (int i = 0; i < 4; ++i) { w[i][0] = *(const f32x4*)(cw + i * 1536 + c); w[i][1] = *(const f32x4*)(cw + i * 1536 + c + 4); }
            u32x4 x[7];
#pragma unroll
            for (int rr = 0; rr < 7; ++rr) {
                if (tgl == 0 && rr < 3) {
                    if (s0 > 0) x[rr] = *(const u32x4*)(halo + ((size_t)(rb - 1) * 3 + rr) * 1536 + c);
                    else x[rr] = (u32x4){0u, 0u, 0u, 0u};
                } else x[rr] = *(const u32x4*)(proj + (size_t)(t0 - 3 + rr) * PJ + 768 + c);
            }
#pragma unroll
            for (int tk = 0; tk < 4; ++tk) {
                float y[8];
#pragma unroll
                for (int e = 0; e < 8; ++e) y[e] = 0.f;
#pragma unroll
                for (int i = 0; i < 4; ++i)
#pragma unroll
                    for (int jj = 0; jj < 4; ++jj) {
                        y[2 * jj] += w[i][jj >> 1][(2 * jj) & 3] * bf_lo(x[tk + i][jj]);
                        y[2 * jj + 1] += w[i][jj >> 1][(2 * jj + 1) & 3] * bf_hi(x[tk + i][jj]);
                    }
                float ss = 0.f;
#pragma unroll
                for (int e = 0; e < 8; ++e) { y[e] = y[e] * sigmoidf_(y[e]); ss += y[e] * y[e]; }
                if (which < 2) {
                    ss += __shfl_xor(ss, 1); ss += __shfl_xor(ss, 2); ss += __shfl_xor(ss, 4); ss += __shfl_xor(ss, 8);
                    float sc = rsqrtf(ss + 1e-6f);
                    if (which == 0) sc *= 0.08838834764831845f;
#pragma unroll
                    for (int e = 0; e < 8; ++e) y[e] *= sc;
                }
                u32x4 o; o.x = pk_bf16(y[0], y[1]); o.y = pk_bf16(y[2], y[3]); o.z = pk_bf16(y[4], y[5]); o.w = pk_bf16(y[6], y[7]);
                *(u32x4*)(gq + (size_t)(t0 + tk) * 1536 + c) = o;
            }
        }
        {
            const int t = rb * RB + (tid >> 2), hh = tid & 3;
            const float a = ab[(size_t)t * 8 + hh], bl = ab[(size_t)t * 8 + 4 + hh];
            gb[(size_t)t * 8 + hh] = -__expf(P.gdn_a_log[l * 4 + hh]) * softplusf_(a + P.gdn_dt_bias[l * 4 + hh]);
            gb[(size_t)t * 8 + 4 + hh] = sigmoidf_(bl);
        }
    }
}

DI void sc_conv(const Params& P, int l, int vb, int nvb) {
    const bf16_t* proj = (const bf16_t*)(P.ws + OFF_U);
    bf16_t* mixed = (bf16_t*)(P.ws + OFF_XB);
    const float* w = P.sc_conv_w + (size_t)l * 3 * 256;
    const int tids = tid_();
    for (size_t it = (size_t)vb * NTHREADS + tids; it < (size_t)NTOK * 128; it += (size_t)nvb * NTHREADS) {
        const int t = (int)(it >> 7), c = (int)(it & 127) * 2;
        const int s = t & (SEQ - 1);
        float y0 = 0.f, y1 = 0.f;
#pragma unroll
        for (int i = 0; i < 3; ++i) {
            if (s - 2 + i >= 0) {
                const bf16_t* pr = proj + (size_t)(t - 2 + i) * PJ;
                const unsigned cu = *(const unsigned*)(pr + 3072 + c), hu = *(const unsigned*)(pr + 3328 + c);
                y0 += w[i * 256 + c] * (bf_lo(cu) * bf_lo(hu));
                y1 += w[i * 256 + c + 1] * (bf_hi(cu) * bf_hi(hu));
            }
        }
        const unsigned bu = *(const unsigned*)(proj + (size_t)t * PJ + 2816 + c);
        *(unsigned*)(mixed + (size_t)t * D + 768 + c) = pk_bf16(bf_lo(bu) * y0, bf_hi(bu) * y1);
    }
}

DI bf16x8 scale_frag(bf16x8 f, float s) {
    const u32x4 u = __builtin_bit_cast(u32x4, f);
    u32x4 o;
#pragma unroll
    for (int e = 0; e < 4; ++e) o[e] = pk_bf16(bf_lo(u[e]) * s, bf_hi(u[e]) * s);
    return __builtin_bit_cast(bf16x8, o);
}
typedef float f32x16 __attribute__((ext_vector_type(16)));
DI void sb_mfma(const Params& P, int vw, int nvw) {
    const bf16_t* proj = (const bf16_t*)(P.ws + OFF_U);
    bf16_t* mixed = (bf16_t*)(P.ws + OFF_XB);
    for (int it = vw; it < 4096; it += nvw) {
        const int lane = tid_() & 63, c32 = lane & 31, h2 = lane >> 5;
        const int qt = it & 255, h = (it >> 8) & 3, b = it >> 10;
        const size_t Tb = (size_t)b * SEQ, T0 = Tb + 32 * qt;
        bf16x8 qf[4];
#pragma unroll
        for (int ks = 0; ks < 4; ++ks) qf[ks] = scale_frag(*(const bf16x8*)(proj + (T0 + c32) * PJ + h * 64 + 16 * ks + 8 * h2), 0.125f);
        f32x16 O0, O1;
#pragma unroll
        for (int i = 0; i < 16; ++i) { O0[i] = 0.f; O1[i] = 0.f; }
        float carry = 0.f;
        for (int kt = qt; kt >= 0; --kt) {
            const bf16_t* kb = proj + (Tb + 32 * kt + c32) * PJ + 256 + h * 64 + 8 * h2;
            f32x16 S;
#pragma unroll
            for (int i = 0; i < 16; ++i) S[i] = 0.f;
#pragma unroll
            for (int ks = 0; ks < 4; ++ks) S = __builtin_amdgcn_mfma_f32_32x32x16_bf16(*(const bf16x8*)(kb + 16 * ks), qf[ks], S, 0, 0, 0);
            const bf16_t* vb = proj + (Tb + 32 * kt + 4 * h2) * PJ + 512 + h * 64 + c32;
            bf16x8 vf[2][2];
#pragma unroll
            for (int s2 = 0; s2 < 2; ++s2)
#pragma unroll
                for (int nt = 0; nt < 2; ++nt)
#pragma unroll
                    for (int j = 0; j < 8; ++j) vf[s2][nt][j] = (short)vb[(size_t)(16 * s2 + 8 * (j >> 2) + (j & 3)) * PJ + 32 * nt];
            const bool diag = (kt == qt);
            float ls[16], lb[16];
#pragma unroll
            for (int i = 0; i < 16; ++i) {
                const float z = S[i];
                const float sp = fmaxf(z, 0.f) + __logf(1.0f + __expf(-fabsf(z)));
                const int sl = 8 * (i >> 2) + 4 * h2 + (i & 3);
                const bool valid = !diag || (sl < c32);
                lb[i] = valid ? (z - sp) : -1e30f;
                ls[i] = valid ? -sp : 0.f;
            }
            float qs[4], pq[4], ps[4];
#pragma unroll
            for (int g = 0; g < 4; ++g) { qs[g] = (ls[4 * g] + ls[4 * g + 1]) + (ls[4 * g + 2] + ls[4 * g + 3]); pq[g] = __shfl_xor(qs[g], 32); ps[g] = qs[g] + pq[g]; }
            float R[4];
            R[3] = 0.f; R[2] = ps[3]; R[1] = R[2] + ps[2]; R[0] = R[1] + ps[1];
            float att[16];
#pragma unroll
            for (int g = 0; g < 4; ++g) {
                const float suf = carry + R[g] + ((h2 == 0) ? pq[g] : 0.f);
                const float l3 = suf, l2 = l3 + ls[4 * g + 3], l1 = l2 + ls[4 * g + 2], l0 = l1 + ls[4 * g + 1];
                att[4 * g + 3] = __expf(lb[4 * g + 3] + l3);
                att[4 * g + 2] = __expf(lb[4 * g + 2] + l2);
                att[4 * g + 1] = __expf(lb[4 * g + 1] + l1);
                att[4 * g + 0] = __expf(lb[4 * g + 0] + l0);
            }
            carry += R[0] + ps[0];
            bf16x8 af[2];
#pragma unroll
            for (int s2 = 0; s2 < 2; ++s2) {
                u32x4 u;
                u.x = pk_bf16(att[8 * s2 + 0], att[8 * s2 + 1]); u.y = pk_bf16(att[8 * s2 + 2], att[8 * s2 + 3]);
                u.z = pk_bf16(att[8 * s2 + 4], att[8 * s2 + 5]); u.w = pk_bf16(att[8 * s2 + 6], att[8 * s2 + 7]);
                af[s2] = __builtin_bit_cast(bf16x8, u);
            }
#pragma unroll
            for (int s2 = 0; s2 < 2; ++s2) {
                O0 = __builtin_amdgcn_mfma_f32_32x32x16_bf16(af[s2], vf[s2][0], O0, 0, 0, 0);
                O1 = __builtin_amdgcn_mfma_f32_32x32x16_bf16(af[s2], vf[s2][1], O1, 0, 0, 0);
            }
            if (__all(carry < -104.f)) break;
        }
        bf16_t* op = mixed + (T0 + 4 * h2) * D + h * 64 + c32;
#pragma unroll
        for (int i = 0; i < 16; ++i) {
            const int tl = (i & 3) + 8 * (i >> 2);
            op[(size_t)tl * D] = (bf16_t)(pk_bf16(O0[i], 0.f) & 0xffffu);
            op[(size_t)tl * D + 32] = (bf16_t)(pk_bf16(O1[i], 0.f) & 0xffffu);
        }
    }
}

DI void wsync() { asm volatile("s_waitcnt lgkmcnt(0)" ::: "memory"); }
DI void store_T_row(bf16_t* XT, const bf16x8 (&f)[4], float sc, int m, int r16, int q4) {
#pragma unroll
    for (int kk = 0; kk < 4; ++kk) {
        const u32x4 u = __builtin_bit_cast(u32x4, f[kk]);
#pragma unroll
        for (int e = 0; e < 4; ++e) {
            const unsigned w = pk_bf16(bf_lo(u[e]) * sc, bf_hi(u[e]) * sc);
            const int c = 32 * kk + 8 * q4 + 2 * e;
            XT[c * 72 + 16 * m + r16] = (bf16_t)(w & 0xffffu);
            XT[(c + 1) * 72 + 16 * m + r16] = (bf16_t)(w >> 16);
        }
    }
}

DI void phase_gdn_chunk(const Params& P, unsigned char* smem) {
    const int tid0 = tid_(), wid = tid0 >> 6;
    unsigned char* wl = smem + wid * CHUNK_WAVE_LDS;
    float* X = (float*)wl;
    bf16_t* XT = (bf16_t*)wl;
    float* gcs = (float*)(wl + 18432);
    float* bts = gcs + 64;
    bf16_t* gq = (bf16_t*)(P.ws + OFF_GQ);
    bf16_t* proj = (bf16_t*)(P.ws + OFF_U);
    const float* gb = (const float*)(P.ws + OFF_GB);
    float* glw = (float*)(P.ws + OFF_GL);
    for (int it = blockIdx.x * 8 + wid; it < 2048; it += gridDim.x * 8) {
        const int lane = tid_() & 63, r16 = lane & 15, q4 = lane >> 4;
        const int h = it & 3, c = (it >> 2) & 127, b = it >> 9;
        const size_t t0 = (size_t)b * SEQ + (size_t)c * 64;
        float gc = gb[(t0 + lane) * 8 + h];
        const float bt = gb[(t0 + lane) * 8 + 4 + h];
#pragma unroll
        for (int o = 1; o < 64; o <<= 1) { const float v = __shfl_up(gc, o); if (lane >= o) gc += v; }
        gcs[lane] = gc; bts[lane] = bt;
        const float gtot = __shfl(gc, 63);
        if (lane == 0) glw[it] = __expf(gtot);
        wsync();
        bf16x8 kf[4][4];
        {
            const bf16_t* kb = gq + t0 * 1536 + 512 + h * 128 + (size_t)r16 * 1536 + 8 * q4;
#pragma unroll
            for (int m = 0; m < 4; ++m)
#pragma unroll
                for (int kk = 0; kk < 4; ++kk) kf[m][kk] = *(const bf16x8*)(kb + (size_t)m * 16 * 1536 + 32 * kk);
        }
#pragma unroll
        for (int mi = 0; mi < 4; ++mi)
#pragma unroll
            for (int mj = 0; mj <= mi; ++mj) {
                f32x4 a = {0.f, 0.f, 0.f, 0.f};
#pragma unroll
                for (int kk = 0; kk < 4; ++kk) a = __builtin_amdgcn_mfma_f32_16x16x32_bf16(kf[mi][kk], kf[mj][kk], a, 0, 0, 0);
                const int j = 16 * mj + r16;
                const float gj = gcs[j];
                const f32x4 gi = *(const f32x4*)(gcs + 16 * mi + 4 * q4);
                const f32x4 bi = *(const f32x4*)(bts + 16 * mi + 4 * q4);
#pragma unroll
                for (int r = 0; r < 4; ++r) {
                    const int i = 16 * mi + 4 * q4 + r;
                    X[i * 68 + j] = (i > j) ? bi[r] * a[r] * __expf(fminf(gi[r] - gj, 0.f)) : 0.f;
                }
            }
        {
            bf16_t* qb = gq + t0 * 1536 + h * 128 + (size_t)r16 * 1536 + 8 * q4;
#pragma unroll
            for (int mi = 0; mi < 4; ++mi) {
                bf16x8 qf[4];
#pragma unroll
                for (int kk = 0; kk < 4; ++kk) qf[kk] = *(const bf16x8*)(qb + (size_t)mi * 16 * 1536 + 32 * kk);
                const int i = 16 * mi + r16;
                const float gi = gcs[i];
                bf16_t* qkrow = proj + (t0 + i) * PJ + 1792 + h * 128 + 4 * q4;
#pragma unroll
                for (int mj = 0; mj < 4; ++mj) {
                    u32x2 w = {0u, 0u};
                    if (mj <= mi) {
                        f32x4 a = {0.f, 0.f, 0.f, 0.f};
#pragma unroll
                        for (int kk = 0; kk < 4; ++kk) a = __builtin_amdgcn_mfma_f32_16x16x32_bf16(kf[mj][kk], qf[kk], a, 0, 0, 0);
                        const f32x4 gj = *(const f32x4*)(gcs + 16 * mj + 4 * q4);
                        f32x4 v;
#pragma unroll
                        for (int r = 0; r < 4; ++r) { const int j = 16 * mj + 4 * q4 + r; v[r] = (j <= i) ? a[r] * __expf(fminf(gi - gj[r], 0.f)) : 0.f; }
                        w = pack4(v);
                    }
                    *(u32x2*)(qkrow + 16 * mj) = w;
                }
                const float s = __expf(gi);
#pragma unroll
                for (int kk = 0; kk < 4; ++kk) *(bf16x8*)(qb + (size_t)mi * 16 * 1536 + 32 * kk) = scale_frag(qf[kk], s);
            }
        }
        wsync();
        {
            float Tc[64];
#pragma unroll
            for (int i = 0; i < 64; ++i) Tc[i] = 0.f;
            Tc[0] = (lane == 0) ? 1.f : 0.f;
#pragma unroll
            for (int i = 1; i < 64; ++i) {
                float a0 = 0.f, a1 = 0.f, a2 = 0.f, a3 = 0.f;
#pragma unroll
                for (int jj = 0; jj < (i + 3) / 4; ++jj) {
                    const f32x4 m4 = *(const f32x4*)(X + i * 68 + 4 * jj);
                    a0 += m4[0] * Tc[4 * jj]; a1 += m4[1] * Tc[4 * jj + 1]; a2 += m4[2] * Tc[4 * jj + 2]; a3 += m4[3] * Tc[4 * jj + 3];
                }
                Tc[i] = ((lane == i) ? 1.f : 0.f) - ((a0 + a1) + (a2 + a3));
            }
            wsync();
#pragma unroll
            for (int i = 0; i < 64; ++i) X[i * 68 + lane] = Tc[i];
            wsync();
        }
        {
            const bf16_t* kb = gq + t0 * 1536 + 512 + h * 128 + (size_t)r16 * 1536 + 8 * q4;
#pragma unroll
            for (int m = 0; m < 4; ++m)
#pragma unroll
                for (int kk = 0; kk < 4; ++kk) kf[m][kk] = *(const bf16x8*)(kb + (size_t)m * 16 * 1536 + 32 * kk);
        }
        bf16x8 Tf[4][2];
#pragma unroll
        for (int mi = 0; mi < 4; ++mi)
#pragma unroll
            for (int ks = 0; ks < 2; ++ks) {
                const float* xp = X + (16 * mi + r16) * 68 + 32 * ks + 8 * q4;
                const f32x4 a = *(const f32x4*)xp, bb = *(const f32x4*)(xp + 4);
                u32x4 u; u.x = pk_bf16(a[0], a[1]); u.y = pk_bf16(a[2], a[3]); u.z = pk_bf16(bb[0], bb[1]); u.w = pk_bf16(bb[2], bb[3]);
                Tf[mi][ks] = __builtin_bit_cast(bf16x8, u);
            }
        float sk[4];
#pragma unroll
        for (int m = 0; m < 4; ++m) sk[m] = bts[16 * m + r16] * __expf(gcs[16 * m + r16]);
        wsync();
#pragma unroll
        for (int m = 0; m < 4; ++m) store_T_row(XT, kf[m], sk[m], m, r16, q4);
        wsync();
#pragma unroll
        for (int md = 0; md < 8; ++md) {
            bf16x8 af[2];
#pragma unroll
            for (int ks = 0; ks < 2; ++ks) af[ks] = *(const bf16x8*)(XT + (16 * md + r16) * 72 + 32 * ks + 8 * q4);
#pragma unroll
            for (int mi = 0; mi < 4; ++mi) {
                f32x4 a = {0.f, 0.f, 0.f, 0.f};
#pragma unroll
                for (int ks = 0; ks < 2; ++ks) a = __builtin_amdgcn_mfma_f32_16x16x32_bf16(af[ks], Tf[mi][ks], a, 0, 0, 0);
                *(u32x2*)(proj + (t0 + 16 * mi + r16) * PJ + 768 + h * 128 + 16 * md + 4 * q4) = pack4(a);
            }
        }
        wsync();
#pragma unroll
        for (int m = 0; m < 4; ++m) sk[m] = __expf(gtot - gcs[16 * m + r16]);
#pragma unroll
        for (int m = 0; m < 4; ++m) store_T_row(XT, kf[m], sk[m], m, r16, q4);
        wsync();
#pragma unroll
        for (int e = 0; e < 16; ++e) {
            const int q = lane + 64 * e, d = q >> 3, jc = (q & 7) * 8;
            const u32x4 v = *(const u32x4*)(XT + d * 72 + jc);
            *(u32x4*)(proj + (t0 + (d >> 1)) * PJ + 1280 + h * 128 + (d & 1) * 64 + jc) = v;
        }
        wsync();
        {
            const bf16_t* vb = gq + t0 * 1536 + 1024 + h * 128 + (size_t)r16 * 1536 + 8 * q4;
#pragma unroll
            for (int m = 0; m < 4; ++m) {
                bf16x8 vf[4];
#pragma unroll
                for (int kk = 0; kk < 4; ++kk) vf[kk] = *(const bf16x8*)(vb + (size_t)m * 16 * 1536 + 32 * kk);
                store_T_row(XT, vf, bts[16 * m + r16], m, r16, q4);
            }
        }
        wsync();
#pragma unroll
        for (int nt = 0; nt < 8; ++nt) {
            bf16x8 bfv[2];
#pragma unroll
            for (int ks = 0; ks < 2; ++ks) bfv[ks] = *(const bf16x8*)(XT + (16 * nt + r16) * 72 + 32 * ks + 8 * q4);
            const int n = 16 * nt + r16;
#pragma unroll
            for (int mi = 0; mi < 4; ++mi) {
                f32x4 a = {0.f, 0.f, 0.f, 0.f};
#pragma unroll
                for (int ks = 0; ks < 2; ++ks) a = __builtin_amdgcn_mfma_f32_16x16x32_bf16(Tf[mi][ks], bfv[ks], a, 0, 0, 0);
                *(u32x2*)(gq + (t0 + (n >> 1)) * 1536 + 1024 + h * 128 + (n & 1) * 64 + 16 * mi + 4 * q4) = pack4(a);
            }
        }
        wsync();
    }
}

constexpr int SC_W = 0, SC_QD = 16384, SC_QK = 32768, SC_KD = 40960, SC_UT = 57344, SC_STAGE = 61440;
constexpr int SC_ST = 2 * SC_STAGE, SC_VT = SC_ST + 32 * 136 * 2, SC_GL = SC_VT + 32 * 72 * 2;
DI void gdn_scan(const Params& P, int item, unsigned char* smem) {
    const int tid = tid_(), lane = tid & 63, wid = tid >> 6, r16 = lane & 15, q4 = lane >> 4;
    const int ns = (item >> 3) & 3, bh = ((item & 7) << 1) | (item >> 5), h = bh & 3, b = bh >> 2;
    const int mi = wid & 3, nt = wid >> 2, md = wid;
    bf16_t* ST = (bf16_t*)(smem + SC_ST);
    bf16_t* VT = (bf16_t*)(smem + SC_VT);
    float* gls = (float*)(smem + SC_GL);
    const bf16_t* proj = (const bf16_t*)(P.ws + OFF_U);
    const bf16_t* gq = (const bf16_t*)(P.ws + OFF_GQ);
    const float* glw = (const float*)(P.ws + OFF_GL);
    bf16_t* mixed = (bf16_t*)(P.ws + OFF_XB);
    for (int i = tid; i < 32 * 136 / 2; i += NTHREADS) ((unsigned*)ST)[i] = 0u;
    if (tid < 128) gls[tid] = glw[((b * 128 + tid) << 2) + h];
    const size_t tb = (size_t)b * SEQ;
    const int r4 = tid >> 4, k16 = (tid & 15) ^ (r4 & 15), k8 = (tid & 7) ^ (r4 & 7);
    const bf16_t* pw = proj + (tb + r4) * PJ + 768 + h * 128 + k16 * 8;
    const bf16_t* pq = gq + (tb + r4) * 1536 + h * 128 + k16 * 8;
    const bf16_t* pk = proj + (tb + (tid >> 3)) * PJ + 1792 + h * 128 + k8 * 8;
    const bf16_t* pd = proj + (tb + r4) * PJ + 1280 + h * 128 + ((tid >> 3) & 1) * 64 + k8 * 8;
    const int nu = ns * 32 + ((tid >> 3) & 31);
    const bf16_t* pu = gq + (tb + (nu >> 1)) * 1536 + 1024 + h * 128 + (nu & 1) * 64 + (tid & 7) * 8;
    const unsigned lbase = (unsigned)(size_t)smem + (unsigned)__builtin_amdgcn_readfirstlane(wid) * 1024u;
    const bool uwave = (__builtin_amdgcn_readfirstlane(wid) < 4);
#define SC_ISSUE(c_) do { const unsigned dst_ = lbase + (unsigned)((c_) & 1) * SC_STAGE; const size_t o1_ = (size_t)(c_) * 64 * PJ, o2_ = (size_t)(c_) * 64 * 1536; \
        glds16(pw + o1_, dst_ + SC_W); glds16(pw + o1_ + (size_t)32 * PJ, dst_ + SC_W + 8192u); \
        glds16(pq + o2_, dst_ + SC_QD); glds16(pq + o2_ + (size_t)32 * 1536, dst_ + SC_QD + 8192u); \
        glds16(pk + o1_, dst_ + SC_QK); \
        glds16(pd + o1_, dst_ + SC_KD); glds16(pd + o1_ + (size_t)32 * PJ, dst_ + SC_KD + 8192u); \
        if (uwave) glds16(pu + o2_, dst_ + SC_UT); } while (0)
    const int ow = (16 * mi + r16) * 256, oqk = SC_QK + (16 * mi + r16) * 128, okd = SC_KD + (16 * md + r16) * 128;
    const int out = SC_UT + (16 * nt + r16) * 128 + (16 * mi + 4 * q4) * 2;
    const int x8 = r16 >> 1;
    f32x4 accS[2] = {{0.f, 0.f, 0.f, 0.f}, {0.f, 0.f, 0.f, 0.f}};
    SC_ISSUE(0);
    asm volatile("s_waitcnt vmcnt(0)" ::: "memory");
    __syncthreads();
    for (int c = 0; c < 128; ++c) {
        if (c + 1 < 128) SC_ISSUE(c + 1);
        const unsigned char* sg = smem + (c & 1) * SC_STAGE;
        f32x4 aP = {0.f, 0.f, 0.f, 0.f}, aO = {0.f, 0.f, 0.f, 0.f};
#pragma unroll
        for (int kk = 0; kk < 4; ++kk) {
            const bf16x8 sf = *(const bf16x8*)(ST + (16 * nt + r16) * 136 + 32 * kk + 8 * q4);
            const int co = (((4 * kk + q4) ^ r16) << 4);
            const bf16x8 wf = *(const bf16x8*)(sg + SC_W + ow + co);
            const bf16x8 qd = *(const bf16x8*)(sg + SC_QD + ow + co);
            aP = __builtin_amdgcn_mfma_f32_16x16x32_bf16(wf, sf, aP, 0, 0, 0);
            aO = __builtin_amdgcn_mfma_f32_16x16x32_bf16(qd, sf, aO, 0, 0, 0);
        }
        {
            const u32x2 uu = *(const u32x2*)(sg + out);
            f32x4 vn;
            vn[0] = bf_lo(uu.x) - aP[0]; vn[1] = bf_hi(uu.x) - aP[1]; vn[2] = bf_lo(uu.y) - aP[2]; vn[3] = bf_hi(uu.y) - aP[3];
            *(u32x2*)(VT + (16 * nt + r16) * 72 + 16 * mi + 4 * q4) = pack4(vn);
        }
        lds_barrier();
#pragma unroll
        for (int ks = 0; ks < 2; ++ks) {
            const bf16x8 vf = *(const bf16x8*)(VT + (16 * nt + r16) * 72 + 32 * ks + 8 * q4);
            const bf16x8 qk = *(const bf16x8*)(sg + oqk + (((4 * ks + q4) ^ x8) << 4));
            aO = __builtin_amdgcn_mfma_f32_16x16x32_bf16(qk, vf, aO, 0, 0, 0);
        }
        {
            bf16_t* op = mixed + (tb + (size_t)c * 64 + 16 * mi + 4 * q4) * D + 256 + h * 128 + ns * 32 + 16 * nt + r16;
#pragma unroll
            for (int r = 0; r < 4; ++r) op[(size_t)r * D] = (bf16_t)(pk_bf16(aO[r], 0.f) & 0xffffu);
        }
        const float gl = gls[c];
        bf16x8 kd[2];
#pragma unroll
        for (int ks = 0; ks < 2; ++ks) kd[ks] = *(const bf16x8*)(sg + okd + (((4 * ks + q4) ^ x8) << 4));
#pragma unroll
        for (int n2 = 0; n2 < 2; ++n2) {
            accS[n2] = accS[n2] * gl;
#pragma unroll
            for (int ks = 0; ks < 2; ++ks) {
                const bf16x8 vf = *(const bf16x8*)(VT + (16 * n2 + r16) * 72 + 32 * ks + 8 * q4);
                accS[n2] = __builtin_amdgcn_mfma_f32_16x16x32_bf16(kd[ks], vf, accS[n2], 0, 0, 0);
            }
            *(u32x2*)(ST + (16 * n2 + r16) * 136 + 16 * md + 4 * q4) = pack4(accS[n2]);
        }
        asm volatile("s_waitcnt vmcnt(0)" ::: "memory");
        lds_barrier();
    }
#undef SC_ISSUE
    __syncthreads();
}

DI void phase_mix(const Params& P, int l, unsigned char* smem) {
    const int G = gridDim.x;
    for (int it = blockIdx.x; it < 64; it += G) {
        gdn_scan(P, it, smem);
#if PROBE_SCAN2
        __syncthreads();
        gdn_scan(P, it, smem);
#endif
    }
    const int nvb = (G > 64) ? (G - 64) : G;
    const int vb = (G > 64) ? ((int)blockIdx.x - 64) : (int)blockIdx.x;
    if (vb >= 0) {
        sb_mfma(P, vb * 8 + (tid_() >> 6), nvb * 8); sc_conv(P, l, vb, nvb);
#if PROBE_SBSC2
        sb_mfma(P, vb * 8 + (tid_() >> 6), nvb * 8); sc_conv(P, l, vb, nvb);
#endif
        if (l == 0 && G > 64) { __syncthreads(); prep_weights(P, smem, 0, vb, nvb, 1); prep_weights(P, smem, 1, vb, nvb, 2); }
    }
}

DI void grid_bar(unsigned* cnt, unsigned& gen) {
    __syncthreads();
    gen += gridDim.x;
    if (threadIdx.x == 0) {
        __builtin_amdgcn_fence(__ATOMIC_RELEASE, "agent");
        __hip_atomic_fetch_add(cnt, 1u, __ATOMIC_RELAXED, __HIP_MEMORY_SCOPE_AGENT);
        while (__hip_atomic_load(cnt, __ATOMIC_RELAXED, __HIP_MEMORY_SCOPE_AGENT) < gen) __builtin_amdgcn_s_sleep(2);
        __builtin_amdgcn_fence(__ATOMIC_ACQUIRE, "agent");
    }
    __syncthreads();
}

constexpr int NPH = 8;
__global__ void __launch_bounds__(NTHREADS) mega(Params PK) {
    extern __shared__ __attribute__((aligned(16))) unsigned char smem[];
    cg::grid_group grid = cg::this_grid();
    unsigned bar_gen = 0u;
    for (int ph = PK.ph_lo; ph < PK.ph_hi; ++ph) {
        const Params& P = PK;
        if (ph == 0) phase_prep(P, smem);
        else if (ph == 1 || ph == 4 || ph == 7) {
            const int lo = (ph == 1) ? 0 : (ph == 4 ? 3 : 11), hi = (ph == 1) ? 3 : (ph == 4 ? 11 : 16);
            for (int rb = blockIdx.x; rb < NRB; rb += gridDim.x) run_jobs(P, rb, lo, hi, smem);
        }
        else if (ph == 2 || ph == 5) {
            phase_gdn_prep(P, ph == 2 ? 0 : 1);
            __syncthreads();
            phase_gdn_chunk(P, smem);
        }
        else phase_mix(P, ph == 3 ? 0 : 1, smem);
        if (ph + 1 < PK.ph_hi) { if (ph == 0) grid.sync(); else grid_bar((unsigned*)(PK.ws + OFF_BAR), bar_gen); }
    }
}

extern "C" void kernel_launch(void* const* d_in, const int* in_sizes, int n_in, void* d_out, int out_size, void* d_ws, size_t ws_size, hipStream_t stream) {
    static int grid_blocks = 0;
    if (grid_blocks == 0) {
        if (n_in != 16 || out_size != NTOK * D || ws_size < WS_END) {
            fprintf(stderr, "kernel_launch: unexpected shapes / workspace (n_in %d out %d ws %zu need %zu)\n", n_in, out_size, ws_size, (size_t)WS_END);
            grid_blocks = -1; return;
        }
        int dev = 0, cus = 0, per_cu = 0;
        hipGetDevice(&dev);
        hipDeviceGetAttribute(&cus, hipDeviceAttributeMultiprocessorCount, dev);
        if (hipFuncSetAttribute((const void*)mega, hipFuncAttributeMaxDynamicSharedMemorySize, SMEM_BYTES) != hipSuccess) { fprintf(stderr, "hipFuncSetAttribute failed\n"); grid_blocks = -1; return; }
        hipOccupancyMaxActiveBlocksPerMultiprocessor(&per_cu, (const void*)mega, NTHREADS, SMEM_BYTES);
        if (per_cu < 1) per_cu = 1;
        grid_blocks = cus * per_cu;
        if (grid_blocks > NRB) grid_blocks = NRB;
    }
    if (grid_blocks < 0) return;
    Params P{};
    P.x = (const float*)d_in[0]; P.p = (const float*)d_in[1]; P.ln_g = (const float*)d_in[2]; P.ln_b = (const float*)d_in[3];
    P.ffn_w_in = (const float*)d_in[4]; P.ffn_w_out = (const float*)d_in[5]; P.mix_w_in = (const float*)d_in[6]; P.gdn_conv_w = (const float*)d_in[7];
    P.gdn_a_log = (const float*)d_in[8]; P.gdn_dt_bias = (const float*)d_in[9]; P.gdn_norm_w = (const float*)d_in[10]; P.sc_conv_w = (const float*)d_in[11];
    P.mix_w_out = (const float*)d_in[12]; P.ple_w_proj = (const float*)d_in[13]; P.ple_w_gate = (const float*)d_in[14]; P.ple_b_gate = (const float*)d_in[15];
    P.out = (float*)d_out; P.ws = (unsigned char*)d_ws;
#if N_LAUNCH_MODE == 1
    P.ph_lo = 0; P.ph_hi = NPH;
    void* args[] = {&P};
    hipError_t e = hipLaunchCooperativeKernel((const void*)mega, dim3(grid_blocks), dim3(NTHREADS), args, SMEM_BYTES, stream);
    if (e != hipSuccess) fprintf(stderr, "cooperative launch failed: %s (grid %d)\n", hipGetErrorString(e), grid_blocks);
#else
    for (int ph = 0; ph < NPH; ++ph) {
        P.ph_lo = ph; P.ph_hi = ph + 1;
        void* args[] = {&P};
        hipError_t e = hipLaunchCooperativeKernel((const void*)mega, dim3(grid_blocks), dim3(NTHREADS), args, SMEM_BYTES, stream);
        if (e != hipSuccess) fprintf(stderr, "launch failed: %s (grid %d)\n", hipGetErrorString(e), grid_blocks);
    }
#endif
}
```
